# Optimizing an MI355X kernel written in HIP

```python
import jax, jax.numpy as jnp
from jax import lax
import numpy as np

D_MODEL = 2048
BATCH = 4
SEQ = 2048
DEPTH = 1

GRID_W = 64
MIX_WIDTH = D_MODEL
FOURIER_WIDTH = MIX_WIDTH // 4
FOURIER_GROUP_DIM = 128
FOURIER_GROUPS = FOURIER_WIDTH // FOURIER_GROUP_DIM
ATTN_WIDTH = MIX_WIDTH - FOURIER_WIDTH
HEAD_DIM = 128
N_Q_HEADS = ATTN_WIDTH // HEAD_DIM
GQA_GROUP = 3
N_KV_HEADS = N_Q_HEADS // GQA_GROUP
KV_WIDTH = N_KV_HEADS * HEAD_DIM
IN_WIDTH = FOURIER_WIDTH + ATTN_WIDTH + 2 * KV_WIDTH
ROPE_THETA = 10000.0
AXIS_ROPE_DIM = HEAD_DIM // 2
Q_BLOCK = 128
N_EXPERTS = 32
TOP_K = 4
D_FF_EXPERT = D_MODEL
SWIGLU_LIMIT = 7.0
SWIGLU_ALPHA = 1.702
EXPERT_BLOCK = 128
N_MOD = 6
EPS = 1e-6

kernel_name = 'hybrid_fnet_axialgqa_moe_block'


def rms_norm(x, g):
    xf = x.astype(jnp.float32)
    y = xf * lax.rsqrt(jnp.mean(xf * xf, axis=-1, keepdims=True) + EPS)
    return (y * g.astype(jnp.float32)).astype(x.dtype)


def modulate(h, shift, scale):
    return h * (1.0 + scale[:, None, :]) + shift[:, None, :]


def axial_rope_tables(seq_len):
    rows = seq_len // GRID_W
    row_idx = jnp.repeat(jnp.arange(rows, dtype=jnp.float32), GRID_W)
    col_idx = jnp.tile(jnp.arange(GRID_W, dtype=jnp.float32), rows)
    inv_freq = 1.0 / (ROPE_THETA ** (jnp.arange(0, AXIS_ROPE_DIM, 2, dtype=jnp.float32) / AXIS_ROPE_DIM))
    ang = jnp.concatenate([row_idx[:, None] * inv_freq, col_idx[:, None] * inv_freq], axis=-1)
    return jnp.cos(ang), jnp.sin(ang)


def apply_rope(x, cos, sin):
    xf = x.astype(jnp.float32).reshape(x.shape[:-1] + (HEAD_DIM // 2, 2))
    x0, x1 = xf[..., 0], xf[..., 1]
    c = cos[None, :, None, :]
    s = sin[None, :, None, :]
    out = jnp.stack([x0 * c - x1 * s, x0 * s + x1 * c], axis=-1).reshape(x.shape)
    return out.astype(x.dtype)


def fourier_mix(f, w_fourier):
    b, s, _ = f.shape
    fu = f.reshape(b, s, FOURIER_GROUPS, FOURIER_GROUP_DIM).astype(jnp.float32)
    fm = jnp.fft.fft2(fu, axes=(1, 3), norm='ortho').real.astype(f.dtype)
    fo = jnp.einsum('bsgc,gcd->bsgd', fm, w_fourier)
    return fo.reshape(b, s, FOURIER_WIDTH)


def block_attention(q, k, v):
    b, s = q.shape[0], q.shape[1]
    nb = s // Q_BLOCK
    qb = q.reshape(b, nb, Q_BLOCK, N_KV_HEADS, GQA_GROUP, HEAD_DIM).transpose(1, 0, 2, 3, 4, 5)
    scale = HEAD_DIM ** -0.5

    def one_block(q_blk):
        sc = jnp.einsum('bqkgd,bskd->bkgqs', q_blk, k).astype(jnp.float32) * scale
        p = jax.nn.softmax(sc, axis=-1).astype(v.dtype)
        return jnp.einsum('bkgqs,bskd->bqkgd', p, v)

    o = lax.map(one_block, qb)
    return o.transpose(1, 0, 2, 3, 4, 5).reshape(b, s, ATTN_WIDTH)


def clamped_swiglu(g, u):
    g = jnp.minimum(g, SWIGLU_LIMIT)
    u = jnp.clip(u, -SWIGLU_LIMIT, SWIGLU_LIMIT)
    return (u + 1.0) * (g * jax.nn.sigmoid(SWIGLU_ALPHA * g))


def moe_ffn(h, w_router, b_router, w_gate, b_gate, w_up, b_up, w_down, b_down):
    b, s, d = h.shape
    n_tok = b * s
    hf = h.reshape(n_tok, d)
    logits = (hf @ w_router).astype(jnp.float32) + b_router.astype(jnp.float32)
    top_val, top_idx = lax.top_k(logits, TOP_K)
    gates = jax.nn.softmax(top_val, axis=-1).astype(h.dtype)
    n_assign = n_tok * TOP_K
    flat_e = top_idx.reshape(-1).astype(jnp.int32)
    flat_tok = jnp.arange(n_assign, dtype=jnp.int32) // TOP_K
    flat_gate = gates.reshape(-1)
    order = jnp.argsort(flat_e)
    sorted_e = flat_e[order]
    counts = jnp.zeros((N_EXPERTS,), jnp.int32).at[flat_e].add(1)
    padded = (counts + EXPERT_BLOCK - 1) // EXPERT_BLOCK * EXPERT_BLOCK
    pad_end = jnp.cumsum(padded)
    pad_start = pad_end - padded
    start = jnp.cumsum(counts) - counts
    rank = jnp.arange(n_assign, dtype=jnp.int32) - start[sorted_e]
    dest = pad_start[sorted_e] + rank
    n_pad = n_assign + N_EXPERTS * EXPERT_BLOCK
    n_blk = n_pad // EXPERT_BLOCK
    row_tok = jnp.full((n_pad,), n_tok, jnp.int32).at[dest].set(flat_tok[order])
    row_gate = jnp.zeros((n_pad,), h.dtype).at[dest].set(flat_gate[order])
    blk_start = jnp.arange(n_blk, dtype=jnp.int32) * EXPERT_BLOCK
    blk_e = jnp.minimum(jnp.searchsorted(pad_end, blk_start, side='right'), N_EXPERTS - 1)
    x_pad = jnp.concatenate([hf, jnp.zeros((1, d), hf.dtype)], axis=0)

    def expert_block(args):
        tok, e = args
        xb = x_pad[tok]
        g = xb @ w_gate[e] + b_gate[e]
        u = xb @ w_up[e] + b_up[e]
        return clamped_swiglu(g, u) @ w_down[e] + b_down[e]

    out = lax.map(expert_block, (row_tok.reshape(n_blk, EXPERT_BLOCK), blk_e))
    out = out.reshape(n_pad, d) * row_gate[:, None]
    y = jnp.zeros((n_tok + 1, d), h.dtype).at[row_tok].add(out)[:n_tok]
    return y.reshape(b, s, d)


def setup_inputs(seed: int = 0) -> dict:
    key = jax.random.key(seed)
    ks = jax.random.split(key, 24)
    f32 = jnp.float32
    def nrm(k, shape, scale):
        return jax.random.normal(k, shape, f32) * scale
    def gain(k, shape):
        return 1.0 + 0.02 * jax.random.normal(k, shape, f32)
    L = DEPTH
    return {
        'x': nrm(ks[0], (BATCH, SEQ, D_MODEL), 1.0),
        'c': nrm(ks[1], (BATCH, D_MODEL), 1.0),
        'w_ada': nrm(ks[2], (L, D_MODEL, N_MOD * D_MODEL), 0.5 * D_MODEL ** -0.5),
        'b_ada': nrm(ks[3], (L, N_MOD * D_MODEL), 0.02),
        'g_pre_mix': gain(ks[4], (L, D_MODEL)),
        'w_in': nrm(ks[5], (L, D_MODEL, IN_WIDTH), D_MODEL ** -0.5),
        'w_fourier': nrm(ks[6], (L, FOURIER_GROUPS, FOURIER_GROUP_DIM, FOURIER_GROUP_DIM), FOURIER_GROUP_DIM ** -0.5),
        'q_norm_g': gain(ks[7], (L, HEAD_DIM)),
        'k_norm_g': gain(ks[8], (L, HEAD_DIM)),
        'g_fourier_out': gain(ks[9], (L, FOURIER_WIDTH)),
        'g_attn_out': gain(ks[10], (L, ATTN_WIDTH)),
        'w_out': nrm(ks[11], (L, MIX_WIDTH, D_MODEL), MIX_WIDTH ** -0.5),
        'g_post_mix': gain(ks[12], (L, D_MODEL)),
        'g_pre_ffn': gain(ks[13], (L, D_MODEL)),
        'w_router': nrm(ks[14], (L, D_MODEL, N_EXPERTS), D_MODEL ** -0.5),
        'b_router': nrm(ks[15], (L, N_EXPERTS), 0.01),
        'w_gate': nrm(ks[16], (L, N_EXPERTS, D_MODEL, D_FF_EXPERT), D_MODEL ** -0.5),
        'b_gate': nrm(ks[17], (L, N_EXPERTS, D_FF_EXPERT), 0.02),
        'w_up': nrm(ks[18], (L, N_EXPERTS, D_MODEL, D_FF_EXPERT), D_MODEL ** -0.5),
        'b_up': nrm(ks[19], (L, N_EXPERTS, D_FF_EXPERT), 0.02),
        'w_down': nrm(ks[20], (L, N_EXPERTS, D_FF_EXPERT, D_MODEL), D_FF_EXPERT ** -0.5),
        'b_down': nrm(ks[21], (L, N_EXPERTS, D_MODEL), 0.02),
        'g_post_ffn': gain(ks[22], (L, D_MODEL)),
    }


def reference(x, c, w_ada, b_ada, g_pre_mix, w_in, w_fourier, q_norm_g, k_norm_g, g_fourier_out, g_attn_out, w_out, g_post_mix, g_pre_ffn, w_router, b_router, w_gate, b_gate, w_up, b_up, w_down, b_down, g_post_ffn):
    b, s, _ = x.shape
    cos, sin = axial_rope_tables(s)
    for l in range(DEPTH):
        mod = (jax.nn.silu(c) @ w_ada[l] + b_ada[l]).reshape(b, N_MOD, D_MODEL)
        shift_m, scale_m, gate_m = mod[:, 0], mod[:, 1], mod[:, 2]
        shift_f, scale_f, gate_f = mod[:, 3], mod[:, 4], mod[:, 5]

        h = modulate(rms_norm(x, g_pre_mix[l]), shift_m, scale_m)
        proj = h @ w_in[l]
        f = proj[..., :FOURIER_WIDTH]
        q = proj[..., FOURIER_WIDTH:FOURIER_WIDTH + ATTN_WIDTH].reshape(b, s, N_Q_HEADS, HEAD_DIM)
        k = proj[..., FOURIER_WIDTH + ATTN_WIDTH:FOURIER_WIDTH + ATTN_WIDTH + KV_WIDTH].reshape(b, s, N_KV_HEADS, HEAD_DIM)
        v = proj[..., FOURIER_WIDTH + ATTN_WIDTH + KV_WIDTH:].reshape(b, s, N_KV_HEADS, HEAD_DIM)

        fo = fourier_mix(f, w_fourier[l])

        q = apply_rope(rms_norm(q, q_norm_g[l]), cos, sin)
        k = apply_rope(rms_norm(k, k_norm_g[l]), cos, sin)
        ao = block_attention(q, k, v)

        merged = jnp.concatenate([rms_norm(fo, g_fourier_out[l]), rms_norm(ao, g_attn_out[l])], axis=-1)
        mix = merged @ w_out[l]
        x = x + gate_m[:, None, :] * rms_norm(mix, g_post_mix[l])

        h = modulate(rms_norm(x, g_pre_ffn[l]), shift_f, scale_f)
        y = moe_ffn(h, w_router[l], b_router[l], w_gate[l], b_gate[l], w_up[l], b_up[l], w_down[l], b_down[l])
        x = x + gate_f[:, None, :] * rms_norm(y, g_post_ffn[l])
    return x
```

```cpp
#include <hip/hip_runtime.h>
#include <stdint.h>
#include <stdio.h>

#ifndef DEBUG_X1
#define DEBUG_X1 0
#endif
#ifndef STAMP_A
#define STAMP_A 0
#endif
#ifndef STAMP_B
#define STAMP_B 0
#endif
#ifndef S8_KMAP
#define S8_KMAP 0
#endif
#ifndef REP_MASK
#define REP_MASK 0
#endif
#ifndef DEBUG_PROBE
#define DEBUG_PROBE 0
#endif
#ifndef P3_MASK
#define P3_MASK 3
#endif
#ifndef MK_N_LAUNCHES
#define MK_N_LAUNCHES 1
#endif

namespace {

constexpr int DM = 2048, NBATCH = 4, SEQ = 2048, NTOK = NBATCH * SEQ;
constexpr int FW = 512, AW = 1536, KVW = 512, INW = 3072;
constexpr int NEXP = 32, TOPK = 4, NMOD = 6;
constexpr int NPHASE = 11;
constexpr float EPS = 1e-6f;
constexpr int NTHREADS = 512;
constexpr float FP8_SA = 16.f, FP8_SW = 256.f, FP8_SACT = 4.f;

typedef unsigned short bf16_t;
typedef short bf16x8 __attribute__((ext_vector_type(8)));
typedef short s16x4 __attribute__((ext_vector_type(4)));
typedef float f32x4 __attribute__((ext_vector_type(4)));
typedef float f32x2 __attribute__((ext_vector_type(2)));
typedef float f32x16 __attribute__((ext_vector_type(16)));
typedef unsigned u32x4 __attribute__((ext_vector_type(4)));
typedef unsigned u32x2 __attribute__((ext_vector_type(2)));

constexpr size_t al256(size_t x) { return (x + 255) / 256 * 256; }
constexpr size_t WS_CTL   = 0;
constexpr size_t CTL_BAR_BYTES = 16384;
constexpr size_t CTL_CNT_OFF = CTL_BAR_BYTES;
constexpr size_t CTL_RANK_OFF = CTL_BAR_BYTES + 256;
constexpr size_t CTL_BYTES = CTL_BAR_BYTES + 512;
constexpr size_t WS_MODP  = al256(WS_CTL + CTL_BYTES);
constexpr size_t WS_G12   = al256(WS_MODP + 2ull * 4 * 12288 * 4);
constexpr size_t WS_ROPE  = al256(WS_G12 + 4ull * 128 * 256 * 4);
constexpr size_t WS_WZ    = al256(WS_ROPE + 2048ull * 64 * 2 * 4);
constexpr size_t WS_CMAT  = al256(WS_WZ + 2048ull * 1024 * 4);
constexpr size_t WS_SMAT  = al256(WS_CMAT + 2048ull * 2048 * 2);
constexpr size_t WS_H     = al256(WS_SMAT + 2048ull * 2048 * 2);
constexpr size_t WS_ZC    = al256(WS_H + (size_t)NTOK * DM * 2);
constexpr size_t WS_ZS    = al256(WS_ZC + (size_t)NTOK * 512 * 4);
constexpr size_t WS_Q     = al256(WS_ZS + (size_t)NTOK * 512 * 4);
constexpr size_t WS_K     = al256(WS_Q + (size_t)NTOK * AW * 2);
constexpr size_t WS_V     = al256(WS_K + (size_t)NTOK * KVW * 2);
constexpr size_t WS_MRG   = al256(WS_V + (size_t)NTOK * KVW * 2);
constexpr size_t WS_MIX   = al256(WS_MRG + (size_t)NTOK * DM * 2);
constexpr size_t WS_X1    = al256(WS_MIX + (size_t)NTOK * DM * 2);
constexpr size_t WS_H2    = al256(WS_X1 + (size_t)NTOK * DM * 4);
constexpr size_t WS_LIST  = al256(WS_H2 + (size_t)NTOK * DM * 2);
constexpr size_t WS_GATEV = al256(WS_LIST + 32ull * 8192 * 4);
constexpr int ACT_ROWS = NTOK * TOPK + NEXP * 256;
constexpr size_t WS_ACT   = al256(WS_GATEV + 32768ull * 4);
constexpr size_t WS_OUTB  = al256(WS_ACT + (size_t)ACT_ROWS * DM * 2);
constexpr size_t WS_IMGGU = al256(WS_OUTB + (size_t)NTOK * TOPK * DM * 2);
constexpr size_t WS_IMGDN = al256(WS_IMGGU + 32ull * 16 * 32 * 16384);
constexpr size_t WS_IMGIN = al256(WS_IMGDN + 32ull * 8 * 32 * 16384);
constexpr size_t WS_IMGOUT= al256(WS_IMGIN + 14ull * 32 * 32768);
constexpr size_t WS_IMGZ  = al256(WS_IMGOUT + 8ull * 32 * 32768);
constexpr size_t WS_END   = al256(WS_IMGZ + 8ull * 64 * 32768);

constexpr int LDS_GEMM = 131072;
constexpr int LDS_MISC = LDS_GEMM;
constexpr int LDS_BYTES = LDS_GEMM + 1024;

typedef __bf16 bf16x2_t __attribute__((ext_vector_type(2)));
__device__ __forceinline__ unsigned cvt_pk_bf16(float lo, float hi) { f32x2 v = {lo, hi}; bf16x2_t b = __builtin_convertvector(v, bf16x2_t); return __builtin_bit_cast(unsigned, b); }
__device__ __forceinline__ bf16_t f2bf(float f) { return (bf16_t)(cvt_pk_bf16(f, 0.f) & 0xffffu); }
__device__ __forceinline__ float bf2f(unsigned h) { return __uint_as_float(h << 16); }
__device__ __forceinline__ float bflo(unsigned w) { return __uint_as_float(w << 16); }
__device__ __forceinline__ float bfhi(unsigned w) { return __uint_as_float(w & 0xffff0000u); }
__device__ __forceinline__ float wave_sum(float v) {
#pragma unroll
    for (int o = 32; o >= 1; o >>= 1) v += __shfl_xor(v, o, 64);
    return v;
}

#define XB_TMO      128
#define XB_XCNT(j)  (256  + 64 * (j))
#define XB_XSUB(j)  (1280 + 64 * (j))
#define XB_XGEN(j)  (2304 + 64 * (j))
#define XB_TOP      3328
#define XB_TOPGEN   3392
#define XCD_BAR_WORDS 3456
#define XB_SPIN_CAP (1u << 22)
#define LAS __attribute__((address_space(3)))

__device__ __forceinline__ unsigned xb_ld(unsigned* p)              { return __hip_atomic_load(p, __ATOMIC_RELAXED, __HIP_MEMORY_SCOPE_AGENT); }
__device__ __forceinline__ unsigned xb_add(unsigned* p, unsigned v) { return __hip_atomic_fetch_add(p, v, __ATOMIC_RELAXED, __HIP_MEMORY_SCOPE_AGENT); }
__device__ __forceinline__ unsigned xb_xcc_id() { return (unsigned)__builtin_amdgcn_s_getreg((3 << 11) | 20) & 0xFu; }
#define XB_SPIN(cond, bar) do { unsigned _sp = 0; while (cond) { __builtin_amdgcn_s_sleep(1); \
    if ((++_sp & 255u) == 0u) { if (xb_ld(&(bar)[XB_TMO])) break; if (_sp > XB_SPIN_CAP) { atomicAdd(&(bar)[XB_TMO], 1u); break; } } } } while (0)

struct XcdBarrier { unsigned* bar; unsigned x; volatile LAS unsigned* st; };

__device__ __forceinline__ XcdBarrier xcd_barrier_post(unsigned* bar, volatile LAS unsigned* st) {
    XcdBarrier b; b.bar = bar; b.x = xb_xcc_id(); b.st = st;
    if (threadIdx.x == 0) (void)xb_add(&bar[XB_XCNT(b.x)], 1u);
    return b;
}
__device__ __forceinline__ void xcd_barrier_complete(unsigned* bar, unsigned x, unsigned& nloc, unsigned& nx) {
    const unsigned G = gridDim.x * gridDim.y * gridDim.z;
    unsigned sum, cnt, mine, sp = 0u;
    for (;;) {
        sum = 0u; cnt = 0u; mine = 0u;
#pragma unroll
        for (unsigned j = 0; j < 16; ++j) { const unsigned c = xb_ld(&bar[XB_XCNT(j)]); sum += c; cnt += (c > 0u) ? 1u : 0u; mine = (j == x) ? c : mine; }
        if (sum == G) break;
        __builtin_amdgcn_s_sleep(1);
        if ((++sp & 255u) == 0u) { if (xb_ld(&bar[XB_TMO])) break; if (sp > XB_SPIN_CAP) { atomicAdd(&bar[XB_TMO], 1u); break; } }
    }
    nloc = mine > 0u ? mine : 1u; nx = cnt > 0u ? cnt : 1u;
}
__device__ __forceinline__ void xcd_barrier(const XcdBarrier& b) {
    asm volatile("s_waitcnt vmcnt(0)" ::: "memory");
    __syncthreads();
    if (threadIdx.x == 0) {
        unsigned* bar = b.bar;
        __builtin_amdgcn_s_waitcnt(0);
        unsigned nloc = b.st[0], nx = b.st[1];
        if (nloc == 0u) { xcd_barrier_complete(bar, b.x, nloc, nx); b.st[0] = nloc; b.st[1] = nx; }
        const unsigned old = xb_add(&bar[XB_XSUB(b.x)], 1u);
        const unsigned gen = old / nloc;
        if (old + 1u == (gen + 1u) * nloc) {
            __builtin_amdgcn_fence(__ATOMIC_RELEASE, "agent");
            asm volatile("s_waitcnt vmcnt(0)" ::: "memory");
            const unsigned og = xb_add(&bar[XB_TOP], 1u);
            const unsigned tg = og / nx;
            if (og + 1u == (tg + 1u) * nx) xb_add(&bar[XB_TOPGEN], 1u);
            else XB_SPIN(xb_ld(&bar[XB_TOPGEN]) == tg, bar);
            __builtin_amdgcn_fence(__ATOMIC_ACQUIRE, "agent");
            xb_add(&bar[XB_XGEN(b.x)], 1u);
            asm volatile("s_waitcnt vmcnt(0)" ::: "memory");
        } else {
            XB_SPIN(xb_ld(&bar[XB_XGEN(b.x)]) == gen, bar);
            __builtin_amdgcn_fence(__ATOMIC_ACQUIRE, "agent");
            asm volatile("s_waitcnt vmcnt(0)" ::: "memory");
        }
    }
    __syncthreads();
}

struct Args {
    const float* in[23];
    float* out;
    unsigned char* ws;
    int ph_lo, ph_hi;
};

struct GemmThread {
    int a_w0;
    int b_w0;
    int a_r, b_r;
    int c8;
    int r0;
    int kg, ng;
    int wm, wn, l15, lq;
    int arow0, achunk;
    int rrow0, rchunk;
    int rfr;
    int imgw0;
    int f8r0, f8r1;
    int f8w0;
    int s8r0, s8r1;
};
__host__ __device__ constexpr int sw4(int c) { return (0x9C >> (2 * c)) & 3; }
__host__ __device__ constexpr int sw4inv(int p) { return (0x78 >> (2 * p)) & 3; }
__device__ __forceinline__ GemmThread gemm_thread_init() {
    GemmThread g;
    const int tid = threadIdx.x, lane = tid & 63, wave = __builtin_amdgcn_readfirstlane(tid >> 6);
    const int c = tid & 7; g.r0 = tid >> 3; g.c8 = c * 8;
    g.a_w0 = g.r0 * 128 + ((c ^ (g.r0 & 7)) << 4);
    g.kg = lane & 7; g.ng = (lane >> 3) + 8 * wave;
    g.b_w0 = 32768 + (4 * g.ng) * 128 + ((g.kg ^ ((4 * g.ng) & 7)) << 4);
    g.wm = wave >> 1; g.wn = wave & 1; g.l15 = lane & 15; g.lq = lane >> 4;
    const int sw = ((g.lq ^ (g.l15 & 7)) << 4);
    g.a_r = (64 * g.wm + g.l15) * 128 + sw;
    g.b_r = 32768 + (128 * g.wn + g.l15) * 128 + sw;
    g.arow0 = 32 * wave + (lane >> 3); g.achunk = ((lane & 7) ^ (lane >> 3)) * 16;
    g.rrow0 = 32 * wave + (lane >> 2); g.rchunk = sw4inv((lane & 3) ^ ((lane >> 4) & 3)) * 16;
    g.rfr = g.l15 * 64 + ((((g.l15 >> 2) & 3) ^ sw4(g.lq)) << 4);
    g.imgw0 = (g.kg >> 2) * 16384 + (4 * g.ng) * 64 + (((g.ng & 3) ^ sw4(g.kg & 3)) << 4);
    g.f8r0 = g.l15 * 64 + ((((g.l15 >> 2) & 3) ^ sw4(g.lq >> 1)) << 4) + 8 * (g.lq & 1);
    g.f8r1 = g.l15 * 64 + ((((g.l15 >> 2) & 3) ^ sw4(2 + (g.lq >> 1))) << 4) + 8 * (g.lq & 1);
    g.f8w0 = (4 * g.ng) * 64 + (((g.ng & 3) ^ sw4(g.kg >> 1)) << 4) + 8 * (g.kg & 1);
    { const int r32 = lane & 31, hh = lane >> 5, qq = (r32 >> 2) & 3;
      const int c0 = S8_KMAP ? hh : 2 * hh, c1 = S8_KMAP ? 2 + hh : 2 * hh + 1;
      g.s8r0 = r32 * 64 + ((qq ^ sw4(c0)) << 4); g.s8r1 = r32 * 64 + ((qq ^ sw4(c1)) << 4); }
    return g;
}

template <class T> __device__ __forceinline__ T* sgpr_ptr(T* p) {
    const unsigned long long v = (unsigned long long)p;
    const unsigned lo = __builtin_amdgcn_readfirstlane((unsigned)v), hi = __builtin_amdgcn_readfirstlane((unsigned)(v >> 32));
    typedef __attribute__((address_space(1))) T* gptr_t;
    return (T*)(gptr_t)(((unsigned long long)hi << 32) | lo);
}
__device__ __forceinline__ void glds16(const void* src, char* lds_wave_base) {
    __builtin_amdgcn_global_load_lds((const unsigned*)src, (LAS unsigned*)lds_wave_base, 16, 0, 0);
}
#define G_AF(ks)  _Pragma("unroll") for (int i_ = 0; i_ < 4; ++i_) af[i_] = *(const bf16x8*)(sb + ((g.a_r ^ ((ks) << 6)) + i_ * 2048));
#define G_BF(ks, jh) _Pragma("unroll") for (int j_ = 0; j_ < 4; ++j_) bfr[j_] = *(const bf16x8*)(sb + ((g.b_r ^ ((ks) << 6)) + ((jh) * 4 + j_) * 2048));
#define G_MM(jh) _Pragma("unroll") for (int j_ = 0; j_ < 4; ++j_) _Pragma("unroll") for (int i_ = 0; i_ < 4; ++i_) \
        acc[i_][(jh) * 4 + j_] = __builtin_amdgcn_mfma_f32_16x16x32_bf16(bfr[j_], af[i_], acc[i_][(jh) * 4 + j_], 0, 0, 0);
#define G_WRB(sn, j_) do { u32x4 w_; \
        w_[0] = cvt_pk_bf16(rb[0][j_], rb[1][j_]); w_[1] = cvt_pk_bf16(rb[2][j_], rb[3][j_]); \
        w_[2] = cvt_pk_bf16(rb[4][j_], rb[5][j_]); w_[3] = cvt_pk_bf16(rb[6][j_], rb[7][j_]); \
        *(u32x4*)((sn) + (bw0_ ^ ((j_) * 0x90))) = w_; \
        if (IMG) *(u32x4*)(imgk + g.imgw0 + (j_) * 64) = w_; } while (0)
template <bool TWO_SEG, bool WR, bool LD, bool IMG>
__device__ __forceinline__ void gemm_step(f32x4 (&acc)[4][8], char* lds, const GemmThread& g, const int wave, f32x4 (&rb)[8], const int kt,
                                          const char* Abase, const unsigned (&aoffb)[4], const char* Bbase, const unsigned boffb, const int ldbB,
                                          const char* Abase2, const char* Bbase2, const int nk1, char* img) {
    asm volatile("s_waitcnt vmcnt(0)" ::: "memory");
    __syncthreads();
    const char* sb = lds + (kt & 1) * 65536; char* sn = lds + ((kt + 1) & 1) * 65536;
    char* imgk = img + (size_t)(kt + 1) * 32768;
    if (WR) {
        const int k1 = kt + 1; const bool s1 = TWO_SEG && k1 >= nk1; const char* ak = (s1 ? Abase2 : Abase) + (size_t)(s1 ? k1 - nk1 : k1) * 128;
#pragma unroll
        for (int i = 0; i < 4; ++i) glds16(ak + aoffb[i], sn + (4 * wave + i) * 1024);
    }
    int bw0_ = g.b_w0; asm volatile("" : "+v"(bw0_));
    bf16x8 af[4], bfr[4];
    G_AF(0) G_BF(0, 0) G_MM(0)
    if (WR) { G_WRB(sn, 0); G_WRB(sn, 1); }
    __builtin_amdgcn_sched_barrier(0);
    G_BF(0, 1) G_MM(1)
    if (WR) { G_WRB(sn, 2); G_WRB(sn, 3); }
    if (LD) {
        const int k2 = kt + 2; const bool s2 = TWO_SEG && k2 >= nk1; const int kk = s2 ? k2 - nk1 : k2;
        const char* bk = (s2 ? Bbase2 : Bbase) + (size_t)kk * 64 * ldbB;
#pragma unroll
        for (int k = 0; k < 8; ++k) rb[k] = *(const f32x4*)(bk + (size_t)k * ldbB + boffb);
    }
    __builtin_amdgcn_sched_barrier(0);
    G_AF(1) G_BF(1, 0) G_MM(0)
    __builtin_amdgcn_sched_barrier(0);
    G_BF(1, 1) G_MM(1)
}

template <bool TWO_SEG = false, bool IMG = false>
__device__ __forceinline__ void gemm_accum(f32x4 (&acc)[4][8], char* lds, const GemmThread& g, const int wave,
                                           const char* Abase, const unsigned (&aoffb)[4],
                                           const char* Bbase, const unsigned boffb, const int ldbB, const int nk,
                                           const char* Abase2 = nullptr, const char* Bbase2 = nullptr, const int nk1 = 0, char* img = nullptr) {
    f32x4 rb[8];
#define G_LOADB(kt) do { const char* bk_ = Bbase + (size_t)(kt) * 64 * ldbB; \
        _Pragma("unroll") for (int k_ = 0; k_ < 8; ++k_) rb[k_] = *(const f32x4*)(bk_ + (size_t)k_ * ldbB + boffb); } while (0)
#pragma unroll
    for (int i = 0; i < 4; ++i) glds16(Abase + aoffb[i], lds + (4 * wave + i) * 1024);
    G_LOADB(0);
    { char* sn = lds; char* imgk = img; const int bw0_ = g.b_w0; G_WRB(sn, 0); G_WRB(sn, 1); G_WRB(sn, 2); G_WRB(sn, 3); }
    G_LOADB(1);
    for (int kt = 0; kt < nk - 2; ++kt) gemm_step<TWO_SEG, true, true, IMG>(acc, lds, g, wave, rb, kt, Abase, aoffb, Bbase, boffb, ldbB, Abase2, Bbase2, nk1, img);
    gemm_step<TWO_SEG, true, false, IMG>(acc, lds, g, wave, rb, nk - 2, Abase, aoffb, Bbase, boffb, ldbB, Abase2, Bbase2, nk1, img);
    gemm_step<TWO_SEG, false, false, IMG>(acc, lds, g, wave, rb, nk - 1, Abase, aoffb, Bbase, boffb, ldbB, Abase2, Bbase2, nk1, img);
    __syncthreads();
#undef G_LOADB
}

#define R_MMJ(AF, BF, jh, j) do { _Pragma("unroll") for (int i_ = 0; i_ < 4; ++i_) \
        acc[i_][(jh) * 4 + (j)] = __builtin_amdgcn_mfma_f32_16x16x32_bf16(BF[j], AF[i_], acc[i_][(jh) * 4 + (j)], 0, 0, 0); } while (0)
#define R_SB() __builtin_amdgcn_sched_barrier(0)
#define R_MMI(AF, BF, i) do { _Pragma("unroll") for (int j_ = 0; j_ < 4; ++j_) \
        acc[i][4 + j_] = __builtin_amdgcn_mfma_f32_16x16x32_bf16(BF[j_], AF[i], acc[i][4 + j_], 0, 0, 0); } while (0)
__device__ __forceinline__ void gemm_accum_ring(f32x4 (&acc)[4][8], char* lds, const GemmThread& g, const int wave, const int lane,
                                                const char* Abase, const unsigned (&aoffb)[2], const char* Bimg, const int nk) {
    const unsigned boffl = (unsigned)wave * 2048u + (unsigned)lane * 16u;
    const int NS = 2 * nk;
    const int saoff = g.rfr + (64 * g.wm) * 64, sboff = 16384 + g.rfr + (128 * g.wn) * 64;
#pragma unroll
    for (int s = 0; s < 4; ++s) { char* sd = lds + s * 32768 + wave * 2048; const char* ak = Abase + (size_t)s * 64; const char* bk = Bimg + (size_t)s * 16384 + boffl;
        glds16(ak + aoffb[0], sd); glds16(bk, sd + 16384); glds16(ak + aoffb[1], sd + 1024); glds16(bk + 1024, sd + 16384 + 1024); }
    asm volatile("s_waitcnt vmcnt(12)" ::: "memory");
    __builtin_amdgcn_s_barrier();
    asm volatile("" ::: "memory");
    bf16x8 a0[4], b0[4], b1[4];
#pragma unroll
    for (int i = 0; i < 4; ++i) a0[i] = *(const bf16x8*)(lds + saoff + i * 1024);
#pragma unroll
    for (int j = 0; j < 4; ++j) b0[j] = *(const bf16x8*)(lds + sboff + j * 1024);
#pragma unroll
    for (int j = 0; j < 4; ++j) b1[j] = *(const bf16x8*)(lds + sboff + (4 + j) * 1024);
#pragma unroll 1
    for (int s = 0; s < NS; ++s) {
        R_MMJ(a0, b0, 0, 0); R_MMJ(a0, b0, 0, 1); R_MMJ(a0, b0, 0, 2); R_MMJ(a0, b0, 0, 3);
        R_SB();
        asm volatile("s_waitcnt vmcnt(8)" ::: "memory");
        asm volatile("s_waitcnt lgkmcnt(0)" ::: "memory");
        __builtin_amdgcn_s_barrier();
        asm volatile("" ::: "memory");
        const bool ld = s + 4 < NS;
        const char* sn = lds + ((s + 1) & 3) * 32768;
        char* sd = lds + (s & 3) * 32768 + wave * 2048;
        const char* ak = Abase + (size_t)(s + 4) * 64; const char* bk = Bimg + (size_t)(s + 4) * 16384 + boffl;
        const char* p0 = ld ? ak + aoffb[0] : Bimg; const char* p1 = ld ? bk : Bimg; const char* p2 = ld ? ak + aoffb[1] : Bimg; const char* p3 = ld ? bk + 1024 : Bimg;
#pragma unroll
        for (int j = 0; j < 4; ++j) b0[j] = *(const bf16x8*)(sn + sboff + j * 1024);
        glds16(p0, sd); R_SB();
        R_MMI(a0, b1, 0); R_SB();
        a0[0] = *(const bf16x8*)(sn + saoff); glds16(p1, sd + 16384); R_SB();
        R_MMI(a0, b1, 1); R_SB();
        a0[1] = *(const bf16x8*)(sn + saoff + 1024); glds16(p2, sd + 1024); R_SB();
        R_MMI(a0, b1, 2); R_SB();
        a0[2] = *(const bf16x8*)(sn + saoff + 2048); glds16(p3, sd + 16384 + 1024); R_SB();
        R_MMI(a0, b1, 3); R_SB();
        a0[3] = *(const bf16x8*)(sn + saoff + 3072);
#pragma unroll
        for (int j = 0; j < 4; ++j) b1[j] = *(const bf16x8*)(sn + sboff + (4 + j) * 1024);
        R_SB();
    }
    __syncthreads();
}

typedef long f8x8;
__device__ __forceinline__ unsigned cvt4_fp8(float a, float b, float c, float d) {
    unsigned w = 0; w = __builtin_amdgcn_cvt_pk_fp8_f32(a, b, w, false); w = __builtin_amdgcn_cvt_pk_fp8_f32(c, d, w, true); return w;
}
#define F8_RA(AF, off) _Pragma("unroll") for (int i_ = 0; i_ < 4; ++i_) AF[i_] = *(const f8x8*)(sa + (off) + i_ * 1024);
#define F8_RB(BF, off) _Pragma("unroll") for (int j_ = 0; j_ < 8; ++j_) BF[j_] = *(const f8x8*)(sbb + (off) + j_ * 1024);
#define F8_MMJ(AF, BF, j) do { _Pragma("unroll") for (int i_ = 0; i_ < 4; ++i_) \
        acc[i_][j] = __builtin_amdgcn_mfma_f32_16x16x32_fp8_fp8(BF[j], AF[i_], acc[i_][j], 0, 0, 0); } while (0)
template <int WAITN, bool LD>
__device__ __forceinline__ void f8_ring_step(f32x4 (&acc)[4][8], char* lds, const GemmThread& g, const int wave, const int s,
                                             const char* Abase, const unsigned (&aoffb)[2], const char* Bimg, const unsigned boffl) {
    if (WAITN == 8) asm volatile("s_waitcnt vmcnt(8)" ::: "memory"); else if (WAITN == 4) asm volatile("s_waitcnt vmcnt(4)" ::: "memory"); else asm volatile("s_waitcnt vmcnt(0)" ::: "memory");
    asm volatile("s_waitcnt lgkmcnt(0)" ::: "memory");
    __builtin_amdgcn_s_barrier();
    asm volatile("" ::: "memory");
    const char* sa = lds + (s & 3) * 32768 + (64 * g.wm) * 64; const char* sbb = lds + (s & 3) * 32768 + 16384 + (128 * g.wn) * 64;
    char* sd = lds + ((s + 3) & 3) * 32768 + wave * 2048;
    const char* ak = Abase + (size_t)(s + 3) * 64; const char* bk = Bimg + (size_t)(s + 3) * 16384 + boffl;
    f8x8 a0[4], b0[8], a1[4], b1[8];
    F8_RA(a0, g.f8r0) F8_RB(b0, g.f8r0)
    R_SB();
    F8_MMJ(a0, b0, 0); R_SB(); if (LD) glds16(ak + aoffb[0], sd); R_SB();
    F8_MMJ(a0, b0, 1); R_SB(); if (LD) glds16(bk, sd + 16384); R_SB();
    F8_MMJ(a0, b0, 2); R_SB(); if (LD) glds16(ak + aoffb[1], sd + 1024); R_SB();
    F8_MMJ(a0, b0, 3); R_SB(); if (LD) glds16(bk + 1024, sd + 16384 + 1024); R_SB();
    F8_RA(a1, g.f8r1) F8_RB(b1, g.f8r1)
    R_SB();
    F8_MMJ(a0, b0, 4); F8_MMJ(a0, b0, 5); F8_MMJ(a0, b0, 6); F8_MMJ(a0, b0, 7);
    R_SB();
    F8_MMJ(a1, b1, 0); F8_MMJ(a1, b1, 1); F8_MMJ(a1, b1, 2); F8_MMJ(a1, b1, 3); F8_MMJ(a1, b1, 4); F8_MMJ(a1, b1, 5); F8_MMJ(a1, b1, 6); F8_MMJ(a1, b1, 7);
}
__device__ __forceinline__ void f8_accum_ring(f32x4 (&acc)[4][8], char* lds, const GemmThread& g, const int wave, const int lane,
                                              const char* Abase, const unsigned (&aoffb)[2], const char* Bimg, const int nk) {
    const unsigned boffl = (unsigned)wave * 2048u + (unsigned)lane * 16u;
#pragma unroll
    for (int s = 0; s < 3; ++s) { char* sd = lds + s * 32768 + wave * 2048; const char* ak = Abase + (size_t)s * 64; const char* bk = Bimg + (size_t)s * 16384 + boffl;
        glds16(ak + aoffb[0], sd); glds16(bk, sd + 16384); glds16(ak + aoffb[1], sd + 1024); glds16(bk + 1024, sd + 16384 + 1024); }
    for (int s = 0; s < nk - 3; ++s) f8_ring_step<8, true>(acc, lds, g, wave, s, Abase, aoffb, Bimg, boffl);
    f8_ring_step<8, false>(acc, lds, g, wave, nk - 3, Abase, aoffb, Bimg, boffl);
    f8_ring_step<4, false>(acc, lds, g, wave, nk - 2, Abase, aoffb, Bimg, boffl);
    f8_ring_step<0, false>(acc, lds, g, wave, nk - 1, Abase, aoffb, Bimg, boffl);
    __syncthreads();
}
typedef int i32x8 __attribute__((ext_vector_type(8)));
typedef int i32x4 __attribute__((ext_vector_type(4)));
__device__ __forceinline__ i32x8 s8_frag(const char* p0, const char* p1) {
    const i32x4 lo = *(const i32x4*)p0, hi = *(const i32x4*)p1;
    return __builtin_shufflevector(lo, hi, 0, 1, 2, 3, 4, 5, 6, 7);
}
#define S8_MM(i, j) acc[i][j] = __builtin_amdgcn_mfma_scale_f32_32x32x64_f8f6f4(bf[j], af[i], acc[i][j], 0, 0, 0, 0x7F7F7F7F, 0, 0x7F7F7F7F)
#define S8_FR(base) s8_frag((base) + g.s8r0, (base) + g.s8r1)
__device__ __forceinline__ void s8_accum_ring(f32x16 (&acc)[2][4], char* lds, const GemmThread& g, const int wave, const int lane,
                                              const char* Abase, const unsigned (&aoffb)[2], const char* Bimg, const int nk, const unsigned astr = 64) {
    const unsigned boffl = (unsigned)wave * 2048u + (unsigned)lane * 16u;
    const int saoff = (64 * g.wm) * 64, sboff = 16384 + (128 * g.wn) * 64;
#pragma unroll
    for (int s = 0; s < 4; ++s) { char* sd = lds + s * 32768 + wave * 2048; const char* ak = sgpr_ptr(Abase + (size_t)s * astr); const char* bk = sgpr_ptr(Bimg + (size_t)s * 16384);
        glds16(ak + aoffb[0], sd); glds16(bk + boffl, sd + 16384); glds16(ak + aoffb[1], sd + 1024); glds16(bk + (boffl + 1024u), sd + 16384 + 1024); }
    asm volatile("s_waitcnt vmcnt(12)" ::: "memory");
    __builtin_amdgcn_s_barrier();
    asm volatile("" ::: "memory");
    i32x8 af[2], bf[4];
    af[0] = S8_FR(lds + saoff);
#pragma unroll
    for (int j = 0; j < 4; ++j) bf[j] = S8_FR(lds + sboff + j * 2048);
    af[1] = S8_FR(lds + saoff + 2048);
#pragma unroll 1
    for (int s = 0; s < nk; ++s) {
        S8_MM(0, 0); S8_MM(0, 1); S8_MM(0, 2); S8_MM(0, 3);
        R_SB();
        asm volatile("s_waitcnt vmcnt(8)" ::: "memory");
        asm volatile("s_waitcnt lgkmcnt(0)" ::: "memory");
        __builtin_amdgcn_s_barrier();
        asm volatile("" ::: "memory");
        const bool ld = s + 4 < nk;
        const char* sn = lds + ((s + 1) & 3) * 32768;
        char* sd = lds + (s & 3) * 32768 + wave * 2048;
        const char* ak = sgpr_ptr(ld ? Abase + (size_t)(s + 4) * astr : Bimg); const char* bk = sgpr_ptr(ld ? Bimg + (size_t)(s + 4) * 16384 : Bimg);
        const char* p0 = ak + (ld ? aoffb[0] : 0u); const char* p1 = bk + (ld ? boffl : 0u); const char* p2 = ak + (ld ? aoffb[1] : 0u); const char* p3 = bk + (ld ? boffl + 1024u : 0u);
        af[0] = S8_FR(sn + saoff); glds16(p0, sd); R_SB();
        S8_MM(1, 0); R_SB();
        bf[0] = S8_FR(sn + sboff); glds16(p1, sd + 16384); R_SB();
        S8_MM(1, 1); R_SB();
        bf[1] = S8_FR(sn + sboff + 2048); glds16(p2, sd + 1024); R_SB();
        S8_MM(1, 2); R_SB();
        bf[2] = S8_FR(sn + sboff + 4096); glds16(p3, sd + 16384 + 1024); R_SB();
        S8_MM(1, 3); R_SB();
        bf[3] = S8_FR(sn + sboff + 6144); af[1] = S8_FR(sn + saoff + 2048); R_SB();
    }
    __syncthreads();
}
#define F8_WRB(sn, j_) do { u32x2 w_; \
        w_[0] = cvt4_fp8(rb[0][j_] * FP8_SW, rb[1][j_] * FP8_SW, rb[2][j_] * FP8_SW, rb[3][j_] * FP8_SW); \
        w_[1] = cvt4_fp8(rb[4][j_] * FP8_SW, rb[5][j_] * FP8_SW, rb[6][j_] * FP8_SW, rb[7][j_] * FP8_SW); \
        *(u32x2*)((sn) + 16384 + bw8_ + (j_) * 64) = w_; *(u32x2*)(imgk + bw8_ + (j_) * 64) = w_; } while (0)
template <bool WR, bool LD, bool W8>
__device__ __forceinline__ void f8_w32_step(f32x4 (&acc)[4][8], char* lds, const GemmThread& g, const int wave, f32x4 (&rb)[8], const int kt,
                                            const char* Abase, const unsigned (&aoffb)[2], const char* Bbase, const unsigned boffb, const int ldbB, char* img, const unsigned astr) {
    if (W8) asm volatile("s_waitcnt vmcnt(8)" ::: "memory"); else asm volatile("s_waitcnt vmcnt(0)" ::: "memory");
    asm volatile("s_waitcnt lgkmcnt(0)" ::: "memory");
    __builtin_amdgcn_s_barrier();
    asm volatile("" ::: "memory");
    const char* sa = lds + (kt & 1) * 32768 + (64 * g.wm) * 64; const char* sbb = lds + (kt & 1) * 32768 + 16384 + (128 * g.wn) * 64;
    char* sn = lds + ((kt + 1) & 1) * 32768; char* imgk = img + (size_t)(kt + 1) * 16384;
    if (WR) { const char* ak = Abase + (size_t)(kt + 1) * astr; glds16(ak + aoffb[0], sn + (2 * wave) * 1024); glds16(ak + aoffb[1], sn + (2 * wave + 1) * 1024); }
    int bw8_ = g.f8w0; asm volatile("" : "+v"(bw8_));
    f8x8 a0[4], b0[8];
    F8_RA(a0, g.f8r0) F8_RB(b0, g.f8r0)
    F8_MMJ(a0, b0, 0); F8_MMJ(a0, b0, 1); F8_MMJ(a0, b0, 2); F8_MMJ(a0, b0, 3);
    if (WR) { F8_WRB(sn, 0); F8_WRB(sn, 1); }
    __builtin_amdgcn_sched_barrier(0);
    F8_MMJ(a0, b0, 4); F8_MMJ(a0, b0, 5); F8_MMJ(a0, b0, 6); F8_MMJ(a0, b0, 7);
    if (WR) { F8_WRB(sn, 2); F8_WRB(sn, 3); }
    if (LD) { const char* bk = Bbase + (size_t)(kt + 3) * 64 * ldbB;
#pragma unroll
        for (int k = 0; k < 8; ++k) rb[k] = __builtin_nontemporal_load((const f32x4*)(sgpr_ptr(bk + (size_t)k * ldbB) + boffb)); }
    __builtin_amdgcn_sched_barrier(0);
    F8_RA(a0, g.f8r1) F8_RB(b0, g.f8r1)
    F8_MMJ(a0, b0, 0); F8_MMJ(a0, b0, 1); F8_MMJ(a0, b0, 2); F8_MMJ(a0, b0, 3);
    __builtin_amdgcn_sched_barrier(0);
    F8_MMJ(a0, b0, 4); F8_MMJ(a0, b0, 5); F8_MMJ(a0, b0, 6); F8_MMJ(a0, b0, 7);
}
__device__ __forceinline__ void f8_accum_w32(f32x4 (&acc)[4][8], char* lds, const GemmThread& g, const int wave,
                                             const char* Abase, const unsigned (&aoffb)[2], const char* Bbase, const unsigned boffb, const int ldbB, const int nk, char* img, const unsigned astr = 64) {
    f32x4 rbA[8], rbB[8];
#define F8_LOADB(RB, kt) do { const char* bk_ = Bbase + (size_t)(kt) * 64 * ldbB; \
        _Pragma("unroll") for (int k_ = 0; k_ < 8; ++k_) RB[k_] = __builtin_nontemporal_load((const f32x4*)(sgpr_ptr(bk_ + (size_t)k_ * ldbB) + boffb)); } while (0)
    glds16(Abase + aoffb[0], lds + (2 * wave) * 1024); glds16(Abase + aoffb[1], lds + (2 * wave + 1) * 1024);
    F8_LOADB(rbA, 0);
    { f32x4 (&rb)[8] = rbA; char* sn = lds; char* imgk = img; const int bw8_ = g.f8w0; F8_WRB(sn, 0); F8_WRB(sn, 1); F8_WRB(sn, 2); F8_WRB(sn, 3); }
    F8_LOADB(rbA, 1);
    F8_LOADB(rbB, 2);
#pragma unroll 1
    for (int kt = 0; kt < nk - 4; kt += 2) {
        f8_w32_step<true, true, true>(acc, lds, g, wave, rbA, kt, Abase, aoffb, Bbase, boffb, ldbB, img, astr);
        f8_w32_step<true, true, true>(acc, lds, g, wave, rbB, kt + 1, Abase, aoffb, Bbase, boffb, ldbB, img, astr);
    }
    f8_w32_step<true, true, true>(acc, lds, g, wave, rbA, nk - 4, Abase, aoffb, Bbase, boffb, ldbB, img, astr);
    f8_w32_step<true, false, true>(acc, lds, g, wave, rbB, nk - 3, Abase, aoffb, Bbase, boffb, ldbB, img, astr);
    f8_w32_step<true, false, false>(acc, lds, g, wave, rbA, nk - 2, Abase, aoffb, Bbase, boffb, ldbB, img, astr);
    f8_w32_step<false, false, false>(acc, lds, g, wave, rbB, nk - 1, Abase, aoffb, Bbase, boffb, ldbB, img, astr);
    __syncthreads();
#undef F8_LOADB
}

struct EpiLane { int l15, lq, wm, wn; };
__device__ __forceinline__ EpiLane epi_lane(const GemmThread& g) { EpiLane e; e.l15 = g.l15; e.lq = g.lq; e.wm = g.wm; e.wn = g.wn; asm volatile("" : "+v"(e.l15), "+v"(e.lq)); return e; }
__device__ __forceinline__ void acc_zero(f32x4 (&acc)[4][8]) {
#pragma unroll
    for (int i = 0; i < 4; ++i)
#pragma unroll
        for (int j = 0; j < 8; ++j) acc[i][j] = (f32x4){0.f, 0.f, 0.f, 0.f};
}
__device__ __forceinline__ bool patch_unit(int u, int nMt, int nNt, int& mt, int& nt) {
    const int pM = nMt / 8, p = u >> 5, q = u & 31;
    mt = (p % pM) * 8 + (q & 7); nt = (p / pM) * 4 + (q >> 3);
    return nt < nNt;
}
__device__ __forceinline__ int vcu_of_block(int bx, int G) { return (G % 8 == 0) ? (bx % 8) * (G / 8) + bx / 8 : bx; }

namespace attn {
constexpr int D = 128, NW = 8, QBLK = 32, KVBLK = 64;
constexpr float SCALE = 0.088388347648318440f;
constexpr float THR = 8.f;
constexpr int LDQ = AW, LDK = KVW, LDO = DM;
constexpr size_t SHM_V = KVBLK * D * 2, SHM_K = KVBLK * D * 2, SHM_ATTN = 2 * SHM_V + 2 * SHM_K + NW * 64 * 4;
#define KSWZ(row, colB) ((row) * 256 + ((colB) ^ (((row) & 7) << 4)))
#define SBAR() __builtin_amdgcn_sched_barrier(0)
__device__ __forceinline__ int crow(int r, int hi) { return (r & 3) + 8 * (r >> 2) + 4 * hi; }
__device__ __forceinline__ unsigned cvtpk(float lo, float hi) { return cvt_pk_bf16(lo, hi); }

__device__ __forceinline__ void partialSM(f32x16& p0, f32x16& p1, float& m_reg, float& mn, float& alpha) {
  constexpr float C = SCALE * 1.4426950408889634f;
  float pmax = p0[0]; for (int r = 1; r < 16; ++r) pmax = fmaxf(pmax, p0[r]); for (int r = 0; r < 16; ++r) pmax = fmaxf(pmax, p1[r]);
  { auto rr = __builtin_amdgcn_permlane32_swap(__float_as_uint(pmax), __float_as_uint(pmax), false, false);
    pmax = fmaxf(__uint_as_float(rr[0]), __uint_as_float(rr[1])); }
  if (__builtin_expect(__all(pmax - m_reg <= THR / SCALE), 1)) { mn = m_reg; alpha = 1.f; }
  else { mn = fmaxf(m_reg, pmax); alpha = __builtin_amdgcn_exp2f((m_reg - mn) * C); m_reg = mn; }
  float mnC = -mn * C;
  for (int r = 0; r < 16; ++r) p0[r] = fmaf(p0[r], C, mnC); for (int r = 0; r < 16; ++r) p1[r] = fmaf(p1[r], C, mnC);
  for (int r = 0; r < 16; ++r) p0[r] = __builtin_amdgcn_exp2f(p0[r]);
}
__device__ __forceinline__ void finishSM(f32x16& p0, f32x16& p1, float alpha, float& l_reg, bf16x8& pa0, bf16x8& pa1, bf16x8& pa2, bf16x8& pa3) {
  for (int r = 0; r < 16; ++r) p1[r] = __builtin_amdgcn_exp2f(p1[r]);
  float ps = 0; for (int r = 0; r < 16; ++r) ps += p0[r]; for (int r = 0; r < 16; ++r) ps += p1[r];
  { auto rr = __builtin_amdgcn_permlane32_swap(__float_as_uint(ps), __float_as_uint(ps), false, false);
    ps = __uint_as_float(rr[0]) + __uint_as_float(rr[1]); }
  l_reg = l_reg * alpha + ps;
#define PK4(P, BASE, OUT) do { unsigned a0 = cvtpk(P[BASE + 0], P[BASE + 1]), a1 = cvtpk(P[BASE + 2], P[BASE + 3]);   \
    unsigned b0 = cvtpk(P[BASE + 4], P[BASE + 5]), b1 = cvtpk(P[BASE + 6], P[BASE + 7]);                              \
    auto r0 = __builtin_amdgcn_permlane32_swap(a0, b0, false, false); auto r1 = __builtin_amdgcn_permlane32_swap(a1, b1, false, false); \
    u32x4 w = {r0[0], r1[0], r0[1], r1[1]}; OUT = *reinterpret_cast<bf16x8*>(&w); } while (0)
  PK4(p0, 0, pa0); PK4(p0, 8, pa1); PK4(p1, 0, pa2); PK4(p1, 8, pa3);
#undef PK4
}
__device__ __forceinline__ void qkt(f32x16& p0, f32x16& p1, const bf16_t* Ks, const bf16x8* qr, int r32, int hi) {
  p0 = f32x16{}; p1 = f32x16{};
  for (int d0 = 0; d0 < 8; ++d0) { int cb = (d0 * 16 + hi * 8) * 2;
    bf16x8 b0 = *reinterpret_cast<const bf16x8*>((const char*)Ks + KSWZ(r32, cb));
    bf16x8 b1 = *reinterpret_cast<const bf16x8*>((const char*)Ks + KSWZ(32 + r32, cb));
    p0 = __builtin_amdgcn_mfma_f32_32x32x16_bf16(b0, qr[d0], p0, 0, 0, 0);
    p1 = __builtin_amdgcn_mfma_f32_32x32x16_bf16(b1, qr[d0], p1, 0, 0, 0); }
}
__device__ __forceinline__ int v_st(int k, int c) { const int kk = (k & ~0xC) | ((k & 4) << 1) | ((k & 8) >> 1); return ((kk >> 3) * 4 + (c >> 5)) * 512 + ((kk & 7) * 32 + (c & 31)) * 2; }
__device__ __forceinline__ int v_rd_base(int lane) { return ((lane & 3) << 3) | (((lane >> 2) & 3) << 6) | (((lane >> 4) & 1) << 5) | (((lane >> 5) & 1) << 8); }
constexpr int v_rd_off(int d0, int ks, int half) { return d0 * 512 + ks * 4096 + half * 2048; }
template <int OFF> __device__ __forceinline__ s16x4 tr_read(int vb) {
  s16x4 r; asm volatile("ds_read_b64_tr_b16 %0, %1 offset:%2" : "=&v"(r) : "v"(vb), "i"(OFF) : "memory"); return r;
}
template <int D0> __device__ __forceinline__ void pv_one(f32x16& od, int vb, bf16x8 pa0, bf16x8 pa1, bf16x8 pa2, bf16x8 pa3) {
  const s16x4 l0 = tr_read<v_rd_off(D0, 0, 0)>(vb), h0 = tr_read<v_rd_off(D0, 0, 1)>(vb), l1 = tr_read<v_rd_off(D0, 1, 0)>(vb), h1 = tr_read<v_rd_off(D0, 1, 1)>(vb);
  const s16x4 l2 = tr_read<v_rd_off(D0, 2, 0)>(vb), h2 = tr_read<v_rd_off(D0, 2, 1)>(vb), l3 = tr_read<v_rd_off(D0, 3, 0)>(vb), h3 = tr_read<v_rd_off(D0, 3, 1)>(vb);
  asm volatile("s_waitcnt lgkmcnt(0)" ::: "memory"); SBAR();
#define PK(L, H) (bf16x8){L[0], L[1], L[2], L[3], H[0], H[1], H[2], H[3]}
  od = __builtin_amdgcn_mfma_f32_32x32x16_bf16(pa0, PK(l0, h0), od, 0, 0, 0);
  od = __builtin_amdgcn_mfma_f32_32x32x16_bf16(pa1, PK(l1, h1), od, 0, 0, 0);
  od = __builtin_amdgcn_mfma_f32_32x32x16_bf16(pa2, PK(l2, h2), od, 0, 0, 0);
  od = __builtin_amdgcn_mfma_f32_32x32x16_bf16(pa3, PK(l3, h3), od, 0, 0, 0);
#undef PK
}
__device__ __forceinline__ void pv_d0(f32x16* o, int vb, bf16x8 pa0, bf16x8 pa1, bf16x8 pa2, bf16x8 pa3) {
  pv_one<0>(o[0], vb, pa0, pa1, pa2, pa3); pv_one<1>(o[1], vb, pa0, pa1, pa2, pa3); pv_one<2>(o[2], vb, pa0, pa1, pa2, pa3); pv_one<3>(o[3], vb, pa0, pa1, pa2, pa3);
}
__device__ __forceinline__ void attn_dense_body(const bf16_t* __restrict__ Qb, const bf16_t* __restrict__ Kh, const bf16_t* __restrict__ Vh, bf16_t* __restrict__ Ob, int seq, char* lds) {
  const int tid = threadIdx.x, wid = tid >> 6, lane = tid & 63, r32 = lane & 31, hi = lane >> 5;
  bf16_t* V_lds = (bf16_t*)lds; bf16_t* K_lds = (bf16_t*)(lds + 2 * SHM_V);
  float* ws = (float*)(lds + 2 * SHM_V + 2 * SHM_K) + wid * 64; float* li_l = ws; float* al_l = ws + 32;
  float m_reg = -1e30f, l_reg = 0; f32x16 o[4] = {}; bf16x8 qr[8];
  const bf16_t* Qw = Qb + (long)(wid * QBLK + r32) * LDQ + hi * 8;
#pragma unroll
  for (int d0 = 0; d0 < 8; ++d0) qr[d0] = *reinterpret_cast<const bf16x8*>(Qw + d0 * 16);
  const int sr = tid >> 4, sc = (tid & 15) * 8, vst0 = v_st(sr, sc), vst1 = v_st(32 + sr, sc);
  const int vb0 = (int)(uintptr_t)V_lds + v_rd_base(lane);
  struct { bf16x8 vs0, vs1, ks0, ks1; } sr_[2];
#define LD8(p) (*reinterpret_cast<const bf16x8*>(p))
#define SLOAD(i, k0) do { sr_[i].vs0 = LD8(&Vh[(long)((k0) + sr) * LDK + sc]); sr_[i].vs1 = LD8(&Vh[(long)((k0) + 32 + sr) * LDK + sc]); \
    sr_[i].ks0 = LD8(&Kh[(long)((k0) + sr) * LDK + sc]); sr_[i].ks1 = LD8(&Kh[(long)((k0) + 32 + sr) * LDK + sc]); } while (0)
#define SWRITE(b, i) do { *(bf16x8*)((char*)V_lds + (b) * SHM_V + vst0) = sr_[i].vs0;          \
    *(bf16x8*)((char*)V_lds + (b) * SHM_V + vst1) = sr_[i].vs1; int kc = sc * 2;               \
    *(bf16x8*)((char*)K_lds + (b) * SHM_K + KSWZ(sr, kc)) = sr_[i].ks0;                       \
    *(bf16x8*)((char*)K_lds + (b) * SHM_K + KSWZ(32 + sr, kc)) = sr_[i].ks1; } while (0)
#define SWAIT() do { asm volatile("s_waitcnt vmcnt(4)" ::: "memory"); } while (0)
#define RESC(a) do { if (__any((a) < 1.f)) { if (hi == 0) al_l[r32] = (a); asm volatile("s_waitcnt lgkmcnt(0)" ::: "memory"); \
    for (int d = 0; d < 4; ++d) for (int r = 0; r < 16; ++r) o[d][r] *= al_l[crow(r, hi)]; } } while (0)
  f32x16 pA0, pA1, pB0, pB1; float mnA, mnB, alA, alB; bf16x8 pa0, pa1, pa2, pa3; const int NT = seq / KVBLK;
  constexpr int SE = 0, SO = 1;
  SLOAD(SE, 0); asm volatile("s_waitcnt vmcnt(0)" ::: "memory"); SWRITE(0, SE); __syncthreads();
  qkt(pA0, pA1, K_lds, qr, r32, hi); partialSM(pA0, pA1, m_reg, mnA, alA);
  SLOAD(SO, KVBLK); if (2 < NT) SLOAD(SE, 2 * KVBLK);
  SWAIT(); SWRITE(1, SO); __syncthreads();
  for (int j = 1; j + 1 < NT; j += 2) {
    SBAR(); qkt(pB0, pB1, (bf16_t*)((char*)K_lds + SHM_K), qr, r32, hi);
    finishSM(pA0, pA1, alA, l_reg, pa0, pa1, pa2, pa3); SBAR();
    SLOAD(SO, (j + 2) * KVBLK); SBAR();
    pv_d0(o, vb0, pa0, pa1, pa2, pa3); partialSM(pB0, pB1, m_reg, mnB, alB);
    __syncthreads(); SWAIT(); SWRITE(0, SE);
    RESC(alB); __syncthreads();
    SBAR(); qkt(pA0, pA1, K_lds, qr, r32, hi);
    finishSM(pB0, pB1, alB, l_reg, pa0, pa1, pa2, pa3); SBAR();
    if (j + 3 < NT) SLOAD(SE, (j + 3) * KVBLK); SBAR();
    pv_d0(o, vb0 + (int)SHM_V, pa0, pa1, pa2, pa3); partialSM(pA0, pA1, m_reg, mnA, alA);
    __syncthreads(); SWAIT(); SWRITE(1, SO);
    RESC(alA); __syncthreads();
  }
  SBAR(); qkt(pB0, pB1, (bf16_t*)((char*)K_lds + SHM_K), qr, r32, hi);
  finishSM(pA0, pA1, alA, l_reg, pa0, pa1, pa2, pa3); SBAR();
  pv_d0(o, vb0, pa0, pa1, pa2, pa3); partialSM(pB0, pB1, m_reg, mnB, alB);
  __syncthreads(); RESC(alB);
  finishSM(pB0, pB1, alB, l_reg, pa0, pa1, pa2, pa3); SBAR();
  pv_d0(o, vb0 + (int)SHM_V, pa0, pa1, pa2, pa3);
  if (hi == 0) li_l[r32] = l_reg; asm volatile("s_waitcnt lgkmcnt(0)" ::: "memory");
  float rli[16];
#pragma unroll
  for (int r = 0; r < 16; ++r) rli[r] = __builtin_amdgcn_rcpf(li_l[crow(r, hi)]);
  bf16_t* Ow = Ob + (long)(wid * QBLK) * LDO;
#pragma unroll
  for (int r = 0; r < 16; ++r) { int orow = crow(r, hi);
    for (int d0 = 0; d0 < 4; ++d0) Ow[(long)orow * LDO + d0 * 32 + r32] = f2bf(o[d0][r] * rli[r]); }
#undef LD8
#undef SLOAD
#undef SWRITE
#undef SWAIT
#undef RESC
}
}

struct Frame {
    char* lds;
    const Args* a;
    int tid, lane, wave, G, bx;
    int xl, rk;
};
template <class T> __device__ __forceinline__ T* uni(T* p) {
    const unsigned long long v = (unsigned long long)p;
    const unsigned lo = __builtin_amdgcn_readfirstlane((unsigned)v), hi = __builtin_amdgcn_readfirstlane((unsigned)(v >> 32));
    typedef __attribute__((address_space(1))) T* gptr_t;
    return (T*)(gptr_t)(((unsigned long long)hi << 32) | lo);
}
#define WSB() (uni(F.a->ws))
#define WSP(T, off) ((T*)(WSB() + (off)))
#define INP(i) (uni(F.a->in[i]))

__device__ __forceinline__ float mod_at(const Frame& F, int idx) { const float* mp = WSP(const float, WS_MODP); return mp[idx] + mp[4 * 12288 + idx]; }

__device__ __forceinline__ void p0_prologue(const Frame& F) {
    const int tid = F.tid;
    const float* c = INP(1); const float* w_ada = INP(2); const float* b_ada = INP(3); const float* wf = INP(6);
    float* modp = WSP(float, WS_MODP);
    for (int item = F.bx; item < 256; item += F.G) {
        const int half = item & 1, cg = item >> 1;
        float* sc = (float*)F.lds;
        float* red = (float*)(F.lds + 16384);
        __syncthreads();
        for (int i = tid; i < 4096; i += NTHREADS) { const int b = i >> 10, k = i & 1023; const float cv = c[b * DM + half * 1024 + k]; sc[i] = cv / (1.f + __expf(-cv)); }
        __syncthreads();
        const int cq = tid % 24, kg = tid / 24;
        f32x4 am[4]; for (int b = 0; b < 4; ++b) am[b] = (f32x4){0.f, 0.f, 0.f, 0.f};
        if (kg < 21) {
            const float* wp = w_ada + (size_t)(half * 1024) * (NMOD * DM) + cg * 96 + cq * 4;
#pragma unroll 7
            for (int k = kg; k < 1024; k += 21) {
                const f32x4 w = *(const f32x4*)(wp + (size_t)k * (NMOD * DM));
#pragma unroll
                for (int b = 0; b < 4; ++b) am[b] += sc[b * 1024 + k] * w;
            }
#pragma unroll
            for (int b = 0; b < 4; ++b) *(f32x4*)(red + ((kg * 4 + b) * 96 + cq * 4)) = am[b];
        }
        __syncthreads();
        if (tid < 384) { const int b = tid / 96, col = tid % 96; float s = 0.f;
            for (int k2 = 0; k2 < 21; ++k2) s += red[(k2 * 4 + b) * 96 + col];
            if (half == 0) s += b_ada[cg * 96 + col];
            modp[(half * 4 + b) * 12288 + cg * 96 + col] = s; }
    }
    __syncthreads();
    {
        float* tc = (float*)F.lds; float* ts = tc + 128;
        if (tid < 128) { tc[tid] = cospif((float)tid / 64.f); ts[tid] = sinpif((float)tid / 64.f); }
        __syncthreads();
        float* g12 = WSP(float, WS_G12);
        for (int idx = F.bx * NTHREADS + tid; idx < 4 * 128 * 256; idx += F.G * NTHREADS) {
            const int g = idx >> 15, cc = (idx >> 8) & 127, j = idx & 255, part = j >> 7, d = j & 127;
            const float* tb = part ? ts : tc; const float* wp = wf + (size_t)g * 128 * 128 + d;
            float s = 0.f;
#pragma unroll 16
            for (int c2 = 0; c2 < 128; ++c2) s += tb[(cc * c2) & 127] * wp[c2 * 128];
            g12[idx] = s * (1.f / 512.f);
        }
        __syncthreads();
    }
    {
        bf16_t* cm = WSP(bf16_t, WS_CMAT);
        for (int idx = F.bx * NTHREADS + tid; idx < 2 * 2048 * 256; idx += F.G * NTHREADS) {
            const int mat = idx >> 19, s = (idx >> 8) & 2047, t0 = (idx & 255) * 8;
            float v[8];
#pragma unroll
            for (int e = 0; e < 8; ++e) { const float fr = (float)((s * (t0 + e)) & 2047) * (1.f / 2048.f);
                v[e] = mat ? -__builtin_amdgcn_sinf(fr) : __builtin_amdgcn_cosf(fr); }
            u32x4 w = {cvt_pk_bf16(v[0], v[1]), cvt_pk_bf16(v[2], v[3]), cvt_pk_bf16(v[4], v[5]), cvt_pk_bf16(v[6], v[7])};
            bf16_t* dst = cm + (size_t)s * 4096 + mat * 2048 + t0;
            *(u32x4*)dst = w;
        }
    }
    {
        const GemmThread g = gemm_thread_init();
        const float* w_in = INP(5); const float* w_out = INP(11);
        for (int t = F.bx; t < (10 + 8) * 32; t += F.G) {
            const float* srcp; char* dst; const int kt = t & 31, nt = t >> 5;
            if (nt < 10) { srcp = w_in + (size_t)(kt * 64 + 8 * g.kg) * INW + 512 + nt * 256 + 4 * g.ng; dst = (char*)(WSB() + WS_IMGIN) + (size_t)((nt + 4) * 32 + kt) * 32768; }
            else { srcp = w_out + (size_t)(kt * 64 + 8 * g.kg) * DM + (nt - 10) * 256 + 4 * g.ng; dst = (char*)(WSB() + WS_IMGOUT) + (size_t)((nt - 10) * 32 + kt) * 32768; }
            const size_t ld = nt < 10 ? INW : DM;
            f32x4 rb[8];
#pragma unroll
            for (int k = 0; k < 8; ++k) rb[k] = *(const f32x4*)(srcp + (size_t)k * ld);
#pragma unroll
            for (int j = 0; j < 4; ++j) { u32x4 w;
                w[0] = cvt_pk_bf16(rb[0][j], rb[1][j]); w[1] = cvt_pk_bf16(rb[2][j], rb[3][j]); w[2] = cvt_pk_bf16(rb[4][j], rb[5][j]); w[3] = cvt_pk_bf16(rb[6][j], rb[7][j]);
                *(u32x4*)(dst + g.imgw0 + j * 64) = w; }
        }
    }
    {
        f32x2* rp = WSP(f32x2, WS_ROPE);
        for (int idx = F.bx * NTHREADS + tid; idx < 2048 * 64; idx += F.G * NTHREADS) {
            const int s = idx >> 6, p = idx & 63, i = p & 31; const float pos = (float)(p < 32 ? (s >> 6) : (s & 63));
            const float inv = 1.0f / powf(10000.f, (float)(2 * i) / 64.f);
            float sn, cs; sincosf(pos * inv, &sn, &cs);
            rp[idx] = (f32x2){cs, sn};
        }
    }
}

__device__ __forceinline__ void p1_norm(const Frame& F) {
    const int tid = F.tid, lane = F.lane, wave = F.wave;
    const float* x = INP(0); const float* gpm = INP(4); const float* w_in = INP(5);
    bf16_t* h = WSP(bf16_t, WS_H);
    float* av = (float*)F.lds; float* sv = av + DM;
    for (int grp = F.bx; grp < NTOK / 32; grp += F.G) {
        const int row0 = grp * 32, b = row0 / SEQ;
        __syncthreads();
        for (int k = tid; k < DM; k += NTHREADS) { av[k] = gpm[k] * (1.f + mod_at(F, b * 12288 + DM + k)); sv[k] = mod_at(F, b * 12288 + k); }
        __syncthreads();
        for (int rr = 0; rr < 4; ++rr) {
            const int row = row0 + wave * 4 + rr; const float* xr = x + (size_t)row * DM;
            f32x4 xv[8]; float ss = 0.f;
#pragma unroll
            for (int i = 0; i < 8; ++i) { xv[i] = *(const f32x4*)(xr + i * 256 + lane * 4); ss += xv[i][0] * xv[i][0] + xv[i][1] * xv[i][1] + xv[i][2] * xv[i][2] + xv[i][3] * xv[i][3]; }
            ss = wave_sum(ss); const float rstd = rsqrtf(ss * (1.f / DM) + EPS);
#pragma unroll
            for (int i = 0; i < 8; ++i) { const int k = i * 256 + lane * 4; const f32x4 a4 = *(const f32x4*)(av + k), s4 = *(const f32x4*)(sv + k);
                u32x2 w = {cvt_pk_bf16(xv[i][0] * rstd * a4[0] + s4[0], xv[i][1] * rstd * a4[1] + s4[1]), cvt_pk_bf16(xv[i][2] * rstd * a4[2] + s4[2], xv[i][3] * rstd * a4[3] + s4[3])};
                *(u32x2*)(h + (size_t)row * DM + k) = w; }
        }
    }
    const float* g12 = WSP(const float, WS_G12);
    for (int item = F.bx * 8 + wave; item < 2048; item += F.G * 8) {
        const int ntile = item & 63, mgrp = item >> 6, l15 = lane & 15, lq = lane >> 4;
        const int n = ntile * 16 + l15, half = n >> 9, g = (n >> 7) & 3, j = n & 127;
        const float* gp = g12 + (size_t)g * 128 * 256 + half * 128 + j + (size_t)(8 * lq) * 256;
        bf16x8 yh[4], yl[4];
#pragma unroll
        for (int ks = 0; ks < 4; ++ks) {
            float v[8];
#pragma unroll
            for (int q = 0; q < 8; ++q) v[q] = gp[(size_t)(ks * 32 + q) * 256];
            u32x4 h, l;
#pragma unroll
            for (int q = 0; q < 4; ++q) { h[q] = cvt_pk_bf16(v[2 * q], v[2 * q + 1]); l[q] = cvt_pk_bf16(v[2 * q] - bflo(h[q]), v[2 * q + 1] - bfhi(h[q])); }
            yh[ks] = __builtin_bit_cast(bf16x8, h); yl[ks] = __builtin_bit_cast(bf16x8, l);
        }
#pragma unroll 1
        for (int mi = 0; mi < 4; ++mi) {
            const int m0 = (mgrp * 4 + mi) * 16;
            const float* wp = w_in + (size_t)(m0 + l15) * INW + g * 128 + 8 * lq;
            f32x4 xv[4][2];
#pragma unroll
            for (int ks = 0; ks < 4; ++ks) { xv[ks][0] = *(const f32x4*)(wp + ks * 32); xv[ks][1] = *(const f32x4*)(wp + ks * 32 + 4); }
            f32x4 d = {0.f, 0.f, 0.f, 0.f};
#pragma unroll
            for (int ks = 0; ks < 4; ++ks) {
                u32x4 h, l;
#pragma unroll
                for (int q = 0; q < 2; ++q) {
                    h[2 * q] = cvt_pk_bf16(xv[ks][q][0], xv[ks][q][1]); h[2 * q + 1] = cvt_pk_bf16(xv[ks][q][2], xv[ks][q][3]);
                    l[2 * q] = cvt_pk_bf16(xv[ks][q][0] - bflo(h[2 * q]), xv[ks][q][1] - bfhi(h[2 * q])); l[2 * q + 1] = cvt_pk_bf16(xv[ks][q][2] - bflo(h[2 * q + 1]), xv[ks][q][3] - bfhi(h[2 * q + 1]));
                }
                const bf16x8 xh = __builtin_bit_cast(bf16x8, h), xl = __builtin_bit_cast(bf16x8, l);
                d = __builtin_amdgcn_mfma_f32_16x16x32_bf16(xh, yh[ks], d, 0, 0, 0);
                d = __builtin_amdgcn_mfma_f32_16x16x32_bf16(xh, yl[ks], d, 0, 0, 0);
                d = __builtin_amdgcn_mfma_f32_16x16x32_bf16(xl, yh[ks], d, 0, 0, 0);
            }
            const int k = m0 + 4 * lq, nt = n >> 8, brow = n & 255, kt = k >> 6, chunk = (k & 63) >> 3;
            u32x2 w = {cvt_pk_bf16(d[0], d[1]), cvt_pk_bf16(d[2], d[3])};
            *(u32x2*)((char*)(WSB() + WS_IMGIN) + (size_t)(nt * 32 + kt) * 32768 + (chunk >> 2) * 16384 + brow * 64 + ((((brow >> 2) & 3) ^ sw4(chunk & 3)) << 4) + (k & 4) * 2) = w;
        }
    }
}

__device__ __forceinline__ void p2_inproj(const Frame& F) {
    const GemmThread g = gemm_thread_init();
    const bf16_t* h = WSP(const bf16_t, WS_H);
    const float* qg = INP(7); const float* kgn = INP(8);
    const f32x2* rope = WSP(const f32x2, WS_ROPE);
    const int vcu = (F.G & 7) ? F.bx : F.xl * (F.G >> 3) + F.rk;
    for (int u = vcu; u < 512; u += F.G) {
        int mt, nt; if (!patch_unit(u, 32, 14, mt, nt)) continue;
        f32x4 acc[4][8]; acc_zero(acc);
        unsigned aoff[2];
#pragma unroll
        for (int i = 0; i < 2; ++i) aoff[i] = (unsigned)(g.rrow0 + 16 * i) * (DM * 2u) + g.rchunk;
        const char* ab = (const char*)(h + (size_t)mt * 256 * DM);
        gemm_accum_ring(acc, F.lds, g, F.wave, F.lane, ab, aoff, (const char*)(WSB() + WS_IMGIN) + (size_t)(nt * 32) * 32768, DM / 64);
        const EpiLane el = epi_lane(g);
        if (nt < 4) {
            bf16_t* img = (bf16_t*)((char*)(WSB() + WS_IMGZ) + (size_t)((((mt >> 3) * 2 + (nt & 1)) * 64) + (nt >> 1) * 32 + (mt & 7) * 4 + el.wm) * 32768);
#pragma unroll
            for (int i = 0; i < 4; ++i) { const int kk = 16 * i + el.l15, chunk = kk >> 3, ke = kk & 7;
#pragma unroll
                for (int j = 0; j < 8; ++j)
#pragma unroll
                    for (int r = 0; r < 4; ++r) { const int n = 128 * el.wn + 16 * j + 4 * el.lq + r;
                        img[(chunk >> 2) * 8192 + n * 32 + ((((n >> 2) & 3) ^ sw4(chunk & 3)) << 3) + ke] = f2bf(acc[i][j][r]); } }
        } else if (nt < 12) {
            const bool isq = nt < 10;
            const int head = isq ? (nt - 4) * 2 + el.wn : (nt - 10) * 2 + el.wn;
            const float* gn = isq ? qg : kgn;
            bf16_t* dstb = isq ? WSP(bf16_t, WS_Q) : WSP(bf16_t, WS_K); const int ldo = isq ? AW : KVW;
            float rstd[4];
#pragma unroll
            for (int i = 0; i < 4; ++i) {
                float ss = 0.f;
#pragma unroll
                for (int j = 0; j < 8; ++j) ss += acc[i][j][0] * acc[i][j][0] + acc[i][j][1] * acc[i][j][1] + acc[i][j][2] * acc[i][j][2] + acc[i][j][3] * acc[i][j][3];
                ss += __shfl_xor(ss, 16, 64); ss += __shfl_xor(ss, 32, 64);
                rstd[i] = rsqrtf(ss * (1.f / 128.f) + EPS);
            }
#pragma unroll
            for (int j = 0; j < 8; ++j) {
                const int d = 16 * j + 4 * el.lq;
                asm volatile("" ::: "memory");
                const f32x4 gv = *(const f32x4*)(gn + d);
#pragma unroll
                for (int i = 0; i < 4; ++i) {
                    const int t = mt * 256 + 64 * el.wm + 16 * i + el.l15, s = t & (SEQ - 1);
                    const f32x4 cs = *(const f32x4*)(rope + (size_t)s * 64 + (d >> 1));
                    const float x0 = acc[i][j][0] * rstd[i] * gv[0], x1 = acc[i][j][1] * rstd[i] * gv[1];
                    const float x2 = acc[i][j][2] * rstd[i] * gv[2], x3 = acc[i][j][3] * rstd[i] * gv[3];
                    u32x2 w = {cvt_pk_bf16(x0 * cs[0] - x1 * cs[1], x0 * cs[1] + x1 * cs[0]), cvt_pk_bf16(x2 * cs[2] - x3 * cs[3], x2 * cs[3] + x3 * cs[2])};
                    *(u32x2*)(dstb + (size_t)t * ldo + head * 128 + d) = w;
                }
            }
        } else {
            bf16_t* vb = WSP(bf16_t, WS_V);
#pragma unroll
            for (int i = 0; i < 4; ++i) { const int t = mt * 256 + 64 * el.wm + 16 * i + el.l15;
#pragma unroll
                for (int j = 0; j < 8; ++j) { const int col = (nt - 12) * 256 + 128 * el.wn + 16 * j + 4 * el.lq;
                    u32x2 w = {cvt_pk_bf16(acc[i][j][0], acc[i][j][1]), cvt_pk_bf16(acc[i][j][2], acc[i][j][3])};
                    *(u32x2*)(vb + (size_t)t * KVW + col) = w; } }
        }
    }
}

__device__ __forceinline__ void p3_dft_unit(const Frame& F, const GemmThread& g, int du) {
    const int mt = du & 7, nt = du >> 3, b = nt >> 1, g0 = (nt & 1) * 2;
    const bf16_t* cs = WSP(const bf16_t, WS_CMAT);
    f32x4 acc[4][8]; acc_zero(acc);
    unsigned aoff[2];
#pragma unroll
    for (int i = 0; i < 2; ++i) aoff[i] = (unsigned)(g.rrow0 + 16 * i) * 8192u + g.rchunk;
    gemm_accum_ring(acc, F.lds, g, F.wave, F.lane, (const char*)(cs + (size_t)mt * 256 * 4096), aoff, (const char*)(WSB() + WS_IMGZ) + (size_t)(nt * 64) * 32768, 64);
    bf16_t* mrg = WSP(bf16_t, WS_MRG);
    const EpiLane el = epi_lane(g);
#pragma unroll
    for (int i = 0; i < 4; ++i) { const int t = b * SEQ + mt * 256 + 64 * el.wm + 16 * i + el.l15;
#pragma unroll
        for (int j = 0; j < 8; ++j) { const int col = g0 * 128 + 128 * el.wn + 16 * j + 4 * el.lq;
            u32x2 w = {cvt_pk_bf16(acc[i][j][0], acc[i][j][1]), cvt_pk_bf16(acc[i][j][2], acc[i][j][3])};
            *(u32x2*)(mrg + (size_t)t * DM + col) = w; } }
}
__device__ __forceinline__ void p3_attn_unit(const Frame& F, int kvh  , int sub  ) {
    const int b = kvh >> 2, kv = kvh & 3, hq = kv * 3 + sub / 8, qb = sub % 8;
    const bf16_t* q = WSP(const bf16_t, WS_Q) + (size_t)(b * SEQ + qb * 256) * AW + hq * 128;
    const bf16_t* k = WSP(const bf16_t, WS_K) + (size_t)(b * SEQ) * KVW + kv * 128;
    const bf16_t* v = WSP(const bf16_t, WS_V) + (size_t)(b * SEQ) * KVW + kv * 128;
    bf16_t* o = WSP(bf16_t, WS_MRG) + (size_t)(b * SEQ + qb * 256) * DM + FW + hq * 128;
    attn::attn_dense_body(q, k, v, o, SEQ, F.lds);
}
__device__ __forceinline__ void p3_mixers(const Frame& F) {
    const GemmThread g = gemm_thread_init();
    const bool std = (F.G == 256); const int xl = F.xl, r = F.rk;
    int na, a0, astep, nd, d0, dstep;
    if (std) { na = (r < 24) ? 2 : 0; a0 = xl * 24 + r; astep = 8 * 24; nd = (r < 24) ? 0 : 1; d0 = xl * 8 + (r - 24); dstep = 1; }
    else { na = (384 - F.bx + F.G - 1) / F.G; if (F.bx >= 384) na = 0; a0 = F.bx; astep = F.G; nd = (64 - F.bx + F.G - 1) / F.G; if (F.bx >= 64) nd = 0; d0 = F.bx; dstep = F.G; }
#if (P3_MASK & 1)
    for (int it = 0; it < na; ++it) { const int u = a0 + it * astep; __syncthreads(); p3_attn_unit(F, u / 24, u % 24); }
#endif
#if (P3_MASK & 2)
    for (int it = 0; it < nd; ++it) { __syncthreads(); p3_dft_unit(F, g, d0 + it * dstep); }
#endif
}

__device__ __forceinline__ void p4_merge_norm(const Frame& F) {
    const float* gf = INP(9); const float* ga = INP(10);
    bf16_t* mrg = WSP(bf16_t, WS_MRG);
    for (int row = F.bx * 8 + F.wave; row < NTOK; row += F.G * 8) {
        bf16_t* rp = mrg + (size_t)row * DM;
        u32x4 v[4]; float ssf = 0.f, ssa = 0.f;
#pragma unroll
        for (int i = 0; i < 4; ++i) { v[i] = *(const u32x4*)(rp + (i * 64 + F.lane) * 8); float s = 0.f;
#pragma unroll
            for (int e = 0; e < 4; ++e) { const float a = bflo(v[i][e]), b2 = bfhi(v[i][e]); s += a * a + b2 * b2; }
            if (i == 0) ssf = s; else ssa += s; }
        ssf = wave_sum(ssf); ssa = wave_sum(ssa);
        const float rf = rsqrtf(ssf * (1.f / FW) + EPS), ra = rsqrtf(ssa * (1.f / AW) + EPS);
#pragma unroll
        for (int i = 0; i < 4; ++i) { const int k = (i * 64 + F.lane) * 8; const float rs = (i == 0) ? rf : ra; const float* gp = (i == 0) ? (gf + k) : (ga + (k - FW));
            const f32x4 g0 = *(const f32x4*)gp, g1 = *(const f32x4*)(gp + 4);
            u32x4 w;
            w[0] = cvt_pk_bf16(bflo(v[i][0]) * rs * g0[0], bfhi(v[i][0]) * rs * g0[1]); w[1] = cvt_pk_bf16(bflo(v[i][1]) * rs * g0[2], bfhi(v[i][1]) * rs * g0[3]);
            w[2] = cvt_pk_bf16(bflo(v[i][2]) * rs * g1[0], bfhi(v[i][2]) * rs * g1[1]); w[3] = cvt_pk_bf16(bflo(v[i][3]) * rs * g1[2], bfhi(v[i][3]) * rs * g1[3]);
            *(u32x4*)(rp + k) = w; }
    }
}

__device__ __forceinline__ void p5_outproj(const Frame& F) {
    const GemmThread g = gemm_thread_init();
    const bf16_t* mrg = WSP(const bf16_t, WS_MRG); bf16_t* mix = WSP(bf16_t, WS_MIX);
    const int vcu = (F.G & 7) ? F.bx : F.xl * (F.G >> 3) + F.rk;
    for (int u = vcu; u < 256; u += F.G) {
        int mt, nt; if (!patch_unit(u, 32, 8, mt, nt)) continue;
        f32x4 acc[4][8]; acc_zero(acc);
        unsigned aoff[2];
#pragma unroll
        for (int i = 0; i < 2; ++i) aoff[i] = (unsigned)(g.rrow0 + 16 * i) * (DM * 2u) + g.rchunk;
        gemm_accum_ring(acc, F.lds, g, F.wave, F.lane, (const char*)(mrg + (size_t)mt * 256 * DM), aoff, (const char*)(WSB() + WS_IMGOUT) + (size_t)(nt * 32) * 32768, DM / 64);
        const EpiLane el = epi_lane(g);
#pragma unroll
        for (int i = 0; i < 4; ++i) { const int t = mt * 256 + 64 * el.wm + 16 * i + el.l15;
#pragma unroll
            for (int j = 0; j < 8; ++j) { const int col = nt * 256 + 128 * el.wn + 16 * j + 4 * el.lq;
                u32x2 w = {cvt_pk_bf16(acc[i][j][0], acc[i][j][1]), cvt_pk_bf16(acc[i][j][2], acc[i][j][3])};
                *(u32x2*)(mix + (size_t)t * DM + col) = w; } }
    }
}

__device__ __forceinline__ void p6_postmix(const Frame& F) {
    const int tid = F.tid, lane = F.lane, wave = F.wave;
    const float* x = INP(0); const float* gpost = INP(12); const float* gpre = INP(13);
    const float* w_router = INP(14); const float* b_router = INP(15);
    const bf16_t* mix = WSP(const bf16_t, WS_MIX); float* x1b = WSP(float, WS_X1); unsigned char* h2b = WSP(unsigned char, WS_H2);
    int* list = WSP(int, WS_LIST); float* gatev = WSP(float, WS_GATEV); unsigned* cnt = (unsigned*)(WSB() + WS_CTL + CTL_CNT_OFF);
    float* gm = (float*)F.lds; float* af = gm + DM; float* sf = af + DM;
    constexpr int RP = 528;
    char* HAh = F.lds + 24576; char* HAl = HAh + 32 * RP; char* WBh = HAl + 32 * RP; char* WBl = WBh + 32 * RP;
    float* RED = (float*)(WBl + 32 * RP);
    float* LOG = RED + 8 * 32 * 32;
    int* s_cnt = (int*)(LOG + 32 * 32); int* s_base = s_cnt + 32; int* s_e = s_base + 32; int* s_lr = s_e + 128;
    for (int grp = F.bx; grp < NTOK / 32; grp += F.G) {
        const int row0 = grp * 32, b = row0 / SEQ;
        __syncthreads();
        for (int k = tid; k < DM; k += NTHREADS) {
            gm[k] = mod_at(F, b * 12288 + 2 * DM + k) * gpost[k];
            af[k] = gpre[k] * (1.f + mod_at(F, b * 12288 + 4 * DM + k));
            sf[k] = mod_at(F, b * 12288 + 3 * DM + k); }
        if (tid < 32) s_cnt[tid] = 0;
        __syncthreads();
        const unsigned lo16 = (unsigned)lane * 16u, lo8 = (unsigned)lane * 8u;
        float r2v[4];
#pragma unroll
        for (int rr = 0; rr < 4; ++rr) r2v[rr] = 0.f;
#pragma unroll 1
        for (int rr = 0; rr < 4; ++rr) {
            const int row = row0 + wave * 4 + rr;
            float ss = 0.f; f32x4 mv[8];
#pragma unroll
            for (int i = 0; i < 8; ++i) { const u32x2 m2 = *(const u32x2*)((const char*)(mix + (size_t)row * DM + i * 256) + lo8);
                mv[i] = (f32x4){bflo(m2[0]), bfhi(m2[0]), bflo(m2[1]), bfhi(m2[1])};
                ss += mv[i][0] * mv[i][0] + mv[i][1] * mv[i][1] + mv[i][2] * mv[i][2] + mv[i][3] * mv[i][3]; }
            ss = wave_sum(ss); const float r1 = rsqrtf(ss * (1.f / DM) + EPS);
            float s2 = 0.f;
#pragma unroll
            for (int i = 0; i < 8; ++i) { const int k = i * 256 + lane * 4; const f32x4 xv = *(const f32x4*)((const char*)(x + (size_t)row * DM + i * 256) + lo16); const f32x4 g4 = *(const f32x4*)(gm + k);
                f32x4 v1; for (int e = 0; e < 4; ++e) v1[e] = xv[e] + g4[e] * (mv[i][e] * r1);
                *(f32x4*)((char*)(x1b + (size_t)row * DM + i * 256) + lo16) = v1; mv[i] = v1;
#if DEBUG_X1
                *(f32x4*)((char*)(uni(F.a->out) + (size_t)row * DM + i * 256) + lo16) = v1;
#endif
                s2 += v1[0] * v1[0] + v1[1] * v1[1] + v1[2] * v1[2] + v1[3] * v1[3]; }
            s2 = wave_sum(s2); const float r2 = rsqrtf(s2 * (1.f / DM) + EPS);
            r2v[0] = rr == 0 ? r2 : r2v[0]; r2v[1] = rr == 1 ? r2 : r2v[1]; r2v[2] = rr == 2 ? r2 : r2v[2]; r2v[3] = rr == 3 ? r2 : r2v[3];
#pragma unroll
            for (int i = 0; i < 8; ++i) { const int k = i * 256 + lane * 4; const f32x4 a4 = *(const f32x4*)(af + k), s4 = *(const f32x4*)(sf + k);
                float h0 = (mv[i][0] * r2 * a4[0] + s4[0]) * FP8_SA, h1 = (mv[i][1] * r2 * a4[1] + s4[1]) * FP8_SA, h2_ = (mv[i][2] * r2 * a4[2] + s4[2]) * FP8_SA, h3 = (mv[i][3] * r2 * a4[3] + s4[3]) * FP8_SA;
                h0 = fminf(fmaxf(h0, -448.f), 448.f); h1 = fminf(fmaxf(h1, -448.f), 448.f); h2_ = fminf(fmaxf(h2_, -448.f), 448.f); h3 = fminf(fmaxf(h3, -448.f), 448.f);
                *(unsigned*)(h2b + (size_t)row * DM + i * 256 + lane * 4) = cvt4_fp8(h0, h1, h2_, h3); }
        }
        f32x4 racc[2][2];
#pragma unroll
        for (int m = 0; m < 2; ++m)
#pragma unroll
            for (int n = 0; n < 2; ++n) racc[m][n] = (f32x4){0.f, 0.f, 0.f, 0.f};
        const int l15 = lane & 15, lq = lane >> 4;
#pragma unroll 1
        for (int i = 0; i < 8; ++i) {
            __syncthreads();
            {
                const int k = i * 256 + lane * 4; const f32x4 a4 = *(const f32x4*)(af + k), s4 = *(const f32x4*)(sf + k);
#pragma unroll
                for (int rr = 0; rr < 4; ++rr) {
                    const f32x4 xv = *(const f32x4*)((const char*)(x1b + (size_t)(row0 + wave * 4 + rr) * DM + i * 256) + lo16);
                    const float r2 = rr == 0 ? r2v[0] : rr == 1 ? r2v[1] : rr == 2 ? r2v[2] : r2v[3];
                    float h0 = xv[0] * r2 * a4[0] + s4[0], h1 = xv[1] * r2 * a4[1] + s4[1], h2_ = xv[2] * r2 * a4[2] + s4[2], h3 = xv[3] * r2 * a4[3] + s4[3];
                    const unsigned p0 = cvt_pk_bf16(h0, h1), p1 = cvt_pk_bf16(h2_, h3);
                    const unsigned q0 = cvt_pk_bf16(h0 - bflo(p0), h1 - bfhi(p0)), q1 = cvt_pk_bf16(h2_ - bflo(p1), h3 - bfhi(p1));
                    const int off = (wave * 4 + rr) * RP + lane * 8;
                    *(u32x2*)(HAh + off) = (u32x2){p0, p1}; *(u32x2*)(HAl + off) = (u32x2){q0, q1};
                }
            }
            {
                const int k4 = tid & 63, e4 = tid >> 6;
                f32x4 wv[4];
#pragma unroll
                for (int kk = 0; kk < 4; ++kk) wv[kk] = *(const f32x4*)(w_router + (size_t)(i * 256 + 4 * k4 + kk) * NEXP + 4 * e4);
#pragma unroll
                for (int j = 0; j < 4; ++j) {
                    const unsigned p0 = cvt_pk_bf16(wv[0][j], wv[1][j]), p1 = cvt_pk_bf16(wv[2][j], wv[3][j]);
                    const unsigned q0 = cvt_pk_bf16(wv[0][j] - bflo(p0), wv[1][j] - bfhi(p0)), q1 = cvt_pk_bf16(wv[2][j] - bflo(p1), wv[3][j] - bfhi(p1));
                    const int off = (4 * e4 + j) * RP + k4 * 8;
                    *(u32x2*)(WBh + off) = (u32x2){p0, p1}; *(u32x2*)(WBl + off) = (u32x2){q0, q1};
                }
            }
            __syncthreads();
            bf16x8 ah[2], al[2], bh[2], bl[2];
            const int fo = l15 * RP + wave * 64 + lq * 16;
#pragma unroll
            for (int m = 0; m < 2; ++m) { ah[m] = *(const bf16x8*)(HAh + fo + m * 16 * RP); al[m] = *(const bf16x8*)(HAl + fo + m * 16 * RP);
                                          bh[m] = *(const bf16x8*)(WBh + fo + m * 16 * RP); bl[m] = *(const bf16x8*)(WBl + fo + m * 16 * RP); }
#pragma unroll
            for (int m = 0; m < 2; ++m)
#pragma unroll
                for (int n = 0; n < 2; ++n) {
                    racc[m][n] = __builtin_amdgcn_mfma_f32_16x16x32_bf16(ah[m], bh[n], racc[m][n], 0, 0, 0);
                    racc[m][n] = __builtin_amdgcn_mfma_f32_16x16x32_bf16(ah[m], bl[n], racc[m][n], 0, 0, 0);
                    racc[m][n] = __builtin_amdgcn_mfma_f32_16x16x32_bf16(al[m], bh[n], racc[m][n], 0, 0, 0);
                }
        }
#pragma unroll
        for (int m = 0; m < 2; ++m)
#pragma unroll
            for (int n = 0; n < 2; ++n)
#pragma unroll
                for (int r = 0; r < 4; ++r) RED[(wave * 32 + 16 * m + 4 * lq + r) * 32 + 16 * n + l15] = racc[m][n][r];
        __syncthreads();
        { const int tk = tid >> 4, e2 = (tid & 15) * 2; float s0 = b_router[e2], s1 = b_router[e2 + 1];
#pragma unroll
            for (int w = 0; w < 8; ++w) { s0 += RED[(w * 32 + tk) * 32 + e2]; s1 += RED[(w * 32 + tk) * 32 + e2 + 1]; }
            LOG[tk * 32 + e2] = s0; LOG[tk * 32 + e2 + 1] = s1; }
        __syncthreads();
#pragma unroll 1
        for (int rr = 0; rr < 4; ++rr) {
            float val = LOG[(wave * 4 + rr) * 32 + (lane & 31)];
            float tv[4]; int te[4];
#pragma unroll
            for (int kk = 0; kk < 4; ++kk) {
                float m = val;
#pragma unroll
                for (int o = 16; o >= 1; o >>= 1) m = fmaxf(m, __shfl_xor(m, o, 64));
                const unsigned long long bal = __ballot(val == m);
                const int e = __ffsll((long long)bal) - 1;
                tv[kk] = m; te[kk] = e & 31; if ((lane & 31) == (e & 31)) val = -INFINITY;
            }
            const float p1 = __expf(tv[1] - tv[0]), p2 = __expf(tv[2] - tv[0]), p3 = __expf(tv[3] - tv[0]); const float inv = 1.f / (1.f + p1 + p2 + p3);
            if (lane < 4) {
                const int e = lane == 0 ? te[0] : lane == 1 ? te[1] : lane == 2 ? te[2] : te[3];
                const float gt = (lane == 0 ? 1.f : lane == 1 ? p1 : lane == 2 ? p2 : p3) * inv;
                const int al = (wave * 4 + rr) * 4 + lane;
                s_e[al] = e; s_lr[al] = atomicAdd(&s_cnt[e], 1);
                gatev[row0 * 4 + al] = gt;
            }
        }
        __syncthreads();
        if (tid < 32) { int t2 = tid; asm volatile("" : "+v"(t2));
            s_base[tid] = (int)__hip_atomic_fetch_add(&cnt[t2], (unsigned)s_cnt[tid], __ATOMIC_RELAXED, __HIP_MEMORY_SCOPE_AGENT); }
        __syncthreads();
        if (tid < 128) { const int e = s_e[tid]; list[e * 8192 + s_base[e] + s_lr[tid]] = row0 * 4 + tid; }
    }
}

struct MoeTab { int* tiles; int* rowbase; int* cnt; int* pt; };
__device__ __forceinline__ MoeTab moe_tab(const Frame& F) {
    MoeTab t; t.tiles = (int*)(F.lds + LDS_MISC + 64); t.rowbase = t.tiles + 32; t.cnt = t.rowbase + 32; t.pt = t.cnt + 32;
    unsigned* cnt = (unsigned*)(WSB() + WS_CTL + CTL_CNT_OFF);
    __syncthreads();
    if (F.tid < 32) { const int n = (int)__hip_atomic_load(&cnt[F.tid], __ATOMIC_RELAXED, __HIP_MEMORY_SCOPE_AGENT); t.cnt[F.tid] = n; t.tiles[F.tid] = (n + 255) >> 8; }
    __syncthreads();
    if (F.tid == 0) { int s = 0, p = 0; for (int e = 0; e < 32; ++e) { t.rowbase[e] = s; s += t.tiles[e] * 256; t.pt[e] = p; p += t.tiles[e] > 1 ? t.tiles[e] - 1 : 0; } t.pt[32] = p; }
    __syncthreads();
    return t;
}
__device__ __forceinline__ void moe_tile_of(const MoeTab& t, int tix, int& e, int& mt) {
    int ee = 0;
#pragma unroll 1
    for (int k = 1; k < 32; ++k) ee = (tix >= t.pt[k]) ? k : ee;
    e = ee; mt = 1 + tix - t.pt[ee];
}

__device__ __forceinline__ void moe_up_epilogue(const Frame& F, const GemmThread& g, const f32x4 (&acc)[4][8], int e, int mt, int nt, int ne, int rowb) {
    const float* b_gate = INP(17); const float* b_up = INP(19); unsigned char* act = WSP(unsigned char, WS_ACT);
    const EpiLane el = epi_lane(g);
#pragma unroll
    for (int j = 0; j < 4; ++j) {
        const int col = nt * 128 + 64 * el.wn + 16 * j + 4 * el.lq;
        const f32x4 bg = *(const f32x4*)(b_gate + (size_t)e * DM + col), bu = *(const f32x4*)(b_up + (size_t)e * DM + col);
#pragma unroll
        for (int i = 0; i < 4; ++i) {
            const int ml = 64 * el.wm + 16 * i + el.l15;
            float o[4];
#pragma unroll
            for (int q = 0; q < 4; ++q) { float gg = acc[i][j][q] * (1.f / (FP8_SA * FP8_SW)) + bg[q], uu = acc[i][j + 4][q] * (1.f / (FP8_SA * FP8_SW)) + bu[q];
                gg = fminf(gg, 7.f); uu = fminf(fmaxf(uu, -7.f), 7.f);
                o[q] = (uu + 1.f) * gg / (1.f + __expf(-1.702f * gg)); }
            if (mt * 256 + ml < ne) *(unsigned*)(act + ((size_t)(rowb >> 8) * 32 + (col >> 6)) * 16384 + ml * 64 + (col & 63)) = cvt4_fp8(o[0] * FP8_SACT, o[1] * FP8_SACT, o[2] * FP8_SACT, o[3] * FP8_SACT);
        }
    }
}
__device__ __forceinline__ void moe_dn_epilogue(const Frame& F, const GemmThread& g, const f32x4 (&acc)[4][8], int e, int mt, int nt, int ne) {
    const float* b_down = INP(21); const int* list = WSP(const int, WS_LIST); const float* gatev = WSP(const float, WS_GATEV); bf16_t* outb = WSP(bf16_t, WS_OUTB);
    const EpiLane el = epi_lane(g);
#pragma unroll
    for (int i = 0; i < 4; ++i) {
        const int ml = 64 * el.wm + 16 * i + el.l15, rk = mt * 256 + ml;
        if (rk < ne) {
            const int a = list[e * 8192 + rk]; const float gt = gatev[a];
#pragma unroll
            for (int j = 0; j < 8; ++j) { const int col = nt * 256 + 128 * el.wn + 16 * j + 4 * el.lq;
                const f32x4 bd = *(const f32x4*)(b_down + (size_t)e * DM + col);
                constexpr float RS = 1.f / (FP8_SACT * FP8_SW);
                u32x2 w = {cvt_pk_bf16((acc[i][j][0] * RS + bd[0]) * gt, (acc[i][j][1] * RS + bd[1]) * gt), cvt_pk_bf16((acc[i][j][2] * RS + bd[2]) * gt, (acc[i][j][3] * RS + bd[3]) * gt)};
                *(u32x2*)(outb + (size_t)a * DM + col) = w; }
        }
    }
}
__device__ __forceinline__ void moe_up_epilogue32(const Frame& F, const GemmThread& g, const f32x16 (&acc)[2][4], int e, int mt, int nt, int ne, int rowb) {
    const float* b_gate = INP(17); const float* b_up = INP(19); unsigned char* act = WSP(unsigned char, WS_ACT);
    int l31 = F.lane & 31, lh = F.lane >> 5; asm volatile("" : "+v"(l31), "+v"(lh));
#pragma unroll
    for (int j = 0; j < 2; ++j)
#pragma unroll
        for (int q4 = 0; q4 < 4; ++q4) {
            const int col = nt * 128 + 64 * g.wn + 32 * j + 8 * q4 + 4 * lh;
            const f32x4 bg = *(const f32x4*)(b_gate + (size_t)e * DM + col), bu = *(const f32x4*)(b_up + (size_t)e * DM + col);
#pragma unroll
            for (int i = 0; i < 2; ++i) {
                const int ml = 64 * g.wm + 32 * i + l31;
                float o[4];
#pragma unroll
                for (int q = 0; q < 4; ++q) { float gg = acc[i][j][4 * q4 + q] * (1.f / (FP8_SA * FP8_SW)) + bg[q], uu = acc[i][j + 2][4 * q4 + q] * (1.f / (FP8_SA * FP8_SW)) + bu[q];
                    gg = fminf(gg, 7.f); uu = fminf(fmaxf(uu, -7.f), 7.f);
                    o[q] = (uu + 1.f) * gg / (1.f + __expf(-1.702f * gg)); }
                if (mt * 256 + ml < ne) *(unsigned*)(act + ((size_t)(rowb >> 8) * 32 + (col >> 6)) * 16384 + ml * 64 + (col & 63)) = cvt4_fp8(o[0] * FP8_SACT, o[1] * FP8_SACT, o[2] * FP8_SACT, o[3] * FP8_SACT);
            }
        }
}
__device__ __forceinline__ void moe_dn_epilogue32(const Frame& F, const GemmThread& g, const f32x16 (&acc)[2][4], int e, int mt, int nt, int ne) {
    const float* b_down = INP(21); const int* list = WSP(const int, WS_LIST); const float* gatev = WSP(const float, WS_GATEV); bf16_t* outb = WSP(bf16_t, WS_OUTB);
    int l31 = F.lane & 31, lh = F.lane >> 5; asm volatile("" : "+v"(l31), "+v"(lh));
    constexpr float RS = 1.f / (FP8_SACT * FP8_SW);
#pragma unroll
    for (int i = 0; i < 2; ++i) {
        const int ml = 64 * g.wm + 32 * i + l31, rk = mt * 256 + ml;
        if (rk < ne) {
            const int a = list[e * 8192 + rk]; const float gt = gatev[a];
#pragma unroll
            for (int j = 0; j < 4; ++j)
#pragma unroll
                for (int q4 = 0; q4 < 4; ++q4) { const int col = nt * 256 + 128 * g.wn + 32 * j + 8 * q4 + 4 * lh;
                    const f32x4 bd = *(const f32x4*)(b_down + (size_t)e * DM + col);
                    u32x2 w = {cvt_pk_bf16((acc[i][j][4 * q4 + 0] * RS + bd[0]) * gt, (acc[i][j][4 * q4 + 1] * RS + bd[1]) * gt), cvt_pk_bf16((acc[i][j][4 * q4 + 2] * RS + bd[2]) * gt, (acc[i][j][4 * q4 + 3] * RS + bd[3]) * gt)};
                    *(u32x2*)(outb + (size_t)a * DM + col) = w; }
        }
    }
}
__device__ __forceinline__ void moe_up_unit_first(const Frame& F, const GemmThread& g, const MoeTab& tb, int e, int nt) {
    const int ne = __builtin_amdgcn_readfirstlane(tb.cnt[e]); if (ne == 0) return;
    const int* list = WSP(const int, WS_LIST); const unsigned char* h2 = WSP(const unsigned char, WS_H2);
    const float* w_gate = INP(16); const float* w_up = INP(18);
    f32x4 acc[4][8]; acc_zero(acc);
    int achunk = g.rchunk, arow = g.rrow0, kg = g.kg, ng = g.ng; asm volatile("" : "+v"(achunk), "+v"(arow), "+v"(kg), "+v"(ng));
    unsigned aoff[2];
#pragma unroll
    for (int i = 0; i < 2; ++i) { int rk = arow + 16 * i; rk = rk < ne ? rk : ne - 1; const int a = list[e * 8192 + rk]; aoff[i] = (unsigned)(a >> 2) * (unsigned)DM + achunk; }
    const int isup = (F.wave >> 1) & 1;
    const char* bb = (const char*)((isup ? w_up : w_gate) + (size_t)e * DM * DM + nt * 128);
    const unsigned boff = (unsigned)(8 * kg) * (DM * 4u) + (unsigned)((ng >> 5) * 64 + (ng & 15) * 4) * 4u;
    f8_accum_w32(acc, F.lds, g, F.wave, (const char*)h2, aoff, bb, boff, DM * 4, DM / 64, (char*)(WSB() + WS_IMGGU) + (size_t)((e * 16 + nt) * 32) * 16384);
    moe_up_epilogue(F, g, acc, e, 0, nt, ne, __builtin_amdgcn_readfirstlane(tb.rowbase[e]));
}
__device__ __forceinline__ void moe_dn_unit_first(const Frame& F, const GemmThread& g, const MoeTab& tb, int e, int nt) {
    const int ne = __builtin_amdgcn_readfirstlane(tb.cnt[e]); if (ne == 0) return;
    const unsigned char* act = WSP(const unsigned char, WS_ACT); const float* w_down = INP(20);
    const int rowb = __builtin_amdgcn_readfirstlane(tb.rowbase[e]);
    f32x4 acc[4][8]; acc_zero(acc);
    int achunk = g.rchunk, arow = g.rrow0, kg = g.kg, ng = g.ng; asm volatile("" : "+v"(achunk), "+v"(arow), "+v"(kg), "+v"(ng));
    unsigned aoff[2];
#pragma unroll
    for (int i = 0; i < 2; ++i) aoff[i] = (unsigned)(arow + 16 * i) * 64u + achunk;
    f8_accum_w32(acc, F.lds, g, F.wave, (const char*)(act + (size_t)(rowb >> 8) * 32 * 16384), aoff, (const char*)(w_down + (size_t)e * DM * DM + nt * 256), (unsigned)(8 * kg) * (DM * 4u) + 16u * ng, DM * 4, DM / 64,
                 (char*)(WSB() + WS_IMGDN) + (size_t)((e * 8 + nt) * 32) * 16384, 16384u);
    moe_dn_epilogue(F, g, acc, e, 0, nt, ne);
}
__device__ __forceinline__ void moe_up_unit_dma(const Frame& F, const GemmThread& g, const MoeTab& tb, int e, int mt, int nt) {
    const int ne = __builtin_amdgcn_readfirstlane(tb.cnt[e]);
    const int* list = WSP(const int, WS_LIST); const unsigned char* h2 = WSP(const unsigned char, WS_H2);
    int achunk = g.rchunk, arow = g.rrow0; asm volatile("" : "+v"(achunk), "+v"(arow));
    f32x16 acc[2][4];
#pragma unroll
    for (int i = 0; i < 2; ++i)
#pragma unroll
        for (int j = 0; j < 4; ++j) acc[i][j] = f32x16{};
    unsigned aoff[2];
#pragma unroll
    for (int i = 0; i < 2; ++i) { int rk = mt * 256 + arow + 16 * i; rk = rk < ne ? rk : ne - 1; const int a = list[e * 8192 + rk]; aoff[i] = (unsigned)(a >> 2) * (unsigned)DM + achunk; }
    s8_accum_ring(acc, F.lds, g, F.wave, F.lane, (const char*)h2, aoff, (const char*)(WSB() + WS_IMGGU) + (size_t)((e * 16 + nt) * 32) * 16384, DM / 64);
    moe_up_epilogue32(F, g, acc, e, mt, nt, ne, __builtin_amdgcn_readfirstlane(tb.rowbase[e]) + mt * 256);
}
__device__ __forceinline__ void moe_dn_unit_dma(const Frame& F, const GemmThread& g, const MoeTab& tb, int e, int mt, int nt) {
    const int ne = __builtin_amdgcn_readfirstlane(tb.cnt[e]), rowb = __builtin_amdgcn_readfirstlane(tb.rowbase[e]) + mt * 256;
    const unsigned char* act = WSP(const unsigned char, WS_ACT);
    int achunk = g.rchunk, arow = g.rrow0; asm volatile("" : "+v"(achunk), "+v"(arow));
    f32x16 acc[2][4];
#pragma unroll
    for (int i = 0; i < 2; ++i)
#pragma unroll
        for (int j = 0; j < 4; ++j) acc[i][j] = f32x16{};
    unsigned aoff[2];
#pragma unroll
    for (int i = 0; i < 2; ++i) aoff[i] = (unsigned)(arow + 16 * i) * 64u + achunk;
    s8_accum_ring(acc, F.lds, g, F.wave, F.lane, (const char*)(act + (size_t)(rowb >> 8) * 32 * 16384), aoff, (const char*)(WSB() + WS_IMGDN) + (size_t)((e * 8 + nt) * 32) * 16384, DM / 64, 16384u);
    moe_dn_epilogue32(F, g, acc, e, mt, nt, ne);
}

__device__ __forceinline__ void p7_moe_a(const Frame& F) {
    const GemmThread g = gemm_thread_init();
    const MoeTab tb = moe_tab(F);
    const int vcu = (F.G & 7) ? F.bx : F.xl * (F.G >> 3) + F.rk;
    for (int u = vcu; u < 32 * 16; u += F.G) moe_up_unit_first(F, g, tb, u >> 4, u & 15);
}
__device__ __forceinline__ void p8_moe_b(const Frame& F) {
    const GemmThread g = gemm_thread_init();
    const MoeTab tb = moe_tab(F);
    const int nb = __builtin_amdgcn_readfirstlane(tb.pt[32]) * 16;
    const int vcu = (F.G & 7) ? F.bx : F.xl * (F.G >> 3) + F.rk;
    int u = vcu;
    for (; u < 256; u += F.G) moe_dn_unit_first(F, g, tb, u >> 3, u & 7);
    if (F.G == 256) {
        const int T = nb >> 4, ngrp = 2 * ((T + 3) >> 2);
        for (int gi = F.xl; gi < ngrp; gi += 8) { const int tix = (gi >> 1) * 4 + (F.rk >> 3), nt = (gi & 1) * 8 + (F.rk & 7);
            if (tix < T) { int e, mt; moe_tile_of(tb, tix, e, mt); e = __builtin_amdgcn_readfirstlane(e); mt = __builtin_amdgcn_readfirstlane(mt); moe_up_unit_dma(F, g, tb, e, mt, nt); } }
    } else
    for (u = F.bx; u < nb; u += F.G) { int e, mt; moe_tile_of(tb, u >> 4, e, mt); e = __builtin_amdgcn_readfirstlane(e); mt = __builtin_amdgcn_readfirstlane(mt); moe_up_unit_dma(F, g, tb, e, mt, u & 15); }
}
__device__ __forceinline__ void p9_moe_c(const Frame& F) {
    const GemmThread g = gemm_thread_init();
    const MoeTab tb = moe_tab(F);
    const int nb = __builtin_amdgcn_readfirstlane(tb.pt[32]) * 8;
    if (F.G == 256) {
        const int T = nb >> 3, ngrp = (T + 3) >> 2;
        for (int gi = F.xl; gi < ngrp; gi += 8) { const int tix = gi * 4 + (F.rk >> 3), nt = F.rk & 7;
            if (tix < T) { int e, mt; moe_tile_of(tb, tix, e, mt); e = __builtin_amdgcn_readfirstlane(e); mt = __builtin_amdgcn_readfirstlane(mt); moe_dn_unit_dma(F, g, tb, e, mt, nt); } }
    } else
    for (int u = F.bx; u < nb; u += F.G) { int e, mt; moe_tile_of(tb, u >> 3, e, mt); e = __builtin_amdgcn_readfirstlane(e); mt = __builtin_amdgcn_readfirstlane(mt); moe_dn_unit_dma(F, g, tb, e, mt, u & 7); }
}

__device__ __forceinline__ void p10_final(const Frame& F) {
    const int tid = F.tid, lane = F.lane, wave = F.wave;
    const float* gpf = INP(22); const float* x1b = WSP(const float, WS_X1); const bf16_t* outb = WSP(const bf16_t, WS_OUTB);
    float* gfv = (float*)F.lds;
    for (int grp = F.bx; grp < NTOK / 32; grp += F.G) {
        const int row0 = grp * 32, b = row0 / SEQ;
        __syncthreads();
        for (int k = tid; k < DM; k += NTHREADS) gfv[k] = mod_at(F, b * 12288 + 5 * DM + k) * gpf[k];
        __syncthreads();
        for (int rr = 0; rr < 4; ++rr) {
            const int row = row0 + wave * 4 + rr;
            f32x4 y[8]; float ss = 0.f;
#pragma unroll
            for (int i = 0; i < 8; ++i) { y[i] = (f32x4){0.f, 0.f, 0.f, 0.f};
#pragma unroll
                for (int kk = 0; kk < 4; ++kk) { const u32x2 m2 = *(const u32x2*)(outb + (size_t)(row * 4 + kk) * DM + i * 256 + lane * 4);
                    y[i][0] += bflo(m2[0]); y[i][1] += bfhi(m2[0]); y[i][2] += bflo(m2[1]); y[i][3] += bfhi(m2[1]); }
                ss += y[i][0] * y[i][0] + y[i][1] * y[i][1] + y[i][2] * y[i][2] + y[i][3] * y[i][3]; }
            ss = wave_sum(ss); const float rs = rsqrtf(ss * (1.f / DM) + EPS);
#pragma unroll
            for (int i = 0; i < 8; ++i) { const int k = i * 256 + lane * 4; const f32x4 xv = *(const f32x4*)(x1b + (size_t)row * DM + k); const f32x4 g4 = *(const f32x4*)(gfv + k);
                f32x4 o; for (int e = 0; e < 4; ++e) o[e] = xv[e] + g4[e] * (y[i][e] * rs);
                *(f32x4*)(uni(F.a->out) + (size_t)row * DM + k) = o; }
        }
    }
}


__global__ void __launch_bounds__(NTHREADS, 2) fwd_kernel(Args args) {
    extern __shared__ __attribute__((aligned(16))) char lds[];
    Frame F;
    F.lds = lds; F.a = &args;
    F.tid = threadIdx.x; F.lane = F.tid & 63; F.wave = __builtin_amdgcn_readfirstlane(F.tid >> 6); F.G = gridDim.x; F.bx = blockIdx.x;
    const int lo = args.ph_lo, hi = args.ph_hi;
    F.xl = F.bx & 7; F.rk = F.bx >> 3;
    XcdBarrier bar; bar.bar = (unsigned*)(args.ws + WS_CTL); bar.x = 0; bar.st = (volatile LAS unsigned*)(lds + LDS_MISC);
    if (hi - lo > 1) {
        if (F.tid == 0) { *(volatile LAS unsigned*)(lds + LDS_MISC) = 0u; *(volatile LAS unsigned*)(lds + LDS_MISC + 4) = 0u; }
        __syncthreads();
        bar = xcd_barrier_post((unsigned*)(args.ws + WS_CTL), (volatile LAS unsigned*)(lds + LDS_MISC));
        if (F.tid == 0) *(volatile LAS unsigned*)(lds + LDS_MISC + 16) = xb_add((unsigned*)(args.ws + WS_CTL + CTL_RANK_OFF) + bar.x, 1u);
    }
#ifndef PH_MASK
#define PH_MASK 0x7ff
#endif
#define IN(k) (((PH_MASK >> (k)) & 1) && lo <= (k) && (k) < hi)
#define SEAM(k) do { if (IN(k) && IN((k) + 1)) xcd_barrier(bar); } while (0)
    if (IN(0)) { p0_prologue(F); } SEAM(0);
    if (hi - lo > 1 && (F.G & 7) == 0) {
        if (F.tid == 0) { unsigned ok = 1u; for (int j = 0; j < 8; ++j) ok &= (xb_ld(&bar.bar[XB_XCNT(j)]) == (unsigned)(F.G >> 3)) ? 1u : 0u; *(volatile LAS unsigned*)(lds + LDS_MISC + 20) = ok; }
        __syncthreads();
        if (*(volatile LAS unsigned*)(lds + LDS_MISC + 20) && bar.x < 8u) { F.xl = (int)bar.x; F.rk = (int)*(volatile LAS unsigned*)(lds + LDS_MISC + 16); }
        F.xl = __builtin_amdgcn_readfirstlane(F.xl); F.rk = __builtin_amdgcn_readfirstlane(F.rk);
    }
    if (IN(1)) { p1_norm(F); } SEAM(1);
    if (IN(2)) { p2_inproj(F); } SEAM(2);
    if (IN(3)) { p3_mixers(F); } SEAM(3);
    if (IN(4)) { p4_merge_norm(F); } SEAM(4);
    if (IN(5)) { p5_outproj(F); } SEAM(5);
    if (IN(6)) { p6_postmix(F); } SEAM(6);
    if (IN(7)) { p7_moe_a(F); } SEAM(7);
    if (IN(8)) { p8_moe_b(F); } SEAM(8);
    if (IN(9)) { p9_moe_c(F); } SEAM(9);
    if (IN(10)) { p10_final(F); }
#undef IN
#undef SEAM
}

}

extern "C" void kernel_launch(void* const* d_in, const int* in_sizes, int n_in, void* d_out, int out_size, void* d_ws, size_t ws_size, hipStream_t stream) {
    static int grid = 0;
    if (grid == 0) {
        if (n_in != 23 || out_size != NTOK * DM || ws_size < WS_END) { fprintf(stderr, "kernel_launch: unexpected shapes (n_in %d out %d ws %zu need %zu)\n", n_in, out_size, ws_size, (size_t)WS_END); grid = -1; return; }
        int dev = 0, cus = 0, per_cu = 0;
        if (hipGetDevice(&dev) != hipSuccess || hipDeviceGetAttribute(&cus, hipDeviceAttributeMultiprocessorCount, dev) != hipSuccess) { grid = -1; return; }
        if (hipFuncSetAttribute((const void*)fwd_kernel, hipFuncAttributeMaxDynamicSharedMemorySize, LDS_BYTES) != hipSuccess) { fprintf(stderr, "kernel_launch: hipFuncSetAttribute failed\n"); grid = -1; return; }
        if (hipOccupancyMaxActiveBlocksPerMultiprocessor(&per_cu, (const void*)fwd_kernel, NTHREADS, LDS_BYTES) != hipSuccess || per_cu < 1)
            fprintf(stderr, "kernel_launch: occupancy query reports %d blocks per CU\n", per_cu);
        (void)hipGetLastError();
        grid = cus;
    }
    if (grid < 0) return;
    (void)hipMemsetAsync((char*)d_ws + WS_CTL, 0, CTL_BYTES, stream);
    Args a{};
    for (int i = 0; i < 23; ++i) a.in[i] = (const float*)d_in[i];
    a.out = (float*)d_out; a.ws = (unsigned char*)d_ws;
#if MK_N_LAUNCHES == 1
    a.ph_lo = 0; a.ph_hi = NPHASE;
    hipLaunchKernelGGL(fwd_kernel, dim3(grid), dim3(NTHREADS), LDS_BYTES, stream, a);
#else
    for (int p = 0; p < NPHASE; ++p) { a.ph_lo = p; a.ph_hi = p + 1; hipLaunchKernelGGL(fwd_kernel, dim3(grid), dim3(NTHREADS), LDS_BYTES, stream, a);
        if ((REP_MASK >> p) & 1) hipLaunchKernelGGL(fwd_kernel, dim3(grid), dim3(NTHREADS), LDS_BYTES, stream, a); }
#endif
    const hipError_t le = hipPeekAtLastError();
    if (le != hipSuccess) fprintf(stderr, "kernel_launch: launch failed: %s\n", hipGetErrorName(le));
}
```

```cpp
#include <hip/hip_runtime.h>
#include <stdint.h>
#include <stdio.h>

#ifndef DEBUG_X1
#define DEBUG_X1 0
#endif
#ifndef STAMP_A
#define STAMP_A 0
#endif
#ifndef STAMP_B
#define STAMP_B 0
#endif
#ifndef S8_KMAP
#define S8_KMAP 0
#endif
#ifndef REP_MASK
#define REP_MASK 0
#endif
#ifndef DEBUG_PROBE
#define DEBUG_PROBE 0
#endif
#ifndef P3_MASK
#define P3_MASK 3
#endif
#ifndef MK_N_LAUNCHES
#define MK_N_LAUNCHES 1
#endif

namespace {

constexpr int DM = 2048, NBATCH = 4, SEQ = 2048, NTOK = NBATCH * SEQ;
constexpr int FW = 512, AW = 1536, KVW = 512, INW = 3072;
constexpr int NEXP = 32, TOPK = 4, NMOD = 6;
constexpr int NPHASE = 11;
constexpr float EPS = 1e-6f;
constexpr int NTHREADS = 512;
constexpr float FP8_SA = 16.f, FP8_SW = 256.f, FP8_SACT = 4.f;

typedef unsigned short bf16_t;
typedef short bf16x8 __attribute__((ext_vector_type(8)));
typedef short s16x4 __attribute__((ext_vector_type(4)));
typedef float f32x4 __attribute__((ext_vector_type(4)));
typedef float f32x2 __attribute__((ext_vector_type(2)));
typedef float f32x16 __attribute__((ext_vector_type(16)));
typedef unsigned u32x4 __attribute__((ext_vector_type(4)));
typedef unsigned u32x2 __attribute__((ext_vector_type(2)));

constexpr size_t al256(size_t x) { return (x + 255) / 256 * 256; }
constexpr size_t WS_CTL   = 0;
constexpr size_t CTL_BAR_BYTES = 16384;
constexpr size_t CTL_CNT_OFF = CTL_BAR_BYTES;
constexpr size_t CTL_RANK_OFF = CTL_BAR_BYTES + 256;
constexpr size_t CTL_BYTES = CTL_BAR_BYTES + 512;
constexpr size_t WS_MODP  = al256(WS_CTL + CTL_BYTES);
constexpr size_t WS_G12   = al256(WS_MODP + 2ull * 4 * 12288 * 4);
constexpr size_t WS_ROPE  = al256(WS_G12 + 4ull * 128 * 256 * 4);
constexpr size_t WS_WZ    = al256(WS_ROPE + 2048ull * 64 * 2 * 4);
constexpr size_t WS_CMAT  = al256(WS_WZ + 2048ull * 1024 * 4);
constexpr size_t WS_SMAT  = al256(WS_CMAT + 2048ull * 2048 * 2);
constexpr size_t WS_H     = al256(WS_SMAT + 2048ull * 2048 * 2);
constexpr size_t WS_ZC    = al256(WS_H + (size_t)NTOK * DM * 2);
constexpr size_t WS_ZS    = al256(WS_ZC + (size_t)NTOK * 512 * 4);
constexpr size_t WS_Q     = al256(WS_ZS + (size_t)NTOK * 512 * 4);
constexpr size_t WS_K     = al256(WS_Q + (size_t)NTOK * AW * 2);
constexpr size_t WS_V     = al256(WS_K + (size_t)NTOK * KVW * 2);
constexpr size_t WS_MRG   = al256(WS_V + (size_t)NTOK * KVW * 2);
constexpr size_t WS_MIX   = al256(WS_MRG + (size_t)NTOK * DM * 2);
constexpr size_t WS_X1    = al256(WS_MIX + (size_t)NTOK * DM * 2);
constexpr size_t WS_H2    = al256(WS_X1 + (size_t)NTOK * DM * 4);
constexpr size_t WS_LIST  = al256(WS_H2 + (size_t)NTOK * DM * 2);
constexpr size_t WS_GATEV = al256(WS_LIST + 32ull * 8192 * 4);
constexpr int ACT_ROWS = NTOK * TOPK + NEXP * 256;
constexpr size_t WS_ACT   = al256(WS_GATEV + 32768ull * 4);
constexpr size_t WS_OUTB  = al256(WS_ACT + (size_t)ACT_ROWS * DM * 2);
constexpr size_t WS_IMGGU = al256(WS_OUTB + (size_t)NTOK * TOPK * DM * 2);
constexpr size_t WS_IMGDN = al256(WS_IMGGU + 32ull * 16 * 32 * 16384);
constexpr size_t WS_IMGIN = al256(WS_IMGDN + 32ull * 8 * 32 * 16384);
constexpr size_t WS_IMGOUT= al256(WS_IMGIN + 14ull * 32 * 32768);
constexpr size_t WS_IMGZ  = al256(WS_IMGOUT + 8ull * 32 * 32768);
constexpr size_t WS_END   = al256(WS_IMGZ + 8ull * 64 * 32768);

constexpr int LDS_GEMM = 147456;
constexpr int LDS_MISC = LDS_GEMM;
constexpr int LDS_BYTES = LDS_GEMM + 1024;

typedef __bf16 bf16x2_t __attribute__((ext_vector_type(2)));
__device__ __forceinline__ unsigned cvt_pk_bf16(float lo, float hi) { f32x2 v = {lo, hi}; bf16x2_t b = __builtin_convertvector(v, bf16x2_t); return __builtin_bit_cast(unsigned, b); }
__device__ __forceinline__ bf16_t f2bf(float f) { return (bf16_t)(cvt_pk_bf16(f, 0.f) & 0xffffu); }
__device__ __forceinline__ float bf2f(unsigned h) { return __uint_as_float(h << 16); }
__device__ __forceinline__ float bflo(unsigned w) { return __uint_as_float(w << 16); }
__device__ __forceinline__ float bfhi(unsigned w) { return __uint_as_float(w & 0xffff0000u); }
__device__ __forceinline__ float wave_sum(float v) {
#pragma unroll
    for (int o = 32; o >= 1; o >>= 1) v += __shfl_xor(v, o, 64);
    return v;
}

#define XB_TMO      128
#define XB_XCNT(j)  (256  + 64 * (j))
#define XB_XSUB(j)  (1280 + 64 * (j))
#define XB_XGEN(j)  (2304 + 64 * (j))
#define XB_TOP      3328
#define XB_TOPGEN   3392
#define XCD_BAR_WORDS 3456
#define XB_SPIN_CAP (1u << 22)
#define LAS __attribute__((address_space(3)))

__device__ __forceinline__ unsigned xb_ld(unsigned* p)              { return __hip_atomic_load(p, __ATOMIC_RELAXED, __HIP_MEMORY_SCOPE_AGENT); }
__device__ __forceinline__ unsigned xb_add(unsigned* p, unsigned v) { return __hip_atomic_fetch_add(p, v, __ATOMIC_RELAXED, __HIP_MEMORY_SCOPE_AGENT); }
__device__ __forceinline__ unsigned xb_xcc_id() { return (unsigned)__builtin_amdgcn_s_getreg((3 << 11) | 20) & 0xFu; }
#define XB_SPIN(cond, bar) do { unsigned _sp = 0; while (cond) { __builtin_amdgcn_s_sleep(1); \
    if ((++_sp & 255u) == 0u) { if (xb_ld(&(bar)[XB_TMO])) break; if (_sp > XB_SPIN_CAP) { atomicAdd(&(bar)[XB_TMO], 1u); break; } } } } while (0)

struct XcdBarrier { unsigned* bar; unsigned x; volatile LAS unsigned* st; };

__device__ __forceinline__ XcdBarrier xcd_barrier_post(unsigned* bar, volatile LAS unsigned* st) {
    XcdBarrier b; b.bar = bar; b.x = xb_xcc_id(); b.st = st;
    if (threadIdx.x == 0) (void)xb_add(&bar[XB_XCNT(b.x)], 1u);
    return b;
}
__device__ __forceinline__ void xcd_barrier_complete(unsigned* bar, unsigned x, unsigned& nloc, unsigned& nx) {
    const unsigned G = gridDim.x * gridDim.y * gridDim.z;
    unsigned sum, cnt, mine, sp = 0u;
    for (;;) {
        sum = 0u; cnt = 0u; mine = 0u;
#pragma unroll
        for (unsigned j = 0; j < 16; ++j) { const unsigned c = xb_ld(&bar[XB_XCNT(j)]); sum += c; cnt += (c > 0u) ? 1u : 0u; mine = (j == x) ? c : mine; }
        if (sum == G) break;
        __builtin_amdgcn_s_sleep(1);
        if ((++sp & 255u) == 0u) { if (xb_ld(&bar[XB_TMO])) break; if (sp > XB_SPIN_CAP) { atomicAdd(&bar[XB_TMO], 1u); break; } }
    }
    nloc = mine > 0u ? mine : 1u; nx = cnt > 0u ? cnt : 1u;
}
__device__ __forceinline__ void xcd_barrier(const XcdBarrier& b) {
    asm volatile("s_waitcnt vmcnt(0)" ::: "memory");
    __syncthreads();
    if (threadIdx.x == 0) {
        unsigned* bar = b.bar;
        __builtin_amdgcn_s_waitcnt(0);
        unsigned nloc = b.st[0], nx = b.st[1];
        if (nloc == 0u) { xcd_barrier_complete(bar, b.x, nloc, nx); b.st[0] = nloc; b.st[1] = nx; }
        const unsigned old = xb_add(&bar[XB_XSUB(b.x)], 1u);
        const unsigned gen = old / nloc;
        if (old + 1u == (gen + 1u) * nloc) {
            __builtin_amdgcn_fence(__ATOMIC_RELEASE, "agent");
            asm volatile("s_waitcnt vmcnt(0)" ::: "memory");
            const unsigned og = xb_add(&bar[XB_TOP], 1u);
            const unsigned tg = og / nx;
            if (og + 1u == (tg + 1u) * nx) xb_add(&bar[XB_TOPGEN], 1u);
            else XB_SPIN(xb_ld(&bar[XB_TOPGEN]) == tg, bar);
            __builtin_amdgcn_fence(__ATOMIC_ACQUIRE, "agent");
            xb_add(&bar[XB_XGEN(b.x)], 1u);
            asm volatile("s_waitcnt vmcnt(0)" ::: "memory");
        } else {
            XB_SPIN(xb_ld(&bar[XB_XGEN(b.x)]) == gen, bar);
            __builtin_amdgcn_fence(__ATOMIC_ACQUIRE, "agent");
            asm volatile("s_waitcnt vmcnt(0)" ::: "memory");
        }
    }
    __syncthreads();
}

struct Args {
    const float* in[23];
    float* out;
    unsigned char* ws;
    int ph_lo, ph_hi;
};

struct GemmThread {
    int a_w0;
    int b_w0;
    int a_r, b_r;
    int c8;
    int r0;
    int kg, ng;
    int wm, wn, l15, lq;
    int arow0, achunk;
    int rrow0, rchunk;
    int rfr;
    int imgw0;
    int f8r0, f8r1;
    int f8w0;
    int s8r0, s8r1;
};
__host__ __device__ constexpr int sw4(int c) { return (0x9C >> (2 * c)) & 3; }
__host__ __device__ constexpr int sw4inv(int p) { return (0x78 >> (2 * p)) & 3; }
template <bool OPQ = false>
__device__ __forceinline__ GemmThread gemm_thread_init() {
    GemmThread g;
    int tid = threadIdx.x; if (OPQ) asm volatile("" : "+v"(tid));
    const int lane = tid & 63, wave = __builtin_amdgcn_readfirstlane(tid >> 6);
    const int c = tid & 7; g.r0 = tid >> 3; g.c8 = c * 8;
    g.a_w0 = g.r0 * 128 + ((c ^ (g.r0 & 7)) << 4);
    g.kg = lane & 7; g.ng = (lane >> 3) + 8 * wave;
    g.b_w0 = 32768 + (4 * g.ng) * 128 + ((g.kg ^ ((4 * g.ng) & 7)) << 4);
    g.wm = wave >> 1; g.wn = wave & 1; g.l15 = lane & 15; g.lq = lane >> 4;
    const int sw = ((g.lq ^ (g.l15 & 7)) << 4);
    g.a_r = (64 * g.wm + g.l15) * 128 + sw;
    g.b_r = 32768 + (128 * g.wn + g.l15) * 128 + sw;
    g.arow0 = 32 * wave + (lane >> 3); g.achunk = ((lane & 7) ^ (lane >> 3)) * 16;
    g.rrow0 = 32 * wave + (lane >> 2); g.rchunk = sw4inv((lane & 3) ^ ((lane >> 4) & 3)) * 16;
    g.rfr = g.l15 * 64 + ((((g.l15 >> 2) & 3) ^ sw4(g.lq)) << 4);
    g.imgw0 = (g.kg >> 2) * 16384 + (4 * g.ng) * 64 + (((g.ng & 3) ^ sw4(g.kg & 3)) << 4);
    g.f8r0 = g.l15 * 64 + ((((g.l15 >> 2) & 3) ^ sw4(g.lq >> 1)) << 4) + 8 * (g.lq & 1);
    g.f8r1 = g.l15 * 64 + ((((g.l15 >> 2) & 3) ^ sw4(2 + (g.lq >> 1))) << 4) + 8 * (g.lq & 1);
    g.f8w0 = (4 * g.ng) * 64 + (((g.ng & 3) ^ sw4(g.kg >> 1)) << 4) + 8 * (g.kg & 1);
    { const int r32 = lane & 31, hh = lane >> 5, qq = (r32 >> 2) & 3;
      const int c0 = S8_KMAP ? hh : 2 * hh, c1 = S8_KMAP ? 2 + hh : 2 * hh + 1;
      g.s8r0 = r32 * 64 + ((qq ^ sw4(c0)) << 4); g.s8r1 = r32 * 64 + ((qq ^ sw4(c1)) << 4); }
    return g;
}

template <class T> __device__ __forceinline__ T* sgpr_ptr(T* p) {
    const unsigned long long v = (unsigned long long)p;
    const unsigned lo = __builtin_amdgcn_readfirstlane((unsigned)v), hi = __builtin_amdgcn_readfirstlane((unsigned)(v >> 32));
    typedef __attribute__((address_space(1))) T* gptr_t;
    return (T*)(gptr_t)(((unsigned long long)hi << 32) | lo);
}
__device__ __forceinline__ f32x4 ld_nt_async(const char* sbase, unsigned voff) {
    f32x4 r; asm volatile("global_load_dwordx4 %0, %1, %2 nt" : "=v"(r) : "v"(voff), "s"(sbase) : "memory"); return r;
}
#define RB_PIN(WAITSTR, RB) asm volatile(WAITSTR : "+v"(RB[0]), "+v"(RB[1]), "+v"(RB[2]), "+v"(RB[3]), "+v"(RB[4]), "+v"(RB[5]), "+v"(RB[6]), "+v"(RB[7]) :: "memory")
__device__ __forceinline__ void glds16(const void* src, char* lds_wave_base) {
    __builtin_amdgcn_global_load_lds((const unsigned*)src, (LAS unsigned*)lds_wave_base, 16, 0, 0);
}
#define G_AF(ks)  _Pragma("unroll") for (int i_ = 0; i_ < 4; ++i_) af[i_] = *(const bf16x8*)(sb + ((g.a_r ^ ((ks) << 6)) + i_ * 2048));
#define G_BF(ks, jh) _Pragma("unroll") for (int j_ = 0; j_ < 4; ++j_) bfr[j_] = *(const bf16x8*)(sb + ((g.b_r ^ ((ks) << 6)) + ((jh) * 4 + j_) * 2048));
#define G_MM(jh) _Pragma("unroll") for (int j_ = 0; j_ < 4; ++j_) _Pragma("unroll") for (int i_ = 0; i_ < 4; ++i_) \
        acc[i_][(jh) * 4 + j_] = __builtin_amdgcn_mfma_f32_16x16x32_bf16(bfr[j_], af[i_], acc[i_][(jh) * 4 + j_], 0, 0, 0);
#define G_WRB(sn, j_) do { u32x4 w_; \
        w_[0] = cvt_pk_bf16(rb[0][j_], rb[1][j_]); w_[1] = cvt_pk_bf16(rb[2][j_], rb[3][j_]); \
        w_[2] = cvt_pk_bf16(rb[4][j_], rb[5][j_]); w_[3] = cvt_pk_bf16(rb[6][j_], rb[7][j_]); \
        *(u32x4*)((sn) + (bw0_ ^ ((j_) * 0x90))) = w_; \
        if (IMG) *(u32x4*)(imgk + g.imgw0 + (j_) * 64) = w_; } while (0)
template <bool TWO_SEG, bool WR, bool LD, bool IMG>
__device__ __forceinline__ void gemm_step(f32x4 (&acc)[4][8], char* lds, const GemmThread& g, const int wave, f32x4 (&rb)[8], const int kt,
                                          const char* Abase, const unsigned (&aoffb)[4], const char* Bbase, const unsigned boffb, const int ldbB,
                                          const char* Abase2, const char* Bbase2, const int nk1, char* img) {
    asm volatile("s_waitcnt vmcnt(0)" ::: "memory");
    __syncthreads();
    const char* sb = lds + (kt & 1) * 65536; char* sn = lds + ((kt + 1) & 1) * 65536;
    char* imgk = img + (size_t)(kt + 1) * 32768;
    if (WR) {
        const int k1 = kt + 1; const bool s1 = TWO_SEG && k1 >= nk1; const char* ak = (s1 ? Abase2 : Abase) + (size_t)(s1 ? k1 - nk1 : k1) * 128;
#pragma unroll
        for (int i = 0; i < 4; ++i) glds16(ak + aoffb[i], sn + (4 * wave + i) * 1024);
    }
    int bw0_ = g.b_w0; asm volatile("" : "+v"(bw0_));
    bf16x8 af[4], bfr[4];
    G_AF(0) G_BF(0, 0) G_MM(0)
    if (WR) { G_WRB(sn, 0); G_WRB(sn, 1); }
    __builtin_amdgcn_sched_barrier(0);
    G_BF(0, 1) G_MM(1)
    if (WR) { G_WRB(sn, 2); G_WRB(sn, 3); }
    if (LD) {
        const int k2 = kt + 2; const bool s2 = TWO_SEG && k2 >= nk1; const int kk = s2 ? k2 - nk1 : k2;
        const char* bk = (s2 ? Bbase2 : Bbase) + (size_t)kk * 64 * ldbB;
#pragma unroll
        for (int k = 0; k < 8; ++k) rb[k] = *(const f32x4*)(bk + (size_t)k * ldbB + boffb);
    }
    __builtin_amdgcn_sched_barrier(0);
    G_AF(1) G_BF(1, 0) G_MM(0)
    __builtin_amdgcn_sched_barrier(0);
    G_BF(1, 1) G_MM(1)
}

template <bool TWO_SEG = false, bool IMG = false>
__device__ __forceinline__ void gemm_accum(f32x4 (&acc)[4][8], char* lds, const GemmThread& g, const int wave,
                                           const char* Abase, const unsigned (&aoffb)[4],
                                           const char* Bbase, const unsigned boffb, const int ldbB, const int nk,
                                           const char* Abase2 = nullptr, const char* Bbase2 = nullptr, const int nk1 = 0, char* img = nullptr) {
    f32x4 rb[8];
#define G_LOADB(kt) do { const char* bk_ = Bbase + (size_t)(kt) * 64 * ldbB; \
        _Pragma("unroll") for (int k_ = 0; k_ < 8; ++k_) rb[k_] = *(const f32x4*)(bk_ + (size_t)k_ * ldbB + boffb); } while (0)
#pragma unroll
    for (int i = 0; i < 4; ++i) glds16(Abase + aoffb[i], lds + (4 * wave + i) * 1024);
    G_LOADB(0);
    { char* sn = lds; char* imgk = img; const int bw0_ = g.b_w0; G_WRB(sn, 0); G_WRB(sn, 1); G_WRB(sn, 2); G_WRB(sn, 3); }
    G_LOADB(1);
    for (int kt = 0; kt < nk - 2; ++kt) gemm_step<TWO_SEG, true, true, IMG>(acc, lds, g, wave, rb, kt, Abase, aoffb, Bbase, boffb, ldbB, Abase2, Bbase2, nk1, img);
    gemm_step<TWO_SEG, true, false, IMG>(acc, lds, g, wave, rb, nk - 2, Abase, aoffb, Bbase, boffb, ldbB, Abase2, Bbase2, nk1, img);
    gemm_step<TWO_SEG, false, false, IMG>(acc, lds, g, wave, rb, nk - 1, Abase, aoffb, Bbase, boffb, ldbB, Abase2, Bbase2, nk1, img);
    __syncthreads();
#undef G_LOADB
}

#define R_MMJ(AF, BF, jh, j) do { _Pragma("unroll") for (int i_ = 0; i_ < 4; ++i_) \
        acc[i_][(jh) * 4 + (j)] = __builtin_amdgcn_mfma_f32_16x16x32_bf16(BF[j], AF[i_], acc[i_][(jh) * 4 + (j)], 0, 0, 0); } while (0)
#define R_SB() __builtin_amdgcn_sched_barrier(0)
#define R_MMI(AF, BF, i) do { _Pragma("unroll") for (int j_ = 0; j_ < 4; ++j_) \
        acc[i][4 + j_] = __builtin_amdgcn_mfma_f32_16x16x32_bf16(BF[j_], AF[i], acc[i][4 + j_], 0, 0, 0); } while (0)
__device__ __forceinline__ void gemm_accum_ring(f32x4 (&acc)[4][8], char* lds, const GemmThread& g, const int wave, const int lane,
                                                const char* Abase, const unsigned (&aoffb)[2], const char* Bimg, const int nk) {
    const unsigned boffl = (unsigned)wave * 2048u + (unsigned)lane * 16u;
    const int NS = 2 * nk;
    const int saoff = g.rfr + (64 * g.wm) * 64, sboff = 16384 + g.rfr + (128 * g.wn) * 64;
#pragma unroll
    for (int s = 0; s < 4; ++s) { char* sd = lds + s * 32768 + wave * 2048; const char* ak = sgpr_ptr(Abase + (size_t)s * 64); const char* bk = sgpr_ptr(Bimg + (size_t)s * 16384);
        glds16(ak + aoffb[0], sd); glds16(bk + boffl, sd + 16384); glds16(ak + aoffb[1], sd + 1024); glds16(bk + (boffl + 1024u), sd + 16384 + 1024); }
    asm volatile("s_waitcnt vmcnt(12)" ::: "memory");
    __builtin_amdgcn_s_barrier();
    asm volatile("" ::: "memory");
    bf16x8 a0[4], b0[4], b1[4];
#pragma unroll
    for (int i = 0; i < 4; ++i) a0[i] = *(const bf16x8*)(lds + saoff + i * 1024);
#pragma unroll
    for (int j = 0; j < 4; ++j) b0[j] = *(const bf16x8*)(lds + sboff + j * 1024);
#pragma unroll
    for (int j = 0; j < 4; ++j) b1[j] = *(const bf16x8*)(lds + sboff + (4 + j) * 1024);
#pragma unroll 1
    for (int s = 0; s < NS; ++s) {
        R_MMJ(a0, b0, 0, 0); R_MMJ(a0, b0, 0, 1); R_MMJ(a0, b0, 0, 2); R_MMJ(a0, b0, 0, 3);
        R_SB();
        asm volatile("s_waitcnt vmcnt(8)" ::: "memory");
        asm volatile("s_waitcnt lgkmcnt(0)" ::: "memory");
        __builtin_amdgcn_s_barrier();
        asm volatile("" ::: "memory");
        const bool ld = s + 4 < NS;
        const char* sn = lds + ((s + 1) & 3) * 32768;
        char* sd = lds + (s & 3) * 32768 + wave * 2048;
        const char* ak = sgpr_ptr(ld ? Abase + (size_t)(s + 4) * 64 : Bimg); const char* bk = sgpr_ptr(ld ? Bimg + (size_t)(s + 4) * 16384 : Bimg);
        const char* p0 = ak + (ld ? aoffb[0] : 0u); const char* p1 = bk + (ld ? boffl : 0u); const char* p2 = ak + (ld ? aoffb[1] : 0u); const char* p3 = bk + (ld ? boffl + 1024u : 0u);
#pragma unroll
        for (int j = 0; j < 4; ++j) b0[j] = *(const bf16x8*)(sn + sboff + j * 1024);
        glds16(p0, sd); R_SB();
        R_MMI(a0, b1, 0); R_SB();
        a0[0] = *(const bf16x8*)(sn + saoff); glds16(p1, sd + 16384); R_SB();
        R_MMI(a0, b1, 1); R_SB();
        a0[1] = *(const bf16x8*)(sn + saoff + 1024); glds16(p2, sd + 1024); R_SB();
        R_MMI(a0, b1, 2); R_SB();
        a0[2] = *(const bf16x8*)(sn + saoff + 2048); glds16(p3, sd + 16384 + 1024); R_SB();
        R_MMI(a0, b1, 3); R_SB();
        a0[3] = *(const bf16x8*)(sn + saoff + 3072);
#pragma unroll
        for (int j = 0; j < 4; ++j) b1[j] = *(const bf16x8*)(sn + sboff + (4 + j) * 1024);
        R_SB();
    }
    __syncthreads();
}

typedef long f8x8;
__device__ __forceinline__ unsigned cvt4_fp8(float a, float b, float c, float d) {
    unsigned w = 0; w = __builtin_amdgcn_cvt_pk_fp8_f32(a, b, w, false); w = __builtin_amdgcn_cvt_pk_fp8_f32(c, d, w, true); return w;
}
#define F8_RA(AF, off) _Pragma("unroll") for (int i_ = 0; i_ < 4; ++i_) AF[i_] = *(const f8x8*)(sa + (off) + i_ * 1024);
#define F8_RB(BF, off) _Pragma("unroll") for (int j_ = 0; j_ < 8; ++j_) BF[j_] = *(const f8x8*)(sbb + (off) + j_ * 1024);
#define F8_MMJ(AF, BF, j) do { _Pragma("unroll") for (int i_ = 0; i_ < 4; ++i_) \
        acc[i_][j] = __builtin_amdgcn_mfma_f32_16x16x32_fp8_fp8(BF[j], AF[i_], acc[i_][j], 0, 0, 0); } while (0)
template <int WAITN, bool LD>
__device__ __forceinline__ void f8_ring_step(f32x4 (&acc)[4][8], char* lds, const GemmThread& g, const int wave, const int s,
                                             const char* Abase, const unsigned (&aoffb)[2], const char* Bimg, const unsigned boffl) {
    if (WAITN == 8) asm volatile("s_waitcnt vmcnt(8)" ::: "memory"); else if (WAITN == 4) asm volatile("s_waitcnt vmcnt(4)" ::: "memory"); else asm volatile("s_waitcnt vmcnt(0)" ::: "memory");
    asm volatile("s_waitcnt lgkmcnt(0)" ::: "memory");
    __builtin_amdgcn_s_barrier();
    asm volatile("" ::: "memory");
    const char* sa = lds + (s & 3) * 32768 + (64 * g.wm) * 64; const char* sbb = lds + (s & 3) * 32768 + 16384 + (128 * g.wn) * 64;
    char* sd = lds + ((s + 3) & 3) * 32768 + wave * 2048;
    const char* ak = Abase + (size_t)(s + 3) * 64; const char* bk = Bimg + (size_t)(s + 3) * 16384 + boffl;
    f8x8 a0[4], b0[8], a1[4], b1[8];
    F8_RA(a0, g.f8r0) F8_RB(b0, g.f8r0)
    R_SB();
    F8_MMJ(a0, b0, 0); R_SB(); if (LD) glds16(ak + aoffb[0], sd); R_SB();
    F8_MMJ(a0, b0, 1); R_SB(); if (LD) glds16(bk, sd + 16384); R_SB();
    F8_MMJ(a0, b0, 2); R_SB(); if (LD) glds16(ak + aoffb[1], sd + 1024); R_SB();
    F8_MMJ(a0, b0, 3); R_SB(); if (LD) glds16(bk + 1024, sd + 16384 + 1024); R_SB();
    F8_RA(a1, g.f8r1) F8_RB(b1, g.f8r1)
    R_SB();
    F8_MMJ(a0, b0, 4); F8_MMJ(a0, b0, 5); F8_MMJ(a0, b0, 6); F8_MMJ(a0, b0, 7);
    R_SB();
    F8_MMJ(a1, b1, 0); F8_MMJ(a1, b1, 1); F8_MMJ(a1, b1, 2); F8_MMJ(a1, b1, 3); F8_MMJ(a1, b1, 4); F8_MMJ(a1, b1, 5); F8_MMJ(a1, b1, 6); F8_MMJ(a1, b1, 7);
}
__device__ __forceinline__ void f8_accum_ring(f32x4 (&acc)[4][8], char* lds, const GemmThread& g, const int wave, const int lane,
                                              const char* Abase, const unsigned (&aoffb)[2], const char* Bimg, const int nk) {
    const unsigned boffl = (unsigned)wave * 2048u + (unsigned)lane * 16u;
#pragma unroll
    for (int s = 0; s < 3; ++s) { char* sd = lds + s * 32768 + wave * 2048; const char* ak = Abase + (size_t)s * 64; const char* bk = Bimg + (size_t)s * 16384 + boffl;
        glds16(ak + aoffb[0], sd); glds16(bk, sd + 16384); glds16(ak + aoffb[1], sd + 1024); glds16(bk + 1024, sd + 16384 + 1024); }
    for (int s = 0; s < nk - 3; ++s) f8_ring_step<8, true>(acc, lds, g, wave, s, Abase, aoffb, Bimg, boffl);
    f8_ring_step<8, false>(acc, lds, g, wave, nk - 3, Abase, aoffb, Bimg, boffl);
    f8_ring_step<4, false>(acc, lds, g, wave, nk - 2, Abase, aoffb, Bimg, boffl);
    f8_ring_step<0, false>(acc, lds, g, wave, nk - 1, Abase, aoffb, Bimg, boffl);
    __syncthreads();
}
typedef int i32x8 __attribute__((ext_vector_type(8)));
typedef int i32x4 __attribute__((ext_vector_type(4)));
__device__ __forceinline__ i32x8 s8_frag(const char* p0, const char* p1) {
    const i32x4 lo = *(const i32x4*)p0, hi = *(const i32x4*)p1;
    return __builtin_shufflevector(lo, hi, 0, 1, 2, 3, 4, 5, 6, 7);
}
#define S8_MM(i, j) acc[i][j] = __builtin_amdgcn_mfma_scale_f32_32x32x64_f8f6f4(bf[j], af[i], acc[i][j], 0, 0, 0, 0x7F7F7F7F, 0, 0x7F7F7F7F)
#define S8_FR(base) s8_frag((base) + g.s8r0, (base) + g.s8r1)
__device__ __forceinline__ void s8_accum_ring(f32x16 (&acc)[2][4], char* lds, const GemmThread& g, const int wave, const int lane,
                                              const char* Abase, const unsigned (&aoffb)[2], const char* Bimg, const int nk, const unsigned astr = 64) {
    const unsigned boffl = (unsigned)wave * 2048u + (unsigned)lane * 16u;
    const int saoff = (64 * g.wm) * 64, sboff = 16384 + (128 * g.wn) * 64;
#pragma unroll
    for (int s = 0; s < 4; ++s) { char* sd = lds + s * 32768 + wave * 2048; const char* ak = sgpr_ptr(Abase + (size_t)s * astr); const char* bk = sgpr_ptr(Bimg + (size_t)s * 16384);
        glds16(ak + aoffb[0], sd); glds16(bk + boffl, sd + 16384); glds16(ak + aoffb[1], sd + 1024); glds16(bk + (boffl + 1024u), sd + 16384 + 1024); }
    asm volatile("s_waitcnt vmcnt(12)" ::: "memory");
    __builtin_amdgcn_s_barrier();
    asm volatile("" ::: "memory");
    i32x8 af[2], bf[4];
    af[0] = S8_FR(lds + saoff);
#pragma unroll
    for (int j = 0; j < 4; ++j) bf[j] = S8_FR(lds + sboff + j * 2048);
    af[1] = S8_FR(lds + saoff + 2048);
#pragma unroll 1
    for (int s = 0; s < nk; ++s) {
        S8_MM(0, 0); S8_MM(0, 1); S8_MM(0, 2); S8_MM(0, 3);
        R_SB();
        asm volatile("s_waitcnt vmcnt(8)" ::: "memory");
        asm volatile("s_waitcnt lgkmcnt(0)" ::: "memory");
        __builtin_amdgcn_s_barrier();
        asm volatile("" ::: "memory");
        const bool ld = s + 4 < nk;
        const char* sn = lds + ((s + 1) & 3) * 32768;
        char* sd = lds + (s & 3) * 32768 + wave * 2048;
        const char* ak = sgpr_ptr(ld ? Abase + (size_t)(s + 4) * astr : Bimg); const char* bk = sgpr_ptr(ld ? Bimg + (size_t)(s + 4) * 16384 : Bimg);
        const char* p0 = ak + (ld ? aoffb[0] : 0u); const char* p1 = bk + (ld ? boffl : 0u); const char* p2 = ak + (ld ? aoffb[1] : 0u); const char* p3 = bk + (ld ? boffl + 1024u : 0u);
        af[0] = S8_FR(sn + saoff); glds16(p0, sd); R_SB();
        S8_MM(1, 0); R_SB();
        bf[0] = S8_FR(sn + sboff); glds16(p1, sd + 16384); R_SB();
        S8_MM(1, 1); R_SB();
        bf[1] = S8_FR(sn + sboff + 2048); glds16(p2, sd + 1024); R_SB();
        S8_MM(1, 2); R_SB();
        bf[2] = S8_FR(sn + sboff + 4096); glds16(p3, sd + 16384 + 1024); R_SB();
        S8_MM(1, 3); R_SB();
        bf[3] = S8_FR(sn + sboff + 6144); af[1] = S8_FR(sn + saoff + 2048); R_SB();
    }
    __syncthreads();
}
__device__ __forceinline__ void s8_accum_ring_h(f32x16 (&acc)[2][2], char* lds, const GemmThread& g, const int wave, const int lane,
                                                const char* Abase, const unsigned (&aoffb)[2], const char* Bimg, const int nk, const unsigned astr) {
    const unsigned boffl = (unsigned)wave * 1024u + (unsigned)lane * 16u;
    const int saoff = (64 * g.wm) * 64, sboff = 16384 + (64 * g.wn) * 64;
#pragma unroll
    for (int s = 0; s < 4; ++s) { char* sd = lds + s * 32768; const char* ak = Abase + (size_t)s * astr; const char* bk = Bimg + (size_t)s * 16384 + boffl;
        glds16(ak + aoffb[0], sd + wave * 2048); glds16(bk, sd + 16384 + wave * 1024); glds16(ak + aoffb[1], sd + wave * 2048 + 1024); }
    asm volatile("s_waitcnt vmcnt(9)" ::: "memory");
    __builtin_amdgcn_s_barrier();
    asm volatile("" ::: "memory");
    i32x8 af[2], bf[2];
    af[0] = S8_FR(lds + saoff); bf[0] = S8_FR(lds + sboff); bf[1] = S8_FR(lds + sboff + 2048); af[1] = S8_FR(lds + saoff + 2048);
#pragma unroll 1
    for (int s = 0; s < nk; ++s) {
        S8_MM(0, 0); S8_MM(0, 1);
        R_SB();
        asm volatile("s_waitcnt vmcnt(6)" ::: "memory");
        asm volatile("s_waitcnt lgkmcnt(0)" ::: "memory");
        __builtin_amdgcn_s_barrier();
        asm volatile("" ::: "memory");
        const bool ld = s + 4 < nk;
        const char* sn = lds + ((s + 1) & 3) * 32768;
        char* sd = lds + (s & 3) * 32768;
        const char* ak = Abase + (size_t)(s + 4) * astr; const char* bk = Bimg + (size_t)(s + 4) * 16384 + boffl;
        const char* p0 = ld ? ak + aoffb[0] : Bimg; const char* p1 = ld ? bk : Bimg; const char* p2 = ld ? ak + aoffb[1] : Bimg;
        af[0] = S8_FR(sn + saoff); glds16(p0, sd + wave * 2048); R_SB();
        S8_MM(1, 0); R_SB();
        bf[0] = S8_FR(sn + sboff); glds16(p1, sd + 16384 + wave * 1024); R_SB();
        S8_MM(1, 1); R_SB();
        bf[1] = S8_FR(sn + sboff + 2048); af[1] = S8_FR(sn + saoff + 2048); glds16(p2, sd + wave * 2048 + 1024); R_SB();
    }
    __syncthreads();
}
#define F8_WRB(sn, j_) do { u32x2 w_; \
        w_[0] = cvt4_fp8(rb[0][j_] * FP8_SW, rb[1][j_] * FP8_SW, rb[2][j_] * FP8_SW, rb[3][j_] * FP8_SW); \
        w_[1] = cvt4_fp8(rb[4][j_] * FP8_SW, rb[5][j_] * FP8_SW, rb[6][j_] * FP8_SW, rb[7][j_] * FP8_SW); \
        *(u32x2*)((sn) + 16384 + bw8_ + (j_) * 64) = w_; } while (0)
template <bool WR, bool LD, bool W8>
__device__ __forceinline__ void f8_w32_step(f32x4 (&acc)[4][8], char* lds, const GemmThread& g, const int wave, f32x4 (&rb)[8], const int kt,
                                            const char* Abase, const unsigned (&aoffb)[2], const char* Bbase, const unsigned boffb, const int ldbB, char* img, const unsigned astr) {
    if (WR) { if (W8) RB_PIN("s_waitcnt vmcnt(8)", rb); else RB_PIN("s_waitcnt vmcnt(0)", rb); }
    else { if (W8) asm volatile("s_waitcnt vmcnt(8)" ::: "memory"); else asm volatile("s_waitcnt vmcnt(0)" ::: "memory"); }
    asm volatile("s_waitcnt lgkmcnt(0)" ::: "memory");
    __builtin_amdgcn_s_barrier();
    asm volatile("" ::: "memory");
    const char* sa = lds + (kt & 1) * 32768 + (64 * g.wm) * 64; const char* sbb = lds + (kt & 1) * 32768 + 16384 + (128 * g.wn) * 64;
    char* sn = lds + ((kt + 1) & 1) * 32768;
    if (WR) { const char* ak = Abase + (size_t)(kt + 1) * astr; glds16(ak + aoffb[0], sn + (2 * wave) * 1024); glds16(ak + aoffb[1], sn + (2 * wave + 1) * 1024); }
    {
        int to = (int)threadIdx.x * 16; asm volatile("" : "+v"(to));
        const char* sbi = lds + (kt & 1) * 32768 + 16384; char* imgk = img + (size_t)kt * 16384;
        const u32x4 i0 = *(const u32x4*)(sbi + to), i1 = *(const u32x4*)(sbi + 8192 + to);
        *(u32x4*)(imgk + to) = i0; *(u32x4*)(imgk + 8192 + to) = i1; }
    int bw8_ = g.f8w0; asm volatile("" : "+v"(bw8_));
    f8x8 a0[4], b0[8];
    F8_RA(a0, g.f8r0) F8_RB(b0, g.f8r0)
    F8_MMJ(a0, b0, 0); F8_MMJ(a0, b0, 1); F8_MMJ(a0, b0, 2); F8_MMJ(a0, b0, 3);
    if (WR) { F8_WRB(sn, 0); F8_WRB(sn, 1); }
    __builtin_amdgcn_sched_barrier(0);
    F8_MMJ(a0, b0, 4); F8_MMJ(a0, b0, 5); F8_MMJ(a0, b0, 6); F8_MMJ(a0, b0, 7);
    if (WR) { F8_WRB(sn, 2); F8_WRB(sn, 3); }
    if (LD) { const char* bk = Bbase + (size_t)(kt + 3) * 64 * ldbB;
#pragma unroll
        for (int k = 0; k < 8; ++k) rb[k] = ld_nt_async(sgpr_ptr(bk + (size_t)k * ldbB), boffb); }
    __builtin_amdgcn_sched_barrier(0);
    F8_RA(a0, g.f8r1) F8_RB(b0, g.f8r1)
    F8_MMJ(a0, b0, 0); F8_MMJ(a0, b0, 1); F8_MMJ(a0, b0, 2); F8_MMJ(a0, b0, 3);
    __builtin_amdgcn_sched_barrier(0);
    F8_MMJ(a0, b0, 4); F8_MMJ(a0, b0, 5); F8_MMJ(a0, b0, 6); F8_MMJ(a0, b0, 7);
}
__device__ __forceinline__ void f8_accum_w32(f32x4 (&acc)[4][8], char* lds, const GemmThread& g, const int wave,
                                             const char* Abase, const unsigned (&aoffb)[2], const char* Bbase, const unsigned boffb, const int ldbB, const int nk, char* img, const unsigned astr = 64) {
    f32x4 rbA[8], rbB[8];
#define F8_LOADB(RB, kt) do { const char* bk_ = Bbase + (size_t)(kt) * 64 * ldbB; \
        _Pragma("unroll") for (int k_ = 0; k_ < 8; ++k_) RB[k_] = ld_nt_async(sgpr_ptr(bk_ + (size_t)k_ * ldbB), boffb); } while (0)
    glds16(Abase + aoffb[0], lds + (2 * wave) * 1024); glds16(Abase + aoffb[1], lds + (2 * wave + 1) * 1024);
    F8_LOADB(rbA, 0);
    RB_PIN("s_waitcnt vmcnt(0)", rbA);
    { f32x4 (&rb)[8] = rbA; char* sn = lds; const int bw8_ = g.f8w0; F8_WRB(sn, 0); F8_WRB(sn, 1); F8_WRB(sn, 2); F8_WRB(sn, 3); }
    F8_LOADB(rbA, 1);
    F8_LOADB(rbB, 2);
#pragma unroll 1
    for (int kt = 0; kt < nk - 4; kt += 2) {
        f8_w32_step<true, true, true>(acc, lds, g, wave, rbA, kt, Abase, aoffb, Bbase, boffb, ldbB, img, astr);
        f8_w32_step<true, true, true>(acc, lds, g, wave, rbB, kt + 1, Abase, aoffb, Bbase, boffb, ldbB, img, astr);
    }
    f8_w32_step<true, true, true>(acc, lds, g, wave, rbA, nk - 4, Abase, aoffb, Bbase, boffb, ldbB, img, astr);
    f8_w32_step<true, false, true>(acc, lds, g, wave, rbB, nk - 3, Abase, aoffb, Bbase, boffb, ldbB, img, astr);
    f8_w32_step<true, false, false>(acc, lds, g, wave, rbA, nk - 2, Abase, aoffb, Bbase, boffb, ldbB, img, astr);
    f8_w32_step<false, false, false>(acc, lds, g, wave, rbB, nk - 1, Abase, aoffb, Bbase, boffb, ldbB, img, astr);
    __syncthreads();
#undef F8_LOADB
}

struct EpiLane { int l15, lq, wm, wn; };
__device__ __forceinline__ EpiLane epi_lane(const GemmThread& g) { EpiLane e; e.l15 = g.l15; e.lq = g.lq; e.wm = g.wm; e.wn = g.wn; asm volatile("" : "+v"(e.l15), "+v"(e.lq)); return e; }
constexpr int STG_PITCH = 272, STG_WAVE = 64 * STG_PITCH;
#define stg_base(F) ((F).lds + (F).wave * STG_WAVE)
__device__ __forceinline__ void stg_put(char* tw, const EpiLane& el, int i, int j, u32x2 w) { *(u32x2*)(tw + (16 * i + el.l15) * STG_PITCH + (16 * j + 4 * el.lq) * 2) = w; }
__device__ __forceinline__ void stg_flush_(int lane, char* tw, bf16_t* dst, size_t ld) {
    int ln = lane; asm volatile("" : "+v"(ln));
#pragma unroll 4
    for (int q = 0; q < 16; ++q) { const int rl = q * 4 + (ln >> 4), chunk = ln & 15;
        *(u32x4*)(dst + (size_t)rl * ld + chunk * 8) = *(const u32x4*)(tw + rl * STG_PITCH + chunk * 16); }
    __syncthreads();
}
#define stg_flush(F, tw, dst, ld) stg_flush_((F).lane, tw, dst, ld)
__device__ __forceinline__ void acc_zero(f32x4 (&acc)[4][8]) {
#pragma unroll
    for (int i = 0; i < 4; ++i)
#pragma unroll
        for (int j = 0; j < 8; ++j) acc[i][j] = (f32x4){0.f, 0.f, 0.f, 0.f};
}
__device__ __forceinline__ bool patch_unit(int u, int nMt, int nNt, int& mt, int& nt) {
    const int pM = nMt / 8, p = u >> 5, q = u & 31;
    mt = (p % pM) * 8 + (q & 7); nt = (p / pM) * 4 + (q >> 3);
    return nt < nNt;
}
__device__ __forceinline__ int vcu_of_block(int bx, int G) { return (G % 8 == 0) ? (bx % 8) * (G / 8) + bx / 8 : bx; }

namespace attn {
constexpr int D = 128, NW = 8, QBLK = 32, KVBLK = 64;
constexpr float SCALE = 0.088388347648318440f;
constexpr float THR = 8.f;
constexpr int LDQ = AW, LDK = KVW, LDO = DM;
constexpr size_t SHM_V = KVBLK * D * 2, SHM_K = KVBLK * D * 2, SHM_ATTN = 2 * SHM_V + 2 * SHM_K + NW * 64 * 4;
#define KSWZ(row, colB) ((row) * 256 + ((colB) ^ (((row) & 7) << 4)))
#define SBAR() __builtin_amdgcn_sched_barrier(0)
__device__ __forceinline__ int crow(int r, int hi) { return (r & 3) + 8 * (r >> 2) + 4 * hi; }
__device__ __forceinline__ unsigned cvtpk(float lo, float hi) { return cvt_pk_bf16(lo, hi); }

__device__ __forceinline__ void partialSM(f32x16& p0, f32x16& p1, float& m_reg, float& mn, float& alpha) {
  constexpr float C = SCALE * 1.4426950408889634f;
  float pmax = p0[0]; for (int r = 1; r < 16; ++r) pmax = fmaxf(pmax, p0[r]); for (int r = 0; r < 16; ++r) pmax = fmaxf(pmax, p1[r]);
  { auto rr = __builtin_amdgcn_permlane32_swap(__float_as_uint(pmax), __float_as_uint(pmax), false, false);
    pmax = fmaxf(__uint_as_float(rr[0]), __uint_as_float(rr[1])); }
  if (__builtin_expect(__all(pmax - m_reg <= THR / SCALE), 1)) { mn = m_reg; alpha = 1.f; }
  else { mn = fmaxf(m_reg, pmax); alpha = __builtin_amdgcn_exp2f((m_reg - mn) * C); m_reg = mn; }
  float mnC = -mn * C;
  for (int r = 0; r < 16; ++r) p0[r] = fmaf(p0[r], C, mnC); for (int r = 0; r < 16; ++r) p1[r] = fmaf(p1[r], C, mnC);
  for (int r = 0; r < 16; ++r) p0[r] = __builtin_amdgcn_exp2f(p0[r]);
}
__device__ __forceinline__ void finishSM(f32x16& p0, f32x16& p1, float alpha, float& l_reg, bf16x8& pa0, bf16x8& pa1, bf16x8& pa2, bf16x8& pa3) {
  for (int r = 0; r < 16; ++r) p1[r] = __builtin_amdgcn_exp2f(p1[r]);
  float ps = 0; for (int r = 0; r < 16; ++r) ps += p0[r]; for (int r = 0; r < 16; ++r) ps += p1[r];
  { auto rr = __builtin_amdgcn_permlane32_swap(__float_as_uint(ps), __float_as_uint(ps), false, false);
    ps = __uint_as_float(rr[0]) + __uint_as_float(rr[1]); }
  l_reg = l_reg * alpha + ps;
#define PK4(P, BASE, OUT) do { unsigned a0 = cvtpk(P[BASE + 0], P[BASE + 1]), a1 = cvtpk(P[BASE + 2], P[BASE + 3]);   \
    unsigned b0 = cvtpk(P[BASE + 4], P[BASE + 5]), b1 = cvtpk(P[BASE + 6], P[BASE + 7]);                              \
    auto r0 = __builtin_amdgcn_permlane32_swap(a0, b0, false, false); auto r1 = __builtin_amdgcn_permlane32_swap(a1, b1, false, false); \
    u32x4 w = {r0[0], r1[0], r0[1], r1[1]}; OUT = *reinterpret_cast<bf16x8*>(&w); } while (0)
  PK4(p0, 0, pa0); PK4(p0, 8, pa1); PK4(p1, 0, pa2); PK4(p1, 8, pa3);
#undef PK4
}
__device__ __forceinline__ void qkt(f32x16& p0, f32x16& p1, const bf16_t* Ks, const bf16x8* qr, int r32, int hi) {
  p0 = f32x16{}; p1 = f32x16{};
  for (int d0 = 0; d0 < 8; ++d0) { int cb = (d0 * 16 + hi * 8) * 2;
    bf16x8 b0 = *reinterpret_cast<const bf16x8*>((const char*)Ks + KSWZ(r32, cb));
    bf16x8 b1 = *reinterpret_cast<const bf16x8*>((const char*)Ks + KSWZ(32 + r32, cb));
    p0 = __builtin_amdgcn_mfma_f32_32x32x16_bf16(b0, qr[d0], p0, 0, 0, 0);
    p1 = __builtin_amdgcn_mfma_f32_32x32x16_bf16(b1, qr[d0], p1, 0, 0, 0); }
}
__device__ __forceinline__ int v_st(int k, int c) { const int kk = (k & ~0xC) | ((k & 4) << 1) | ((k & 8) >> 1); return ((kk >> 3) * 4 + (c >> 5)) * 512 + ((kk & 7) * 32 + (c & 31)) * 2; }
__device__ __forceinline__ int v_rd_base(int lane) { return ((lane & 3) << 3) | (((lane >> 2) & 3) << 6) | (((lane >> 4) & 1) << 5) | (((lane >> 5) & 1) << 8); }
constexpr int v_rd_off(int d0, int ks, int half) { return d0 * 512 + ks * 4096 + half * 2048; }
template <int OFF> __device__ __forceinline__ s16x4 tr_read(int vb) {
  s16x4 r; asm volatile("ds_read_b64_tr_b16 %0, %1 offset:%2" : "=&v"(r) : "v"(vb), "i"(OFF) : "memory"); return r;
}
template <int D0> __device__ __forceinline__ void pv_one(f32x16& od, int vb, bf16x8 pa0, bf16x8 pa1, bf16x8 pa2, bf16x8 pa3) {
  const s16x4 l0 = tr_read<v_rd_off(D0, 0, 0)>(vb), h0 = tr_read<v_rd_off(D0, 0, 1)>(vb), l1 = tr_read<v_rd_off(D0, 1, 0)>(vb), h1 = tr_read<v_rd_off(D0, 1, 1)>(vb);
  const s16x4 l2 = tr_read<v_rd_off(D0, 2, 0)>(vb), h2 = tr_read<v_rd_off(D0, 2, 1)>(vb), l3 = tr_read<v_rd_off(D0, 3, 0)>(vb), h3 = tr_read<v_rd_off(D0, 3, 1)>(vb);
  asm volatile("s_waitcnt lgkmcnt(0)" ::: "memory"); SBAR();
#define PK(L, H) (bf16x8){L[0], L[1], L[2], L[3], H[0], H[1], H[2], H[3]}
  od = __builtin_amdgcn_mfma_f32_32x32x16_bf16(pa0, PK(l0, h0), od, 0, 0, 0);
  od = __builtin_amdgcn_mfma_f32_32x32x16_bf16(pa1, PK(l1, h1), od, 0, 0, 0);
  od = __builtin_amdgcn_mfma_f32_32x32x16_bf16(pa2, PK(l2, h2), od, 0, 0, 0);
  od = __builtin_amdgcn_mfma_f32_32x32x16_bf16(pa3, PK(l3, h3), od, 0, 0, 0);
#undef PK
}
__device__ __forceinline__ void pv_d0(f32x16* o, int vb, bf16x8 pa0, bf16x8 pa1, bf16x8 pa2, bf16x8 pa3) {
  pv_one<0>(o[0], vb, pa0, pa1, pa2, pa3); pv_one<1>(o[1], vb, pa0, pa1, pa2, pa3); pv_one<2>(o[2], vb, pa0, pa1, pa2, pa3); pv_one<3>(o[3], vb, pa0, pa1, pa2, pa3);
}
__device__ __forceinline__ void attn_dense_body(const bf16_t* __restrict__ Qb, const bf16_t* __restrict__ Kh, const bf16_t* __restrict__ Vh, bf16_t* __restrict__ Ob, int seq, char* lds) {
  const int tid = threadIdx.x, wid = tid >> 6, lane = tid & 63, r32 = lane & 31, hi = lane >> 5;
  bf16_t* V_lds = (bf16_t*)lds; bf16_t* K_lds = (bf16_t*)(lds + 2 * SHM_V);
  float* ws = (float*)(lds + 2 * SHM_V + 2 * SHM_K) + wid * 64; float* li_l = ws; float* al_l = ws + 32;
  float m_reg = -1e30f, l_reg = 0; f32x16 o[4] = {}; bf16x8 qr[8];
  const bf16_t* Qw = Qb + (long)(wid * QBLK + r32) * LDQ + hi * 8;
#pragma unroll
  for (int d0 = 0; d0 < 8; ++d0) qr[d0] = *reinterpret_cast<const bf16x8*>(Qw + d0 * 16);
  const int sr = tid >> 4, sc = (tid & 15) * 8, vst0 = v_st(sr, sc), vst1 = v_st(32 + sr, sc);
  const int vb0 = (int)(uintptr_t)V_lds + v_rd_base(lane);
  struct { bf16x8 vs0, vs1, ks0, ks1; } sr_[2];
#define LD8(p) (*reinterpret_cast<const bf16x8*>(p))
#define SLOAD(i, k0) do { sr_[i].vs0 = LD8(&Vh[(long)((k0) + sr) * LDK + sc]); sr_[i].vs1 = LD8(&Vh[(long)((k0) + 32 + sr) * LDK + sc]); \
    sr_[i].ks0 = LD8(&Kh[(long)((k0) + sr) * LDK + sc]); sr_[i].ks1 = LD8(&Kh[(long)((k0) + 32 + sr) * LDK + sc]); } while (0)
#define SWRITE(b, i) do { *(bf16x8*)((char*)V_lds + (b) * SHM_V + vst0) = sr_[i].vs0;          \
    *(bf16x8*)((char*)V_lds + (b) * SHM_V + vst1) = sr_[i].vs1; int kc = sc * 2;               \
    *(bf16x8*)((char*)K_lds + (b) * SHM_K + KSWZ(sr, kc)) = sr_[i].ks0;                       \
    *(bf16x8*)((char*)K_lds + (b) * SHM_K + KSWZ(32 + sr, kc)) = sr_[i].ks1; } while (0)
#define SWAIT() do { asm volatile("s_waitcnt vmcnt(4)" ::: "memory"); } while (0)
#define RESC(a) do { if (__any((a) < 1.f)) { if (hi == 0) al_l[r32] = (a); asm volatile("s_waitcnt lgkmcnt(0)" ::: "memory"); \
    for (int d = 0; d < 4; ++d) for (int r = 0; r < 16; ++r) o[d][r] *= al_l[crow(r, hi)]; } } while (0)
  f32x16 pA0, pA1, pB0, pB1; float mnA, mnB, alA, alB; bf16x8 pa0, pa1, pa2, pa3; const int NT = seq / KVBLK;
  constexpr int SE = 0, SO = 1;
  SLOAD(SE, 0); asm volatile("s_waitcnt vmcnt(0)" ::: "memory"); SWRITE(0, SE); __syncthreads();
  qkt(pA0, pA1, K_lds, qr, r32, hi); partialSM(pA0, pA1, m_reg, mnA, alA);
  SLOAD(SO, KVBLK); if (2 < NT) SLOAD(SE, 2 * KVBLK);
  SWAIT(); SWRITE(1, SO); __syncthreads();
  for (int j = 1; j + 1 < NT; j += 2) {
    SBAR(); qkt(pB0, pB1, (bf16_t*)((char*)K_lds + SHM_K), qr, r32, hi);
    finishSM(pA0, pA1, alA, l_reg, pa0, pa1, pa2, pa3); SBAR();
    SLOAD(SO, (j + 2) * KVBLK); SBAR();
    pv_d0(o, vb0, pa0, pa1, pa2, pa3); partialSM(pB0, pB1, m_reg, mnB, alB);
    __syncthreads(); SWAIT(); SWRITE(0, SE);
    RESC(alB); __syncthreads();
    SBAR(); qkt(pA0, pA1, K_lds, qr, r32, hi);
    finishSM(pB0, pB1, alB, l_reg, pa0, pa1, pa2, pa3); SBAR();
    if (j + 3 < NT) SLOAD(SE, (j + 3) * KVBLK); SBAR();
    pv_d0(o, vb0 + (int)SHM_V, pa0, pa1, pa2, pa3); partialSM(pA0, pA1, m_reg, mnA, alA);
    __syncthreads(); SWAIT(); SWRITE(1, SO);
    RESC(alA); __syncthreads();
  }
  SBAR(); qkt(pB0, pB1, (bf16_t*)((char*)K_lds + SHM_K), qr, r32, hi);
  finishSM(pA0, pA1, alA, l_reg, pa0, pa1, pa2, pa3); SBAR();
  pv_d0(o, vb0, pa0, pa1, pa2, pa3); partialSM(pB0, pB1, m_reg, mnB, alB);
  __syncthreads(); RESC(alB);
  finishSM(pB0, pB1, alB, l_reg, pa0, pa1, pa2, pa3); SBAR();
  pv_d0(o, vb0 + (int)SHM_V, pa0, pa1, pa2, pa3);
  if (hi == 0) li_l[r32] = l_reg; asm volatile("s_waitcnt lgkmcnt(0)" ::: "memory");
  float rli[16];
#pragma unroll
  for (int r = 0; r < 16; ++r) rli[r] = __builtin_amdgcn_rcpf(li_l[crow(r, hi)]);
  bf16_t* Ow = Ob + (long)(wid * QBLK) * LDO;
#pragma unroll
  for (int r = 0; r < 16; ++r) { int orow = crow(r, hi);
    for (int d0 = 0; d0 < 4; ++d0) Ow[(long)orow * LDO + d0 * 32 + r32] = f2bf(o[d0][r] * rli[r]); }
#undef LD8
#undef SLOAD
#undef SWRITE
#undef SWAIT
#undef RESC
}
}

struct Frame {
    char* lds;
    const Args* a;
    int tid, lane, wave, G, bx;
    int xl, rk;
};
template <class T> __device__ __forceinline__ T* uni(T* p) {
    const unsigned long long v = (unsigned long long)p;
    const unsigned lo = __builtin_amdgcn_readfirstlane((unsigned)v), hi = __builtin_amdgcn_readfirstlane((unsigned)(v >> 32));
    typedef __attribute__((address_space(1))) T* gptr_t;
    return (T*)(gptr_t)(((unsigned long long)hi << 32) | lo);
}
#define WSB() (uni(F.a->ws))
#define WSP(T, off) ((T*)(WSB() + (off)))
#define INP(i) (uni(F.a->in[i]))

__device__ __forceinline__ float mod_at(const Frame& F, int idx) { const float* mp = WSP(const float, WS_MODP); return mp[idx] + mp[4 * 12288 + idx]; }

__device__ __forceinline__ void build_cs(const Frame& F, int idx0, int idx1, int step) {
    bf16_t* cm = WSP(bf16_t, WS_CMAT);
    for (int idx = idx0; idx < idx1; idx += step) {
        const int mat = idx >> 19, s = (idx >> 8) & 2047, t0 = (idx & 255) * 8;
        float v[8];
#pragma unroll
        for (int e = 0; e < 8; ++e) { const float fr = (float)((s * (t0 + e)) & 2047) * (1.f / 2048.f);
            v[e] = mat ? -__builtin_amdgcn_sinf(fr) : __builtin_amdgcn_cosf(fr); }
        u32x4 w = {cvt_pk_bf16(v[0], v[1]), cvt_pk_bf16(v[2], v[3]), cvt_pk_bf16(v[4], v[5]), cvt_pk_bf16(v[6], v[7])};
        *(u32x4*)(cm + (size_t)s * 4096 + mat * 2048 + t0) = w;
    }
}
__device__ __forceinline__ void build_wimg(const Frame& F, const GemmThread& g, int t0, int t1, int step) {
    const float* w_in = INP(5); const float* w_out = INP(11);
    for (int t = t0; t < t1; t += step) {
        const float* srcp; char* dst; const int kt = t & 31, nt = t >> 5;
        if (nt < 10) { srcp = w_in + (size_t)(kt * 64 + 8 * g.kg) * INW + 512 + nt * 256 + 4 * g.ng; dst = (char*)(WSB() + WS_IMGIN) + (size_t)((nt + 4) * 32 + kt) * 32768; }
        else { srcp = w_out + (size_t)(kt * 64 + 8 * g.kg) * DM + (nt - 10) * 256 + 4 * g.ng; dst = (char*)(WSB() + WS_IMGOUT) + (size_t)((nt - 10) * 32 + kt) * 32768; }
        const size_t ld = nt < 10 ? INW : DM;
        f32x4 rb[8];
#pragma unroll
        for (int k = 0; k < 8; ++k) rb[k] = *(const f32x4*)(srcp + (size_t)k * ld);
#pragma unroll
        for (int j = 0; j < 4; ++j) { u32x4 w;
            w[0] = cvt_pk_bf16(rb[0][j], rb[1][j]); w[1] = cvt_pk_bf16(rb[2][j], rb[3][j]); w[2] = cvt_pk_bf16(rb[4][j], rb[5][j]); w[3] = cvt_pk_bf16(rb[6][j], rb[7][j]);
            *(u32x4*)(dst + g.imgw0 + j * 64) = w; }
    }
}
__device__ __forceinline__ void p0_prologue(const Frame& F) {
    const int tid = F.tid;
    const float* c = INP(1); const float* w_ada = INP(2); const float* b_ada = INP(3); const float* wf = INP(6);
    float* modp = WSP(float, WS_MODP);
    for (int item = F.bx; item < 256; item += F.G) {
        const int half = item & 1, cg = item >> 1;
        float* sc = (float*)F.lds;
        float* red = (float*)(F.lds + 16384);
        __syncthreads();
        for (int i = tid; i < 4096; i += NTHREADS) { const int b = i >> 10, k = i & 1023; const float cv = c[b * DM + half * 1024 + k]; sc[i] = cv / (1.f + __expf(-cv)); }
        __syncthreads();
        const int cq = tid % 24, kg = tid / 24;
        f32x4 am[4]; for (int b = 0; b < 4; ++b) am[b] = (f32x4){0.f, 0.f, 0.f, 0.f};
        if (kg < 21) {
            const float* wp = w_ada + (size_t)(half * 1024) * (NMOD * DM) + cg * 96 + cq * 4;
#pragma unroll 7
            for (int k = kg; k < 1024; k += 21) {
                const f32x4 w = *(const f32x4*)(wp + (size_t)k * (NMOD * DM));
#pragma unroll
                for (int b = 0; b < 4; ++b) am[b] += sc[b * 1024 + k] * w;
            }
#pragma unroll
            for (int b = 0; b < 4; ++b) *(f32x4*)(red + ((kg * 4 + b) * 96 + cq * 4)) = am[b];
        }
        __syncthreads();
        if (tid < 384) { const int b = tid / 96, col = tid % 96; float s = 0.f;
            for (int k2 = 0; k2 < 21; ++k2) s += red[(k2 * 4 + b) * 96 + col];
            if (half == 0) s += b_ada[cg * 96 + col];
            modp[(half * 4 + b) * 12288 + cg * 96 + col] = s; }
    }
    __syncthreads();
    {
        float* tc = (float*)F.lds; float* ts = tc + 128;
        if (tid < 128) { tc[tid] = cospif((float)tid / 64.f); ts[tid] = sinpif((float)tid / 64.f); }
        __syncthreads();
        float* g12 = WSP(float, WS_G12);
        const int lane = tid & 63, l15 = lane & 15, lq = lane >> 4;
        for (int item = F.bx * 8 + F.wave; item < 512; item += F.G * 8) {
            const int gp = item >> 6, g = gp >> 1, part = gp & 1, mt = (item >> 3) & 7, nt = item & 7;
            const float* tb = part ? ts : tc; const float* wp = wf + (size_t)g * 128 * 128 + nt * 16 + l15 + (size_t)(8 * lq) * 128;
            const int cc = mt * 16 + l15;
            f32x4 dacc = {0.f, 0.f, 0.f, 0.f};
            float wv[4][8];
#pragma unroll
            for (int ks = 0; ks < 4; ++ks)
#pragma unroll
                for (int q = 0; q < 8; ++q) wv[ks][q] = wp[(size_t)(ks * 32 + q) * 128];
#pragma unroll
            for (int ks = 0; ks < 4; ++ks) {
                u32x4 th, tl, wh, wl;
#pragma unroll
                for (int q = 0; q < 4; ++q) {
                    const int c2 = ks * 32 + 8 * lq + 2 * q;
                    const float t0 = tb[(cc * c2) & 127], t1 = tb[(cc * (c2 + 1)) & 127];
                    th[q] = cvt_pk_bf16(t0, t1); tl[q] = cvt_pk_bf16(t0 - bflo(th[q]), t1 - bfhi(th[q]));
                    wh[q] = cvt_pk_bf16(wv[ks][2 * q], wv[ks][2 * q + 1]); wl[q] = cvt_pk_bf16(wv[ks][2 * q] - bflo(wh[q]), wv[ks][2 * q + 1] - bfhi(wh[q]));
                }
                const bf16x8 ah = __builtin_bit_cast(bf16x8, th), al = __builtin_bit_cast(bf16x8, tl), bh = __builtin_bit_cast(bf16x8, wh), bl = __builtin_bit_cast(bf16x8, wl);
                dacc = __builtin_amdgcn_mfma_f32_16x16x32_bf16(ah, bh, dacc, 0, 0, 0);
                dacc = __builtin_amdgcn_mfma_f32_16x16x32_bf16(ah, bl, dacc, 0, 0, 0);
                dacc = __builtin_amdgcn_mfma_f32_16x16x32_bf16(al, bh, dacc, 0, 0, 0);
            }
#pragma unroll
            for (int r = 0; r < 4; ++r) g12[((size_t)g * 128 + mt * 16 + 4 * lq + r) * 256 + part * 128 + nt * 16 + l15] = dacc[r] * (1.f / 512.f);
        }
        __syncthreads();
    }
    {
        const GemmThread g = gemm_thread_init();
        if (F.G != 256) { build_cs(F, F.bx * NTHREADS + tid, 2 * 2048 * 256, F.G * NTHREADS); build_wimg(F, g, F.bx, (10 + 8) * 32, F.G); }
        else build_wimg(F, g, F.bx, 10 * 32, F.G);
    }
    {
        f32x2* rp = WSP(f32x2, WS_ROPE);
        for (int idx = F.bx * NTHREADS + tid; idx < 2048 * 64; idx += F.G * NTHREADS) {
            const int s = idx >> 6, p = idx & 63, i = p & 31; const float pos = (float)(p < 32 ? (s >> 6) : (s & 63));
            const float inv = 1.0f / powf(10000.f, (float)(2 * i) / 64.f);
            float sn, cs; sincosf(pos * inv, &sn, &cs);
            rp[idx] = (f32x2){cs, sn};
        }
    }
}

__device__ __forceinline__ void p1_norm(const Frame& F) {
    const int tid = F.tid, lane = F.lane, wave = F.wave;
    const float* x = INP(0); const float* gpm = INP(4); const float* w_in = INP(5);
    bf16_t* h = WSP(bf16_t, WS_H);
    float* av = (float*)F.lds; float* sv = av + DM;
    for (int grp = F.bx; grp < NTOK / 32; grp += F.G) {
        const int row0 = grp * 32, b = row0 / SEQ;
        f32x4 xv[4][8];
#pragma unroll
        for (int rr = 0; rr < 4; ++rr) { const float* xr = x + (size_t)(row0 + wave * 4 + rr) * DM;
#pragma unroll
            for (int i = 0; i < 8; ++i) xv[rr][i] = *(const f32x4*)(xr + i * 256 + lane * 4); }
        __syncthreads();
        for (int k = tid; k < DM; k += NTHREADS) { av[k] = gpm[k] * (1.f + mod_at(F, b * 12288 + DM + k)); sv[k] = mod_at(F, b * 12288 + k); }
        __syncthreads();
#pragma unroll
        for (int rr = 0; rr < 4; ++rr) {
            const int row = row0 + wave * 4 + rr; float ss = 0.f;
#pragma unroll
            for (int i = 0; i < 8; ++i) ss += xv[rr][i][0] * xv[rr][i][0] + xv[rr][i][1] * xv[rr][i][1] + xv[rr][i][2] * xv[rr][i][2] + xv[rr][i][3] * xv[rr][i][3];
            ss = wave_sum(ss); const float rstd = rsqrtf(ss * (1.f / DM) + EPS);
#pragma unroll
            for (int i = 0; i < 8; ++i) { const int k = i * 256 + lane * 4; const f32x4 a4 = *(const f32x4*)(av + k), s4 = *(const f32x4*)(sv + k);
                u32x2 w = {cvt_pk_bf16(xv[rr][i][0] * rstd * a4[0] + s4[0], xv[rr][i][1] * rstd * a4[1] + s4[1]), cvt_pk_bf16(xv[rr][i][2] * rstd * a4[2] + s4[2], xv[rr][i][3] * rstd * a4[3] + s4[3])};
                *(u32x2*)(h + (size_t)row * DM + k) = w; }
        }
    }
    const float* g12 = WSP(const float, WS_G12);
    for (int item = F.bx * 8 + wave; item < 2048; item += F.G * 8) {
        const int ntile = item & 63, mgrp = item >> 6, l15 = lane & 15, lq = lane >> 4;
        const int n = ntile * 16 + l15, half = n >> 9, g = (n >> 7) & 3, j = n & 127;
        const float* gp = g12 + (size_t)g * 128 * 256 + half * 128 + j + (size_t)(8 * lq) * 256;
        bf16x8 yh[4], yl[4];
#pragma unroll
        for (int ks = 0; ks < 4; ++ks) {
            float v[8];
#pragma unroll
            for (int q = 0; q < 8; ++q) v[q] = gp[(size_t)(ks * 32 + q) * 256];
            u32x4 h, l;
#pragma unroll
            for (int q = 0; q < 4; ++q) { h[q] = cvt_pk_bf16(v[2 * q], v[2 * q + 1]); l[q] = cvt_pk_bf16(v[2 * q] - bflo(h[q]), v[2 * q + 1] - bfhi(h[q])); }
            yh[ks] = __builtin_bit_cast(bf16x8, h); yl[ks] = __builtin_bit_cast(bf16x8, l);
        }
        f32x4 xva[4][4][2];
#pragma unroll
        for (int mi = 0; mi < 4; ++mi) { const float* wp = w_in + (size_t)((mgrp * 4 + mi) * 16 + l15) * INW + g * 128 + 8 * lq;
#pragma unroll
            for (int ks = 0; ks < 4; ++ks) { xva[mi][ks][0] = *(const f32x4*)(wp + ks * 32); xva[mi][ks][1] = *(const f32x4*)(wp + ks * 32 + 4); } }
#pragma unroll
        for (int mi = 0; mi < 4; ++mi) {
            const int m0 = (mgrp * 4 + mi) * 16;
            f32x4 (&xv)[4][2] = xva[mi];
            f32x4 d = {0.f, 0.f, 0.f, 0.f};
#pragma unroll
            for (int ks = 0; ks < 4; ++ks) {
                u32x4 h, l;
#pragma unroll
                for (int q = 0; q < 2; ++q) {
                    h[2 * q] = cvt_pk_bf16(xv[ks][q][0], xv[ks][q][1]); h[2 * q + 1] = cvt_pk_bf16(xv[ks][q][2], xv[ks][q][3]);
                    l[2 * q] = cvt_pk_bf16(xv[ks][q][0] - bflo(h[2 * q]), xv[ks][q][1] - bfhi(h[2 * q])); l[2 * q + 1] = cvt_pk_bf16(xv[ks][q][2] - bflo(h[2 * q + 1]), xv[ks][q][3] - bfhi(h[2 * q + 1]));
                }
                const bf16x8 xh = __builtin_bit_cast(bf16x8, h), xl = __builtin_bit_cast(bf16x8, l);
                d = __builtin_amdgcn_mfma_f32_16x16x32_bf16(xh, yh[ks], d, 0, 0, 0);
                d = __builtin_amdgcn_mfma_f32_16x16x32_bf16(xh, yl[ks], d, 0, 0, 0);
                d = __builtin_amdgcn_mfma_f32_16x16x32_bf16(xl, yh[ks], d, 0, 0, 0);
            }
            const int k = m0 + 4 * lq, nt = n >> 8, brow = n & 255, kt = k >> 6, chunk = (k & 63) >> 3;
            u32x2 w = {cvt_pk_bf16(d[0], d[1]), cvt_pk_bf16(d[2], d[3])};
            *(u32x2*)((char*)(WSB() + WS_IMGIN) + (size_t)(nt * 32 + kt) * 32768 + (chunk >> 2) * 16384 + brow * 64 + ((((brow >> 2) & 3) ^ sw4(chunk & 3)) << 4) + (k & 4) * 2) = w;
        }
    }
}

__device__ __forceinline__ void p2_inproj(const Frame& F) {
    const GemmThread g = gemm_thread_init();
    const bf16_t* h = WSP(const bf16_t, WS_H);
    const float* qg = INP(7); const float* kgn = INP(8);
    const f32x2* rope = WSP(const f32x2, WS_ROPE);
    const int vcu = (F.G & 7) ? F.bx : F.xl * (F.G >> 3) + F.rk;
    for (int u = vcu; u < 512; u += F.G) {
        int mt, nt;
        if (!patch_unit(u, 32, 14, mt, nt)) {
            if (F.G == 256) { const int idle = ((u >> 5) - 12) * 16 + ((u & 31) - 16);
                int to = F.tid; asm volatile("" : "+v"(to));
                build_cs(F, idle * 16384 + to, (idle + 1) * 16384, NTHREADS);
                const GemmThread g2 = gemm_thread_init<true>();
                build_wimg(F, g2, 10 * 32 + idle * 4, 10 * 32 + idle * 4 + 4, 1); }
            continue; }
        f32x4 acc[4][8]; acc_zero(acc);
        unsigned aoff[2];
#pragma unroll
        for (int i = 0; i < 2; ++i) aoff[i] = (unsigned)(g.rrow0 + 16 * i) * (DM * 2u) + g.rchunk;
        const char* ab = (const char*)(h + (size_t)mt * 256 * DM);
        gemm_accum_ring(acc, F.lds, g, F.wave, F.lane, ab, aoff, (const char*)(WSB() + WS_IMGIN) + (size_t)(nt * 32) * 32768, DM / 64);
        const EpiLane el = epi_lane(g);
        if (nt < 4) {
            char* img = (char*)(WSB() + WS_IMGZ) + (size_t)((((mt >> 3) * 2 + (nt & 1)) * 64) + (nt >> 1) * 32 + (mt & 7) * 4 + el.wm) * 32768;
            char* tw = F.lds + F.wave * 16384;
#pragma unroll
            for (int i = 0; i < 4; ++i)
#pragma unroll
                for (int j = 0; j < 8; ++j)
#pragma unroll
                    for (int r = 0; r < 4; ++r) *(bf16_t*)(tw + (16 * j + 4 * el.lq + r) * 128 + (16 * i + el.l15) * 2) = f2bf(acc[i][j][r]);
            int ln = F.lane; asm volatile("" : "+v"(ln));
#pragma unroll
            for (int q = 0; q < 16; ++q) { const int idx = q * 64 + ln, nl = idx >> 3, chunk = idx & 7, n = 128 * el.wn + nl;
                const u32x4 v = *(const u32x4*)(tw + nl * 128 + chunk * 16);
                *(u32x4*)(img + (chunk >> 2) * 16384 + n * 64 + ((((n >> 2) & 3) ^ sw4(chunk & 3)) << 4)) = v; }
            __syncthreads();
        } else if (nt < 12) {
            const bool isq = nt < 10;
            const int head = isq ? (nt - 4) * 2 + el.wn : (nt - 10) * 2 + el.wn;
            const float* gn = isq ? qg : kgn;
            bf16_t* dstb = isq ? WSP(bf16_t, WS_Q) : WSP(bf16_t, WS_K); const int ldo = isq ? AW : KVW;
            char* twq = stg_base(F);
            float rstd[4];
#pragma unroll
            for (int i = 0; i < 4; ++i) {
                float ss = 0.f;
#pragma unroll
                for (int j = 0; j < 8; ++j) ss += acc[i][j][0] * acc[i][j][0] + acc[i][j][1] * acc[i][j][1] + acc[i][j][2] * acc[i][j][2] + acc[i][j][3] * acc[i][j][3];
                ss += __shfl_xor(ss, 16, 64); ss += __shfl_xor(ss, 32, 64);
                rstd[i] = rsqrtf(ss * (1.f / 128.f) + EPS);
            }
#pragma unroll
            for (int jb = 0; jb < 8; jb += 2) {
                f32x4 gvv[2], csv[2][4];
#pragma unroll
                for (int jj = 0; jj < 2; ++jj) { const int d = 16 * (jb + jj) + 4 * el.lq;
                    gvv[jj] = *(const f32x4*)(gn + d);
#pragma unroll
                    for (int i = 0; i < 4; ++i) { const int t = mt * 256 + 64 * el.wm + 16 * i + el.l15, sq = t & (SEQ - 1);
                        csv[jj][i] = *(const f32x4*)(rope + (size_t)sq * 64 + (d >> 1)); } }
#pragma unroll
                for (int jj = 0; jj < 2; ++jj) { const int j = jb + jj, d = 16 * j + 4 * el.lq;
                    const f32x4 gv = gvv[jj];
#pragma unroll
                    for (int i = 0; i < 4; ++i) {
                        const int t = mt * 256 + 64 * el.wm + 16 * i + el.l15; const f32x4 cs = csv[jj][i];
                        const float x0 = acc[i][j][0] * rstd[i] * gv[0], x1 = acc[i][j][1] * rstd[i] * gv[1];
                        const float x2 = acc[i][j][2] * rstd[i] * gv[2], x3 = acc[i][j][3] * rstd[i] * gv[3];
                        u32x2 w = {cvt_pk_bf16(x0 * cs[0] - x1 * cs[1], x0 * cs[1] + x1 * cs[0]), cvt_pk_bf16(x2 * cs[2] - x3 * cs[3], x2 * cs[3] + x3 * cs[2])};
                        stg_put(twq, el, i, j, w);
                    }
                }
            }
            stg_flush(F, twq, dstb + (size_t)(mt * 256 + 64 * el.wm) * ldo + head * 128, ldo);
        } else {
            bf16_t* vb = WSP(bf16_t, WS_V);
            char* tw = stg_base(F);
#pragma unroll
            for (int i = 0; i < 4; ++i)
#pragma unroll
                for (int j = 0; j < 8; ++j) stg_put(tw, el, i, j, (u32x2){cvt_pk_bf16(acc[i][j][0], acc[i][j][1]), cvt_pk_bf16(acc[i][j][2], acc[i][j][3])});
            stg_flush(F, tw, vb + (size_t)(mt * 256 + 64 * el.wm) * KVW + (nt - 12) * 256 + 128 * el.wn, KVW);
        }
    }
}

__device__ __forceinline__ void p3_dft_unit(const Frame& F, const GemmThread& g, int du) {
    const int mt = du & 7, nt = du >> 3, b = nt >> 1, g0 = (nt & 1) * 2;
    const bf16_t* cs = WSP(const bf16_t, WS_CMAT);
    f32x4 acc[4][8]; acc_zero(acc);
    unsigned aoff[2];
#pragma unroll
    for (int i = 0; i < 2; ++i) aoff[i] = (unsigned)(g.rrow0 + 16 * i) * 8192u + g.rchunk;
    gemm_accum_ring(acc, F.lds, g, F.wave, F.lane, (const char*)(cs + (size_t)mt * 256 * 4096), aoff, (const char*)(WSB() + WS_IMGZ) + (size_t)(nt * 64) * 32768, 64);
    bf16_t* mrg = WSP(bf16_t, WS_MRG);
    const EpiLane el = epi_lane(g);
    char* tw = stg_base(F);
#pragma unroll
    for (int i = 0; i < 4; ++i)
#pragma unroll
        for (int j = 0; j < 8; ++j) stg_put(tw, el, i, j, (u32x2){cvt_pk_bf16(acc[i][j][0], acc[i][j][1]), cvt_pk_bf16(acc[i][j][2], acc[i][j][3])});
    stg_flush(F, tw, mrg + (size_t)(b * SEQ + mt * 256 + 64 * el.wm) * DM + g0 * 128 + 128 * el.wn, DM);
}
__device__ __forceinline__ void p3_attn_unit(const Frame& F, int kvh  , int sub  ) {
    const int b = kvh >> 2, kv = kvh & 3, hq = kv * 3 + sub / 8, qb = sub % 8;
    const bf16_t* q = WSP(const bf16_t, WS_Q) + (size_t)(b * SEQ + qb * 256) * AW + hq * 128;
    const bf16_t* k = WSP(const bf16_t, WS_K) + (size_t)(b * SEQ) * KVW + kv * 128;
    const bf16_t* v = WSP(const bf16_t, WS_V) + (size_t)(b * SEQ) * KVW + kv * 128;
    bf16_t* o = WSP(bf16_t, WS_MRG) + (size_t)(b * SEQ + qb * 256) * DM + FW + hq * 128;
    attn::attn_dense_body(q, k, v, o, SEQ, F.lds);
}
__device__ __forceinline__ void p3_mixers(const Frame& F) {
    const GemmThread g = gemm_thread_init();
    const bool std = (F.G == 256); const int xl = F.xl, r = F.rk;
    int na, a0, astep, nd, d0, dstep;
    if (std) { na = (r < 24) ? 2 : 0; a0 = xl * 24 + r; astep = 8 * 24; nd = (r < 24) ? 0 : 1; d0 = xl * 8 + (r - 24); dstep = 1; }
    else { na = (384 - F.bx + F.G - 1) / F.G; if (F.bx >= 384) na = 0; a0 = F.bx; astep = F.G; nd = (64 - F.bx + F.G - 1) / F.G; if (F.bx >= 64) nd = 0; d0 = F.bx; dstep = F.G; }
#if (P3_MASK & 1)
    for (int it = 0; it < na; ++it) { const int u = a0 + it * astep; __syncthreads(); p3_attn_unit(F, u / 24, u % 24); }
#endif
#if (P3_MASK & 2)
    for (int it = 0; it < nd; ++it) { __syncthreads(); p3_dft_unit(F, g, d0 + it * dstep); }
#endif
}

__device__ __forceinline__ void p4_merge_norm(const Frame& F) {
    const float* gf = INP(9); const float* ga = INP(10);
    bf16_t* mrg = WSP(bf16_t, WS_MRG);
    for (int base = F.bx * 8 + F.wave; base < NTOK; base += 4 * F.G * 8) {
        u32x4 v[4][4];
#pragma unroll
        for (int q = 0; q < 4; ++q) { const int row = base + q * F.G * 8;
            if (row < NTOK) {
#pragma unroll
                for (int i = 0; i < 4; ++i) v[q][i] = *(const u32x4*)(mrg + (size_t)row * DM + (i * 64 + F.lane) * 8); } }
#pragma unroll
        for (int q = 0; q < 4; ++q) { const int row = base + q * F.G * 8;
            if (row < NTOK) {
                bf16_t* rp = mrg + (size_t)row * DM;
                float ssf = 0.f, ssa = 0.f;
#pragma unroll
                for (int i = 0; i < 4; ++i) { float s2 = 0.f;
#pragma unroll
                    for (int e = 0; e < 4; ++e) { const float a = bflo(v[q][i][e]), b2 = bfhi(v[q][i][e]); s2 += a * a + b2 * b2; }
                    if (i == 0) ssf = s2; else ssa += s2; }
                ssf = wave_sum(ssf); ssa = wave_sum(ssa);
                const float rf = rsqrtf(ssf * (1.f / FW) + EPS), ra = rsqrtf(ssa * (1.f / AW) + EPS);
#pragma unroll
                for (int i = 0; i < 4; ++i) { const int k = (i * 64 + F.lane) * 8; const float rs = (i == 0) ? rf : ra; const float* gp = (i == 0) ? (gf + k) : (ga + (k - FW));
                    const f32x4 g0 = *(const f32x4*)gp, g1 = *(const f32x4*)(gp + 4);
                    u32x4 w;
                    w[0] = cvt_pk_bf16(bflo(v[q][i][0]) * rs * g0[0], bfhi(v[q][i][0]) * rs * g0[1]); w[1] = cvt_pk_bf16(bflo(v[q][i][1]) * rs * g0[2], bfhi(v[q][i][1]) * rs * g0[3]);
                    w[2] = cvt_pk_bf16(bflo(v[q][i][2]) * rs * g1[0], bfhi(v[q][i][2]) * rs * g1[1]); w[3] = cvt_pk_bf16(bflo(v[q][i][3]) * rs * g1[2], bfhi(v[q][i][3]) * rs * g1[3]);
                    *(u32x4*)(rp + k) = w; }
            } }
    }
}

__device__ __forceinline__ void p5_outproj(const Frame& F) {
    const GemmThread g = gemm_thread_init();
    const bf16_t* mrg = WSP(const bf16_t, WS_MRG); bf16_t* mix = WSP(bf16_t, WS_MIX);
    const int vcu = (F.G & 7) ? F.bx : F.xl * (F.G >> 3) + F.rk;
    for (int u = vcu; u < 256; u += F.G) {
        int mt, nt; if (!patch_unit(u, 32, 8, mt, nt)) continue;
        f32x4 acc[4][8]; acc_zero(acc);
        unsigned aoff[2];
#pragma unroll
        for (int i = 0; i < 2; ++i) aoff[i] = (unsigned)(g.rrow0 + 16 * i) * (DM * 2u) + g.rchunk;
        gemm_accum_ring(acc, F.lds, g, F.wave, F.lane, (const char*)(mrg + (size_t)mt * 256 * DM), aoff, (const char*)(WSB() + WS_IMGOUT) + (size_t)(nt * 32) * 32768, DM / 64);
        const EpiLane el = epi_lane(g);
        char* tw = stg_base(F);
#pragma unroll
        for (int i = 0; i < 4; ++i)
#pragma unroll
            for (int j = 0; j < 8; ++j) stg_put(tw, el, i, j, (u32x2){cvt_pk_bf16(acc[i][j][0], acc[i][j][1]), cvt_pk_bf16(acc[i][j][2], acc[i][j][3])});
        stg_flush(F, tw, mix + (size_t)(mt * 256 + 64 * el.wm) * DM + nt * 256 + 128 * el.wn, DM);
    }
}

__device__ __forceinline__ void p6_postmix(const Frame& F) {
    const int tid = F.tid, lane = F.lane, wave = F.wave;
    const float* x = INP(0); const float* gpost = INP(12); const float* gpre = INP(13);
    const float* w_router = INP(14); const float* b_router = INP(15);
    const bf16_t* mix = WSP(const bf16_t, WS_MIX); float* x1b = WSP(float, WS_X1); unsigned char* h2b = WSP(unsigned char, WS_H2);
    int* list = WSP(int, WS_LIST); float* gatev = WSP(float, WS_GATEV); unsigned* cnt = (unsigned*)(WSB() + WS_CTL + CTL_CNT_OFF);
    float* gm = (float*)F.lds; float* af = gm + DM; float* sf = af + DM;
    constexpr int RP = 528;
    char* HAh = F.lds + 24576; char* HAl = HAh + 32 * RP; char* WBh = HAl + 32 * RP; char* WBl = WBh + 32 * RP;
    float* RED = (float*)(WBl + 32 * RP);
    float* LOG = RED + 8 * 32 * 32;
    int* s_cnt = (int*)(LOG + 32 * 32); int* s_base = s_cnt + 32; int* s_e = s_base + 32; int* s_lr = s_e + 128;
    for (int grp = F.bx; grp < NTOK / 32; grp += F.G) {
        const int row0 = grp * 32, b = row0 / SEQ;
        __syncthreads();
        for (int k = tid; k < DM; k += NTHREADS) {
            gm[k] = mod_at(F, b * 12288 + 2 * DM + k) * gpost[k];
            af[k] = gpre[k] * (1.f + mod_at(F, b * 12288 + 4 * DM + k));
            sf[k] = mod_at(F, b * 12288 + 3 * DM + k); }
        if (tid < 32) s_cnt[tid] = 0;
        __syncthreads();
        const unsigned lo16 = (unsigned)lane * 16u, lo8 = (unsigned)lane * 8u;
        float r2v[4];
#pragma unroll
        for (int rr = 0; rr < 4; ++rr) r2v[rr] = 0.f;
#pragma unroll 1
        for (int rr = 0; rr < 4; ++rr) {
            const int row = row0 + wave * 4 + rr;
            float ss = 0.f; f32x4 mv[8];
#pragma unroll
            for (int i = 0; i < 8; ++i) { const u32x2 m2 = *(const u32x2*)((const char*)(mix + (size_t)row * DM + i * 256) + lo8);
                mv[i] = (f32x4){bflo(m2[0]), bfhi(m2[0]), bflo(m2[1]), bfhi(m2[1])};
                ss += mv[i][0] * mv[i][0] + mv[i][1] * mv[i][1] + mv[i][2] * mv[i][2] + mv[i][3] * mv[i][3]; }
            ss = wave_sum(ss); const float r1 = rsqrtf(ss * (1.f / DM) + EPS);
            float s2 = 0.f;
            f32x4 xrow[8];
#pragma unroll
            for (int i = 0; i < 8; ++i) xrow[i] = *(const f32x4*)((const char*)(x + (size_t)row * DM + i * 256) + lo16);
#pragma unroll
            for (int i = 0; i < 8; ++i) { const int k = i * 256 + lane * 4; const f32x4 xv = xrow[i]; const f32x4 g4 = *(const f32x4*)(gm + k);
                f32x4 v1; for (int e = 0; e < 4; ++e) v1[e] = xv[e] + g4[e] * (mv[i][e] * r1);
                *(f32x4*)((char*)(x1b + (size_t)row * DM + i * 256) + lo16) = v1; mv[i] = v1;
#if DEBUG_X1
                *(f32x4*)((char*)(uni(F.a->out) + (size_t)row * DM + i * 256) + lo16) = v1;
#endif
                s2 += v1[0] * v1[0] + v1[1] * v1[1] + v1[2] * v1[2] + v1[3] * v1[3]; }
            s2 = wave_sum(s2); const float r2 = rsqrtf(s2 * (1.f / DM) + EPS);
            r2v[0] = rr == 0 ? r2 : r2v[0]; r2v[1] = rr == 1 ? r2 : r2v[1]; r2v[2] = rr == 2 ? r2 : r2v[2]; r2v[3] = rr == 3 ? r2 : r2v[3];
#pragma unroll
            for (int i = 0; i < 8; ++i) { const int k = i * 256 + lane * 4; const f32x4 a4 = *(const f32x4*)(af + k), s4 = *(const f32x4*)(sf + k);
                float h0 = (mv[i][0] * r2 * a4[0] + s4[0]) * FP8_SA, h1 = (mv[i][1] * r2 * a4[1] + s4[1]) * FP8_SA, h2_ = (mv[i][2] * r2 * a4[2] + s4[2]) * FP8_SA, h3 = (mv[i][3] * r2 * a4[3] + s4[3]) * FP8_SA;
                h0 = fminf(fmaxf(h0, -448.f), 448.f); h1 = fminf(fmaxf(h1, -448.f), 448.f); h2_ = fminf(fmaxf(h2_, -448.f), 448.f); h3 = fminf(fmaxf(h3, -448.f), 448.f);
                *(unsigned*)(h2b + (size_t)row * DM + i * 256 + lane * 4) = cvt4_fp8(h0, h1, h2_, h3); }
        }
        f32x4 racc[2][2];
#pragma unroll
        for (int m = 0; m < 2; ++m)
#pragma unroll
            for (int n = 0; n < 2; ++n) racc[m][n] = (f32x4){0.f, 0.f, 0.f, 0.f};
        const int l15 = lane & 15, lq = lane >> 4;
#pragma unroll 1
        for (int i = 0; i < 8; ++i) {
            __syncthreads();
            {
                const int k = i * 256 + lane * 4; const f32x4 a4 = *(const f32x4*)(af + k), s4 = *(const f32x4*)(sf + k);
#pragma unroll
                for (int rr = 0; rr < 4; ++rr) {
                    const f32x4 xv = *(const f32x4*)((const char*)(x1b + (size_t)(row0 + wave * 4 + rr) * DM + i * 256) + lo16);
                    const float r2 = rr == 0 ? r2v[0] : rr == 1 ? r2v[1] : rr == 2 ? r2v[2] : r2v[3];
                    float h0 = xv[0] * r2 * a4[0] + s4[0], h1 = xv[1] * r2 * a4[1] + s4[1], h2_ = xv[2] * r2 * a4[2] + s4[2], h3 = xv[3] * r2 * a4[3] + s4[3];
                    const unsigned p0 = cvt_pk_bf16(h0, h1), p1 = cvt_pk_bf16(h2_, h3);
                    const unsigned q0 = cvt_pk_bf16(h0 - bflo(p0), h1 - bfhi(p0)), q1 = cvt_pk_bf16(h2_ - bflo(p1), h3 - bfhi(p1));
                    const int off = (wave * 4 + rr) * RP + lane * 8;
                    *(u32x2*)(HAh + off) = (u32x2){p0, p1}; *(u32x2*)(HAl + off) = (u32x2){q0, q1};
                }
            }
            {
                const int k4 = tid & 63, e4 = tid >> 6;
                f32x4 wv[4];
#pragma unroll
                for (int kk = 0; kk < 4; ++kk) wv[kk] = *(const f32x4*)(w_router + (size_t)(i * 256 + 4 * k4 + kk) * NEXP + 4 * e4);
#pragma unroll
                for (int j = 0; j < 4; ++j) {
                    const unsigned p0 = cvt_pk_bf16(wv[0][j], wv[1][j]), p1 = cvt_pk_bf16(wv[2][j], wv[3][j]);
                    const unsigned q0 = cvt_pk_bf16(wv[0][j] - bflo(p0), wv[1][j] - bfhi(p0)), q1 = cvt_pk_bf16(wv[2][j] - bflo(p1), wv[3][j] - bfhi(p1));
                    const int off = (4 * e4 + j) * RP + k4 * 8;
                    *(u32x2*)(WBh + off) = (u32x2){p0, p1}; *(u32x2*)(WBl + off) = (u32x2){q0, q1};
                }
            }
            __syncthreads();
            bf16x8 ah[2], al[2], bh[2], bl[2];
            const int fo = l15 * RP + wave * 64 + lq * 16;
#pragma unroll
            for (int m = 0; m < 2; ++m) { ah[m] = *(const bf16x8*)(HAh + fo + m * 16 * RP); al[m] = *(const bf16x8*)(HAl + fo + m * 16 * RP);
                                          bh[m] = *(const bf16x8*)(WBh + fo + m * 16 * RP); bl[m] = *(const bf16x8*)(WBl + fo + m * 16 * RP); }
#pragma unroll
            for (int m = 0; m < 2; ++m)
#pragma unroll
                for (int n = 0; n < 2; ++n) {
                    racc[m][n] = __builtin_amdgcn_mfma_f32_16x16x32_bf16(ah[m], bh[n], racc[m][n], 0, 0, 0);
                    racc[m][n] = __builtin_amdgcn_mfma_f32_16x16x32_bf16(ah[m], bl[n], racc[m][n], 0, 0, 0);
                    racc[m][n] = __builtin_amdgcn_mfma_f32_16x16x32_bf16(al[m], bh[n], racc[m][n], 0, 0, 0);
                }
        }
#pragma unroll
        for (int m = 0; m < 2; ++m)
#pragma unroll
            for (int n = 0; n < 2; ++n)
#pragma unroll
                for (int r = 0; r < 4; ++r) RED[(wave * 32 + 16 * m + 4 * lq + r) * 32 + 16 * n + l15] = racc[m][n][r];
        __syncthreads();
        { const int tk = tid >> 4, e2 = (tid & 15) * 2; float s0 = b_router[e2], s1 = b_router[e2 + 1];
#pragma unroll
            for (int w = 0; w < 8; ++w) { s0 += RED[(w * 32 + tk) * 32 + e2]; s1 += RED[(w * 32 + tk) * 32 + e2 + 1]; }
            LOG[tk * 32 + e2] = s0; LOG[tk * 32 + e2 + 1] = s1; }
        __syncthreads();
#pragma unroll 1
        for (int rr = 0; rr < 4; ++rr) {
            float val = LOG[(wave * 4 + rr) * 32 + (lane & 31)];
            float tv[4]; int te[4];
#pragma unroll
            for (int kk = 0; kk < 4; ++kk) {
                float m = val;
#pragma unroll
                for (int o = 16; o >= 1; o >>= 1) m = fmaxf(m, __shfl_xor(m, o, 64));
                const unsigned long long bal = __ballot(val == m);
                const int e = __ffsll((long long)bal) - 1;
                tv[kk] = m; te[kk] = e & 31; if ((lane & 31) == (e & 31)) val = -INFINITY;
            }
            const float p1 = __expf(tv[1] - tv[0]), p2 = __expf(tv[2] - tv[0]), p3 = __expf(tv[3] - tv[0]); const float inv = 1.f / (1.f + p1 + p2 + p3);
            if (lane < 4) {
                const int e = lane == 0 ? te[0] : lane == 1 ? te[1] : lane == 2 ? te[2] : te[3];
                const float gt = (lane == 0 ? 1.f : lane == 1 ? p1 : lane == 2 ? p2 : p3) * inv;
                const int al = (wave * 4 + rr) * 4 + lane;
                s_e[al] = e; s_lr[al] = atomicAdd(&s_cnt[e], 1);
                gatev[row0 * 4 + al] = gt;
            }
        }
        __syncthreads();
        if (tid < 32) { int t2 = tid; asm volatile("" : "+v"(t2));
            s_base[tid] = (int)__hip_atomic_fetch_add(&cnt[t2], (unsigned)s_cnt[tid], __ATOMIC_RELAXED, __HIP_MEMORY_SCOPE_AGENT); }
        __syncthreads();
        if (tid < 128) { const int e = s_e[tid]; list[e * 8192 + s_base[e] + s_lr[tid]] = row0 * 4 + tid; }
    }
}

struct MoeTab { int* tiles; int* rowbase; int* cnt; int* pt; };
__device__ __forceinline__ MoeTab moe_tab(const Frame& F) {
    MoeTab t; t.tiles = (int*)(F.lds + LDS_MISC + 64); t.rowbase = t.tiles + 32; t.cnt = t.rowbase + 32; t.pt = t.cnt + 32;
    unsigned* cnt = (unsigned*)(WSB() + WS_CTL + CTL_CNT_OFF);
    __syncthreads();
    if (F.tid < 32) { const int n = (int)__hip_atomic_load(&cnt[F.tid], __ATOMIC_RELAXED, __HIP_MEMORY_SCOPE_AGENT); t.cnt[F.tid] = n; t.tiles[F.tid] = (n + 255) >> 8; }
    __syncthreads();
    if (F.tid == 0) { int s = 0, p = 0; for (int e = 0; e < 32; ++e) { t.rowbase[e] = s; s += t.tiles[e] * 256; t.pt[e] = p; p += t.tiles[e] > 2 ? t.tiles[e] - 2 : 0; } t.pt[32] = p; }
    __syncthreads();
    return t;
}
__device__ __forceinline__ void moe_tile_of(const MoeTab& t, int tix, int& e, int& mt) {
    int ee = 0;
#pragma unroll 1
    for (int k = 1; k < 32; ++k) ee = (tix >= t.pt[k]) ? k : ee;
    e = ee; mt = 2 + tix - t.pt[ee];
}

__device__ __forceinline__ void moe_up_epilogue(const Frame& F, const GemmThread& g, const f32x4 (&acc)[4][8], int e, int mt, int nt, int ne, int rowb) {
    const float* b_gate = INP(17); const float* b_up = INP(19); unsigned char* act = WSP(unsigned char, WS_ACT);
    const EpiLane el = epi_lane(g);
    char* tw = F.lds + F.wave * 4096;
    f32x4 bg[4], bu[4];
#pragma unroll
    for (int j = 0; j < 4; ++j) { const int col = nt * 128 + 64 * el.wn + 16 * j + 4 * el.lq;
        bg[j] = *(const f32x4*)(b_gate + (size_t)e * DM + col); bu[j] = *(const f32x4*)(b_up + (size_t)e * DM + col); }
#pragma unroll
    for (int j = 0; j < 4; ++j) {
        const int col = nt * 128 + 64 * el.wn + 16 * j + 4 * el.lq;
#pragma unroll
        for (int i = 0; i < 4; ++i) {
            const int ml = 64 * el.wm + 16 * i + el.l15;
            float o[4];
#pragma unroll
            for (int q = 0; q < 4; ++q) { float gg = acc[i][j][q] * (1.f / (FP8_SA * FP8_SW)) + bg[j][q], uu = acc[i][j + 4][q] * (1.f / (FP8_SA * FP8_SW)) + bu[j][q];
                gg = fminf(gg, 7.f); uu = fminf(fmaxf(uu, -7.f), 7.f);
                o[q] = (uu + 1.f) * gg * __builtin_amdgcn_rcpf(1.f + __expf(-1.702f * gg)); }
            *(unsigned*)(tw + (16 * i + el.l15) * 64 + 16 * j + 4 * el.lq) = cvt4_fp8(o[0] * FP8_SACT, o[1] * FP8_SACT, o[2] * FP8_SACT, o[3] * FP8_SACT);
        }
    }
    { int ln = F.lane; asm volatile("" : "+v"(ln));
      char* dst = (char*)act + ((size_t)(rowb >> 8) * 32 + nt * 2 + el.wn) * 16384 + (64 * el.wm) * 64;
#pragma unroll
      for (int q = 0; q < 4; ++q) *(u32x4*)(dst + q * 1024 + ln * 16) = *(const u32x4*)(tw + q * 1024 + ln * 16); }
    __syncthreads();
}
__device__ __forceinline__ void moe_dn_epilogue(const Frame& F, const GemmThread& g, const f32x4 (&acc)[4][8], int e, int mt, int nt, int ne) {
    const float* b_down = INP(21); const int* list = WSP(const int, WS_LIST); const float* gatev = WSP(const float, WS_GATEV); bf16_t* outb = WSP(bf16_t, WS_OUTB);
    const EpiLane el = epi_lane(g);
    constexpr float RS = 1.f / (FP8_SACT * FP8_SW);
    int av[4]; float gtv[4]; f32x4 bd[8];
#pragma unroll
    for (int i = 0; i < 4; ++i) { int rk = mt * 256 + 64 * el.wm + 16 * i + el.l15; rk = rk < ne ? rk : ne - 1; av[i] = list[e * 8192 + rk]; }
#pragma unroll
    for (int j = 0; j < 8; ++j) bd[j] = *(const f32x4*)(b_down + (size_t)e * DM + nt * 256 + 128 * el.wn + 16 * j + 4 * el.lq);
#pragma unroll
    for (int i = 0; i < 4; ++i) gtv[i] = gatev[av[i]];
    char* tw = F.lds + F.wave * 8704;
    int ln = F.lane; asm volatile("" : "+v"(ln));
#pragma unroll
    for (int hf = 0; hf < 2; ++hf) {
#pragma unroll
        for (int ii = 0; ii < 2; ++ii) { const int i = 2 * hf + ii; const float gt = gtv[i];
#pragma unroll
            for (int j = 0; j < 8; ++j) {
                u32x2 w = {cvt_pk_bf16((acc[i][j][0] * RS + bd[j][0]) * gt, (acc[i][j][1] * RS + bd[j][1]) * gt), cvt_pk_bf16((acc[i][j][2] * RS + bd[j][2]) * gt, (acc[i][j][3] * RS + bd[j][3]) * gt)};
                *(u32x2*)(tw + (16 * ii + el.l15) * 272 + (16 * j + 4 * el.lq) * 2) = w; } }
#pragma unroll
        for (int q = 0; q < 8; ++q) {
            const int rl = q * 4 + (ln >> 4), chunk = ln & 15;
            const int a = __shfl(av[2 * hf + (q >> 2)], rl & 15, 64);
            const u32x4 v = *(const u32x4*)(tw + rl * 272 + chunk * 16);
            if (mt * 256 + 64 * el.wm + 32 * hf + rl < ne) *(u32x4*)(outb + (size_t)a * DM + nt * 256 + 128 * el.wn + chunk * 8) = v;
        }
    }
    __syncthreads();
}
__device__ __forceinline__ void moe_up_epilogue32(const Frame& F, const GemmThread& g, const f32x16 (&acc)[2][4], int e, int mt, int nt, int ne, int rowb) {
    const float* b_gate = INP(17); const float* b_up = INP(19); unsigned char* act = WSP(unsigned char, WS_ACT);
    int l31 = F.lane & 31, lh = F.lane >> 5; asm volatile("" : "+v"(l31), "+v"(lh));
    char* tw = F.lds + F.wave * 4096;
    f32x4 bg[2][4], bu[2][4];
#pragma unroll
    for (int j = 0; j < 2; ++j)
#pragma unroll
        for (int q4 = 0; q4 < 4; ++q4) { const int col = nt * 128 + 64 * g.wn + 32 * j + 8 * q4 + 4 * lh;
            bg[j][q4] = *(const f32x4*)(b_gate + (size_t)e * DM + col); bu[j][q4] = *(const f32x4*)(b_up + (size_t)e * DM + col); }
#pragma unroll
    for (int j = 0; j < 2; ++j)
#pragma unroll
        for (int q4 = 0; q4 < 4; ++q4) {
            const int col = nt * 128 + 64 * g.wn + 32 * j + 8 * q4 + 4 * lh;
#pragma unroll
            for (int i = 0; i < 2; ++i) {
                const int ml = 64 * g.wm + 32 * i + l31;
                float o[4];
#pragma unroll
                for (int q = 0; q < 4; ++q) { float gg = acc[i][j][4 * q4 + q] * (1.f / (FP8_SA * FP8_SW)) + bg[j][q4][q], uu = acc[i][j + 2][4 * q4 + q] * (1.f / (FP8_SA * FP8_SW)) + bu[j][q4][q];
                    gg = fminf(gg, 7.f); uu = fminf(fmaxf(uu, -7.f), 7.f);
                    o[q] = (uu + 1.f) * gg * __builtin_amdgcn_rcpf(1.f + __expf(-1.702f * gg)); }
                *(unsigned*)(tw + (32 * i + l31) * 64 + 32 * j + 8 * q4 + 4 * lh) = cvt4_fp8(o[0] * FP8_SACT, o[1] * FP8_SACT, o[2] * FP8_SACT, o[3] * FP8_SACT);
            }
        }
    { int ln = F.lane; asm volatile("" : "+v"(ln));
      char* dst = (char*)act + ((size_t)(rowb >> 8) * 32 + nt * 2 + g.wn) * 16384 + (64 * g.wm) * 64;
#pragma unroll
      for (int q = 0; q < 4; ++q) *(u32x4*)(dst + q * 1024 + ln * 16) = *(const u32x4*)(tw + q * 1024 + ln * 16); }
    __syncthreads();
}
__device__ __forceinline__ void moe_dn_epilogue32(const Frame& F, const GemmThread& g, const f32x16 (&acc)[2][4], int e, int mt, int nt, int ne) {
    const float* b_down = INP(21); const int* list = WSP(const int, WS_LIST); const float* gatev = WSP(const float, WS_GATEV); bf16_t* outb = WSP(bf16_t, WS_OUTB);
    int l31 = F.lane & 31, lh = F.lane >> 5; asm volatile("" : "+v"(l31), "+v"(lh));
    constexpr float RS = 1.f / (FP8_SACT * FP8_SW);
    int av[2]; float gtv[2]; f32x4 bd[4][4];
#pragma unroll
    for (int i = 0; i < 2; ++i) { int rk = mt * 256 + 64 * g.wm + 32 * i + l31; rk = rk < ne ? rk : ne - 1; av[i] = list[e * 8192 + rk]; }
#pragma unroll
    for (int j = 0; j < 4; ++j)
#pragma unroll
        for (int q4 = 0; q4 < 4; ++q4) bd[j][q4] = *(const f32x4*)(b_down + (size_t)e * DM + nt * 256 + 128 * g.wn + 32 * j + 8 * q4 + 4 * lh);
#pragma unroll
    for (int i = 0; i < 2; ++i) gtv[i] = gatev[av[i]];
    char* tw = F.lds + F.wave * 8704;
    int ln = F.lane; asm volatile("" : "+v"(ln));
#pragma unroll
    for (int i = 0; i < 2; ++i) {
        const float gt = gtv[i];
#pragma unroll
        for (int j = 0; j < 4; ++j)
#pragma unroll
            for (int q4 = 0; q4 < 4; ++q4) {
                u32x2 w = {cvt_pk_bf16((acc[i][j][4 * q4 + 0] * RS + bd[j][q4][0]) * gt, (acc[i][j][4 * q4 + 1] * RS + bd[j][q4][1]) * gt), cvt_pk_bf16((acc[i][j][4 * q4 + 2] * RS + bd[j][q4][2]) * gt, (acc[i][j][4 * q4 + 3] * RS + bd[j][q4][3]) * gt)};
                *(u32x2*)(tw + l31 * 272 + (32 * j + 8 * q4 + 4 * lh) * 2) = w; }
#pragma unroll
        for (int q = 0; q < 8; ++q) {
            const int rl = q * 4 + (ln >> 4), chunk = ln & 15;
            const int a = __shfl(av[i], rl, 64);
            const u32x4 v = *(const u32x4*)(tw + rl * 272 + chunk * 16);
            if (mt * 256 + 64 * g.wm + 32 * i + rl < ne) *(u32x4*)(outb + (size_t)a * DM + nt * 256 + 128 * g.wn + chunk * 8) = v;
        }
    }
    __syncthreads();
}
__device__ __forceinline__ void moe_up_unit_first(const Frame& F, const GemmThread& g, const MoeTab& tb, int e, int nt) {
    const int ne = __builtin_amdgcn_readfirstlane(tb.cnt[e]); if (ne == 0) return;
    const int* list = WSP(const int, WS_LIST); const unsigned char* h2 = WSP(const unsigned char, WS_H2);
    const float* w_gate = INP(16); const float* w_up = INP(18);
    f32x4 acc[4][8]; acc_zero(acc);
    int achunk = g.rchunk, arow = g.rrow0, kg = g.kg, ng = g.ng; asm volatile("" : "+v"(achunk), "+v"(arow), "+v"(kg), "+v"(ng));
    unsigned aoff[2];
#pragma unroll
    for (int i = 0; i < 2; ++i) { int rk = arow + 16 * i; rk = rk < ne ? rk : ne - 1; const int a = list[e * 8192 + rk]; aoff[i] = (unsigned)(a >> 2) * (unsigned)DM + achunk; }
    const int isup = (F.wave >> 1) & 1;
    const char* bb = (const char*)((isup ? w_up : w_gate) + (size_t)e * DM * DM + nt * 128);
    const unsigned boff = (unsigned)(8 * kg) * (DM * 4u) + (unsigned)((ng >> 5) * 64 + (ng & 15) * 4) * 4u;
    f8_accum_w32(acc, F.lds, g, F.wave, (const char*)h2, aoff, bb, boff, DM * 4, DM / 64, (char*)(WSB() + WS_IMGGU) + (size_t)((e * 16 + nt) * 32) * 16384);
    moe_up_epilogue(F, g, acc, e, 0, nt, ne, __builtin_amdgcn_readfirstlane(tb.rowbase[e]));
}
__device__ __forceinline__ void moe_dn_unit_first(const Frame& F, const GemmThread& g, const MoeTab& tb, int e, int nt) {
    const int ne = __builtin_amdgcn_readfirstlane(tb.cnt[e]); if (ne == 0) return;
    const unsigned char* act = WSP(const unsigned char, WS_ACT); const float* w_down = INP(20);
    const int rowb = __builtin_amdgcn_readfirstlane(tb.rowbase[e]);
    f32x4 acc[4][8]; acc_zero(acc);
    int achunk = g.rchunk, arow = g.rrow0, kg = g.kg, ng = g.ng; asm volatile("" : "+v"(achunk), "+v"(arow), "+v"(kg), "+v"(ng));
    unsigned aoff[2];
#pragma unroll
    for (int i = 0; i < 2; ++i) aoff[i] = (unsigned)(arow + 16 * i) * 64u + achunk;
    f8_accum_w32(acc, F.lds, g, F.wave, (const char*)(act + (size_t)(rowb >> 8) * 32 * 16384), aoff, (const char*)(w_down + (size_t)e * DM * DM + nt * 256), (unsigned)(8 * kg) * (DM * 4u) + 16u * ng, DM * 4, DM / 64,
                 (char*)(WSB() + WS_IMGDN) + (size_t)((e * 8 + nt) * 32) * 16384, 16384u);
    moe_dn_epilogue(F, g, acc, e, 0, nt, ne);
}
__device__ __forceinline__ void moe_up_unit_dma(const Frame& F, const GemmThread& g, const MoeTab& tb, int e, int mt, int nt) {
    const int ne = __builtin_amdgcn_readfirstlane(tb.cnt[e]);
    const int* list = WSP(const int, WS_LIST); const unsigned char* h2 = WSP(const unsigned char, WS_H2);
    int achunk = g.rchunk, arow = g.rrow0; asm volatile("" : "+v"(achunk), "+v"(arow));
    f32x16 acc[2][4];
#pragma unroll
    for (int i = 0; i < 2; ++i)
#pragma unroll
        for (int j = 0; j < 4; ++j) acc[i][j] = f32x16{};
    unsigned aoff[2];
#pragma unroll
    for (int i = 0; i < 2; ++i) { int rk = mt * 256 + arow + 16 * i; rk = rk < ne ? rk : ne - 1; const int a = list[e * 8192 + rk]; aoff[i] = (unsigned)(a >> 2) * (unsigned)DM + achunk; }
    s8_accum_ring(acc, F.lds, g, F.wave, F.lane, (const char*)h2, aoff, (const char*)(WSB() + WS_IMGGU) + (size_t)((e * 16 + nt) * 32) * 16384, DM / 64);
    moe_up_epilogue32(F, g, acc, e, mt, nt, ne, __builtin_amdgcn_readfirstlane(tb.rowbase[e]) + mt * 256);
}
__device__ __forceinline__ void moe_dn_unit_dma(const Frame& F, const GemmThread& g, const MoeTab& tb, int e, int mt, int nt) {
    const int ne = __builtin_amdgcn_readfirstlane(tb.cnt[e]), rowb = __builtin_amdgcn_readfirstlane(tb.rowbase[e]) + mt * 256;
    const unsigned char* act = WSP(const unsigned char, WS_ACT);
    int achunk = g.rchunk, arow = g.rrow0; asm volatile("" : "+v"(achunk), "+v"(arow));
    f32x16 acc[2][4];
#pragma unroll
    for (int i = 0; i < 2; ++i)
#pragma unroll
        for (int j = 0; j < 4; ++j) acc[i][j] = f32x16{};
    unsigned aoff[2];
#pragma unroll
    for (int i = 0; i < 2; ++i) aoff[i] = (unsigned)(arow + 16 * i) * 64u + achunk;
    s8_accum_ring(acc, F.lds, g, F.wave, F.lane, (const char*)(act + (size_t)(rowb >> 8) * 32 * 16384), aoff, (const char*)(WSB() + WS_IMGDN) + (size_t)((e * 8 + nt) * 32) * 16384, DM / 64, 16384u);
    moe_dn_epilogue32(F, g, acc, e, mt, nt, ne);
}

__device__ __forceinline__ void moe_dn_unit_dma_h(const Frame& F, const GemmThread& g, const MoeTab& tb, int e, int mt, int nt, int nh) {
    const int ne = __builtin_amdgcn_readfirstlane(tb.cnt[e]), rowb = __builtin_amdgcn_readfirstlane(tb.rowbase[e]) + mt * 256;
    const unsigned char* act = WSP(const unsigned char, WS_ACT);
    int achunk = g.rchunk, arow = g.rrow0; asm volatile("" : "+v"(achunk), "+v"(arow));
    f32x16 acc[2][2];
#pragma unroll
    for (int i = 0; i < 2; ++i)
#pragma unroll
        for (int j = 0; j < 2; ++j) acc[i][j] = f32x16{};
    unsigned aoff[2];
#pragma unroll
    for (int i = 0; i < 2; ++i) aoff[i] = (unsigned)(arow + 16 * i) * 64u + achunk;
    s8_accum_ring_h(acc, F.lds, g, F.wave, F.lane, (const char*)(act + (size_t)(rowb >> 8) * 32 * 16384), aoff, (const char*)(WSB() + WS_IMGDN) + (size_t)((e * 8 + nt) * 32) * 16384 + nh * 8192, DM / 64, 16384u);
    const float* b_down = INP(21); const int* list = WSP(const int, WS_LIST); const float* gatev = WSP(const float, WS_GATEV); bf16_t* outb = WSP(bf16_t, WS_OUTB);
    int l31 = F.lane & 31, lh = F.lane >> 5; asm volatile("" : "+v"(l31), "+v"(lh));
    constexpr float RS = 1.f / (FP8_SACT * FP8_SW);
    int av[2]; float gtv[2]; f32x4 bd[2][4];
#pragma unroll
    for (int i = 0; i < 2; ++i) { int rk = mt * 256 + 64 * g.wm + 32 * i + l31; rk = rk < ne ? rk : ne - 1; av[i] = list[e * 8192 + rk]; }
#pragma unroll
    for (int j = 0; j < 2; ++j)
#pragma unroll
        for (int q4 = 0; q4 < 4; ++q4) bd[j][q4] = *(const f32x4*)(b_down + (size_t)e * DM + nt * 256 + nh * 128 + 64 * g.wn + 32 * j + 8 * q4 + 4 * lh);
#pragma unroll
    for (int i = 0; i < 2; ++i) gtv[i] = gatev[av[i]];
#pragma unroll
    for (int i = 0; i < 2; ++i) {
        const int ml = 64 * g.wm + 32 * i + l31, rk = mt * 256 + ml;
        if (rk < ne) {
            const int a = av[i]; const float gt = gtv[i];
#pragma unroll
            for (int j = 0; j < 2; ++j)
#pragma unroll
                for (int q4 = 0; q4 < 4; ++q4) { const int col = nt * 256 + nh * 128 + 64 * g.wn + 32 * j + 8 * q4 + 4 * lh;
                    u32x2 w = {cvt_pk_bf16((acc[i][j][4 * q4 + 0] * RS + bd[j][q4][0]) * gt, (acc[i][j][4 * q4 + 1] * RS + bd[j][q4][1]) * gt), cvt_pk_bf16((acc[i][j][4 * q4 + 2] * RS + bd[j][q4][2]) * gt, (acc[i][j][4 * q4 + 3] * RS + bd[j][q4][3]) * gt)};
                    *(u32x2*)(outb + (size_t)a * DM + col) = w; }
        }
    }
}

__device__ __forceinline__ void p7_moe_a(const Frame& F) {
    const GemmThread g = gemm_thread_init();
    const MoeTab tb = moe_tab(F);
    const int vcu = (F.G & 7) ? F.bx : F.xl * (F.G >> 3) + F.rk;
#pragma unroll 1
    for (int u = vcu; u < 32 * 16; u += F.G) { const int e = u >> 4, nt = u & 15;
        moe_up_unit_first(F, g, tb, e, nt);
        if (__builtin_amdgcn_readfirstlane(tb.tiles[e]) >= 2) { const GemmThread g2 = gemm_thread_init<true>(); moe_up_unit_dma(F, g2, tb, e, 1, nt); } }
}
__device__ __forceinline__ void p8_moe_b(const Frame& F) {
    const GemmThread g = gemm_thread_init();
    const MoeTab tb = moe_tab(F);
    const int nb = __builtin_amdgcn_readfirstlane(tb.pt[32]) * 16;
    const int vcu = (F.G & 7) ? F.bx : F.xl * (F.G >> 3) + F.rk;
    int u = vcu;
#pragma unroll 1
    for (; u < 256; u += F.G) { const int e = u >> 3, nt = u & 7;
        moe_dn_unit_first(F, g, tb, e, nt);
        if (__builtin_amdgcn_readfirstlane(tb.tiles[e]) >= 2) { const GemmThread g2 = gemm_thread_init<true>(); moe_dn_unit_dma(F, g2, tb, e, 1, nt); } }
    if (F.G == 256) {
        const int T = nb >> 4, ngrp = 2 * ((T + 3) >> 2);
        for (int gi = F.xl; gi < ngrp; gi += 8) { const int tix = (gi >> 1) * 4 + (F.rk >> 3), nt = (gi & 1) * 8 + (F.rk & 7);
            if (tix < T) { int e, mt; moe_tile_of(tb, tix, e, mt); e = __builtin_amdgcn_readfirstlane(e); mt = __builtin_amdgcn_readfirstlane(mt); moe_up_unit_dma(F, g, tb, e, mt, nt); } }
    } else
    for (u = F.bx; u < nb; u += F.G) { int e, mt; moe_tile_of(tb, u >> 4, e, mt); e = __builtin_amdgcn_readfirstlane(e); mt = __builtin_amdgcn_readfirstlane(mt); moe_up_unit_dma(F, g, tb, e, mt, u & 15); }
}
__device__ __forceinline__ void p9_moe_c(const Frame& F) {
    const GemmThread g = gemm_thread_init();
    const MoeTab tb = moe_tab(F);
    const int nb = __builtin_amdgcn_readfirstlane(tb.pt[32]) * 8;
    if (F.G == 256) {
        const int T = nb >> 3, ngrp = (T + 3) >> 2;
        const int rem = ngrp & 7, nfull = (rem >= 1 && rem <= 4) ? ngrp - rem : ngrp;
        for (int gi = F.xl; gi < nfull; gi += 8) { const int tix = gi * 4 + (F.rk >> 3), nt = F.rk & 7;
            if (tix < T) { int e, mt; moe_tile_of(tb, tix, e, mt); e = __builtin_amdgcn_readfirstlane(e); mt = __builtin_amdgcn_readfirstlane(mt); moe_dn_unit_dma(F, g, tb, e, mt, nt); } }
        if (nfull < ngrp && F.xl < 2 * rem) { const int gi = nfull + (F.xl >> 1), nh = F.xl & 1, tix = gi * 4 + (F.rk >> 3), nt = F.rk & 7;
            if (tix < T) { int e, mt; moe_tile_of(tb, tix, e, mt); e = __builtin_amdgcn_readfirstlane(e); mt = __builtin_amdgcn_readfirstlane(mt); moe_dn_unit_dma_h(F, g, tb, e, mt, nt, nh); } }
    } else
    for (int u = F.bx; u < nb; u += F.G) { int e, mt; moe_tile_of(tb, u >> 3, e, mt); e = __builtin_amdgcn_readfirstlane(e); mt = __builtin_amdgcn_readfirstlane(mt); moe_dn_unit_dma(F, g, tb, e, mt, u & 7); }
}

__device__ __forceinline__ void p10_final(const Frame& F) {
    const int tid = F.tid, lane = F.lane, wave = F.wave;
    const float* gpf = INP(22); const float* x1b = WSP(const float, WS_X1); const bf16_t* outb = WSP(const bf16_t, WS_OUTB);
    float* gfv = (float*)F.lds;
    for (int grp = F.bx; grp < NTOK / 32; grp += F.G) {
        const int row0 = grp * 32, b = row0 / SEQ;
        __syncthreads();
        for (int k = tid; k < DM; k += NTHREADS) gfv[k] = mod_at(F, b * 12288 + 5 * DM + k) * gpf[k];
        __syncthreads();
#pragma unroll 1
        for (int rp = 0; rp < 4; rp += 2) {
            u32x2 m2v[2][8][4]; f32x4 xvv[2][8];
#pragma unroll
            for (int q = 0; q < 2; ++q) { const int row = row0 + wave * 4 + rp + q;
#pragma unroll
                for (int i = 0; i < 8; ++i) {
#pragma unroll
                    for (int kk = 0; kk < 4; ++kk) m2v[q][i][kk] = *(const u32x2*)(outb + (size_t)(row * 4 + kk) * DM + i * 256 + lane * 4);
                    xvv[q][i] = *(const f32x4*)(x1b + (size_t)row * DM + i * 256 + lane * 4); } }
#pragma unroll
            for (int q = 0; q < 2; ++q) { const int row = row0 + wave * 4 + rp + q;
                f32x4 y[8]; float ss = 0.f;
#pragma unroll
                for (int i = 0; i < 8; ++i) { y[i] = (f32x4){0.f, 0.f, 0.f, 0.f};
#pragma unroll
                    for (int kk = 0; kk < 4; ++kk) { const u32x2 m2 = m2v[q][i][kk];
                        y[i][0] += bflo(m2[0]); y[i][1] += bfhi(m2[0]); y[i][2] += bflo(m2[1]); y[i][3] += bfhi(m2[1]); }
                    ss += y[i][0] * y[i][0] + y[i][1] * y[i][1] + y[i][2] * y[i][2] + y[i][3] * y[i][3]; }
                ss = wave_sum(ss); const float rs = rsqrtf(ss * (1.f / DM) + EPS);
#pragma unroll
                for (int i = 0; i < 8; ++i) { const int k = i * 256 + lane * 4; const f32x4 g4 = *(const f32x4*)(gfv + k);
                    f32x4 o; for (int e = 0; e < 4; ++e) o[e] = xvv[q][i][e] + g4[e] * (y[i][e] * rs);
                    *(f32x4*)(uni(F.a->out) + (size_t)row * DM + k) = o; }
            }
        }
    }
}


__global__ void __launch_bounds__(NTHREADS, 2) fwd_kernel(Args args) {
    extern __shared__ __attribute__((aligned(16))) char lds[];
    Frame F;
    F.lds = lds; F.a = &args;
    F.tid = threadIdx.x; F.lane = F.tid & 63; F.wave = __builtin_amdgcn_readfirstlane(F.tid >> 6); F.G = gridDim.x; F.bx = blockIdx.x;
    const int lo = args.ph_lo, hi = args.ph_hi;
    if (F.wave >= 4) __builtin_amdgcn_s_setprio(1);
    F.xl = F.bx & 7; F.rk = F.bx >> 3;
    XcdBarrier bar; bar.bar = (unsigned*)(args.ws + WS_CTL); bar.x = 0; bar.st = (volatile LAS unsigned*)(lds + LDS_MISC);
    if (hi - lo > 1) {
        if (F.tid == 0) { *(volatile LAS unsigned*)(lds + LDS_MISC) = 0u; *(volatile LAS unsigned*)(lds + LDS_MISC + 4) = 0u; }
        __syncthreads();
        bar = xcd_barrier_post((unsigned*)(args.ws + WS_CTL), (volatile LAS unsigned*)(lds + LDS_MISC));
        if (F.tid == 0) *(volatile LAS unsigned*)(lds + LDS_MISC + 16) = xb_add((unsigned*)(args.ws + WS_CTL + CTL_RANK_OFF) + bar.x, 1u);
    }
#ifndef PH_MASK
#define PH_MASK 0x7ff
#endif
#define IN(k) (((PH_MASK >> (k)) & 1) && lo <= (k) && (k) < hi)
#define SEAM(k) do { if (IN(k) && IN((k) + 1)) xcd_barrier(bar); } while (0)
    if (IN(0)) { p0_prologue(F); } SEAM(0);
    if (hi - lo > 1 && (F.G & 7) == 0) {
        if (F.tid == 0) { unsigned ok = 1u; for (int j = 0; j < 8; ++j) ok &= (xb_ld(&bar.bar[XB_XCNT(j)]) == (unsigned)(F.G >> 3)) ? 1u : 0u; *(volatile LAS unsigned*)(lds + LDS_MISC + 20) = ok; }
        __syncthreads();
        if (*(volatile LAS unsigned*)(lds + LDS_MISC + 20) && bar.x < 8u) { F.xl = (int)bar.x; F.rk = (int)*(volatile LAS unsigned*)(lds + LDS_MISC + 16); }
        F.xl = __builtin_amdgcn_readfirstlane(F.xl); F.rk = __builtin_amdgcn_readfirstlane(F.rk);
    }
    if (IN(1)) { p1_norm(F); } SEAM(1);
    if (IN(2)) { p2_inproj(F); } SEAM(2);
    if (IN(3)) { p3_mixers(F); } SEAM(3);
    if (IN(4)) { p4_merge_norm(F); } SEAM(4);
    if (IN(5)) { p5_outproj(F); } SEAM(5);
    if (IN(6)) { p6_postmix(F); } SEAM(6);
    if (IN(7)) { p7_moe_a(F); } SEAM(7);
    if (IN(8)) { p8_moe_b(F); } SEAM(8);
    if (IN(9)) { p9_moe_c(F); } SEAM(9);
    if (IN(10)) { p10_final(F); }
#undef IN
#undef SEAM
}

}

extern "C" void kernel_launch(void* const* d_in, const int* in_sizes, int n_in, void* d_out, int out_size, void* d_ws, size_t ws_size, hipStream_t stream) {
    static int grid = 0;
    if (grid == 0) {
        if (n_in != 23 || out_size != NTOK * DM || ws_size < WS_END) { fprintf(stderr, "kernel_launch: unexpected shapes (n_in %d out %d ws %zu need %zu)\n", n_in, out_size, ws_size, (size_t)WS_END); grid = -1; return; }
        int dev = 0, cus = 0, per_cu = 0;
        if (hipGetDevice(&dev) != hipSuccess || hipDeviceGetAttribute(&cus, hipDeviceAttributeMultiprocessorCount, dev) != hipSuccess) { grid = -1; return; }
        if (hipFuncSetAttribute((const void*)fwd_kernel, hipFuncAttributeMaxDynamicSharedMemorySize, LDS_BYTES) != hipSuccess) { fprintf(stderr, "kernel_launch: hipFuncSetAttribute failed\n"); grid = -1; return; }
        if (hipOccupancyMaxActiveBlocksPerMultiprocessor(&per_cu, (const void*)fwd_kernel, NTHREADS, LDS_BYTES) != hipSuccess || per_cu < 1)
            fprintf(stderr, "kernel_launch: occupancy query reports %d blocks per CU\n", per_cu);
        (void)hipGetLastError();
        grid = cus;
    }
    if (grid < 0) return;
    (void)hipMemsetAsync((char*)d_ws + WS_CTL, 0, CTL_BYTES, stream);
    Args a{};
    for (int i = 0; i < 23; ++i) a.in[i] = (const float*)d_in[i];
    a.out = (float*)d_out; a.ws = (unsigned char*)d_ws;
#if MK_N_LAUNCHES == 1
    a.ph_lo = 0; a.ph_hi = NPHASE;
    hipLaunchKernelGGL(fwd_kernel, dim3(grid), dim3(NTHREADS), LDS_BYTES, stream, a);
#else
    for (int p = 0; p < NPHASE; ++p) { a.ph_lo = p; a.ph_hi = p + 1; hipLaunchKernelGGL(fwd_kernel, dim3(grid), dim3(NTHREADS), LDS_BYTES, stream, a);
        if ((REP_MASK >> p) & 1) hipLaunchKernelGGL(fwd_kernel, dim3(grid), dim3(NTHREADS), LDS_BYTES, stream, a); }
#endif
    const hipError_t le = hipPeekAtLastError();
    if (le != hipSuccess) fprintf(stderr, "kernel_launch: launch failed: %s\n", hipGetErrorName(le));
}
```

```cpp
#include <hip/hip_runtime.h>
#include <stdint.h>
#include <stdio.h>

#ifndef DEBUG_X1
#define DEBUG_X1 0
#endif
#ifndef STAMP_A
#define STAMP_A 0
#endif
#ifndef STAMP_B
#define STAMP_B 0
#endif
#ifndef S8_KMAP
#define S8_KMAP 0
#endif
#ifndef REP_MASK
#define REP_MASK 0
#endif
#ifndef DEBUG_PROBE
#define DEBUG_PROBE 0
#endif
#ifndef P3_MASK
#define P3_MASK 3
#endif
#ifndef MK_N_LAUNCHES
#define MK_N_LAUNCHES 1
#endif

namespace {

constexpr int DM = 2048, NBATCH = 4, SEQ = 2048, NTOK = NBATCH * SEQ;
constexpr int FW = 512, AW = 1536, KVW = 512, INW = 3072;
constexpr int NEXP = 32, TOPK = 4, NMOD = 6;
constexpr int NPHASE = 11;
constexpr float EPS = 1e-6f;
constexpr int NTHREADS = 512;
constexpr float FP8_SA = 16.f, FP8_SW = 256.f, FP8_SACT = 4.f;

typedef unsigned short bf16_t;
typedef short bf16x8 __attribute__((ext_vector_type(8)));
typedef short s16x4 __attribute__((ext_vector_type(4)));
typedef float f32x4 __attribute__((ext_vector_type(4)));
typedef float f32x2 __attribute__((ext_vector_type(2)));
typedef float f32x16 __attribute__((ext_vector_type(16)));
typedef unsigned u32x4 __attribute__((ext_vector_type(4)));
typedef unsigned u32x2 __attribute__((ext_vector_type(2)));

constexpr size_t al256(size_t x) { return (x + 255) / 256 * 256; }
constexpr size_t WS_CTL   = 0;
constexpr size_t CTL_BAR_BYTES = 16384;
constexpr size_t CTL_CNT_OFF = CTL_BAR_BYTES;
constexpr size_t CTL_RANK_OFF = CTL_BAR_BYTES + 256;
constexpr size_t CTL_BYTES = CTL_BAR_BYTES + 512;
constexpr size_t WS_MODP  = al256(WS_CTL + CTL_BYTES);
constexpr size_t WS_G12   = al256(WS_MODP + 2ull * 4 * 12288 * 4);
constexpr size_t WS_ROPE  = al256(WS_G12 + 4ull * 128 * 256 * 4);
constexpr size_t WS_WZ    = al256(WS_ROPE + 2048ull * 64 * 2 * 4);
constexpr size_t WS_CMAT  = al256(WS_WZ + 2048ull * 1024 * 4);
constexpr size_t WS_SMAT  = al256(WS_CMAT + 2048ull * 2048 * 2);
constexpr size_t WS_H     = al256(WS_SMAT + 2048ull * 2048 * 2);
constexpr size_t WS_ZC    = al256(WS_H + (size_t)NTOK * DM * 2);
constexpr size_t WS_ZS    = al256(WS_ZC + (size_t)NTOK * 512 * 4);
constexpr size_t WS_Q     = al256(WS_ZS + (size_t)NTOK * 512 * 4);
constexpr size_t WS_K     = al256(WS_Q + (size_t)NTOK * AW * 2);
constexpr size_t WS_V     = al256(WS_K + (size_t)NTOK * KVW * 2);
constexpr size_t WS_MRG   = al256(WS_V + (size_t)NTOK * KVW * 2);
constexpr size_t WS_MIX   = al256(WS_MRG + (size_t)NTOK * DM * 2);
constexpr size_t WS_X1    = al256(WS_MIX + (size_t)NTOK * DM * 2);
constexpr size_t WS_H2    = al256(WS_X1 + (size_t)NTOK * DM * 4);
constexpr size_t WS_LIST  = al256(WS_H2 + (size_t)NTOK * DM * 2);
constexpr size_t WS_GATEV = al256(WS_LIST + 32ull * 8192 * 4);
constexpr int ACT_ROWS = NTOK * TOPK + NEXP * 256;
constexpr size_t WS_ACT   = al256(WS_GATEV + 32768ull * 4);
constexpr size_t WS_OUTB  = al256(WS_ACT + (size_t)ACT_ROWS * DM * 2);
constexpr size_t WS_IMGGU = al256(WS_OUTB + (size_t)NTOK * TOPK * DM * 2);
constexpr size_t WS_IMGDN = al256(WS_IMGGU + 32ull * 16 * 32 * 16384);
constexpr size_t WS_IMGIN = al256(WS_IMGDN + 32ull * 8 * 32 * 16384);
constexpr size_t WS_IMGOUT= al256(WS_IMGIN + 14ull * 32 * 32768);
constexpr size_t WS_IMGZ  = al256(WS_IMGOUT + 8ull * 32 * 32768);
constexpr size_t WS_END   = al256(WS_IMGZ + 8ull * 64 * 32768);

constexpr int LDS_GEMM = 147456;
constexpr int LDS_MISC = LDS_GEMM;
constexpr int LDS_BYTES = LDS_GEMM + 1024;

typedef __bf16 bf16x2_t __attribute__((ext_vector_type(2)));
__device__ __forceinline__ unsigned cvt_pk_bf16(float lo, float hi) { f32x2 v = {lo, hi}; bf16x2_t b = __builtin_convertvector(v, bf16x2_t); return __builtin_bit_cast(unsigned, b); }
__device__ __forceinline__ bf16_t f2bf(float f) { return (bf16_t)(cvt_pk_bf16(f, 0.f) & 0xffffu); }
__device__ __forceinline__ float bf2f(unsigned h) { return __uint_as_float(h << 16); }
__device__ __forceinline__ float bflo(unsigned w) { return __uint_as_float(w << 16); }
__device__ __forceinline__ float bfhi(unsigned w) { return __uint_as_float(w & 0xffff0000u); }
__device__ __forceinline__ float wave_sum(float v) {
#pragma unroll
    for (int o = 32; o >= 1; o >>= 1) v += __shfl_xor(v, o, 64);
    return v;
}

#define XB_TMO      128
#define XB_XCNT(j)  (256  + 64 * (j))
#define XB_XSUB(j)  (1280 + 64 * (j))
#define XB_XGEN(j)  (2304 + 64 * (j))
#define XB_TOP      3328
#define XB_TOPGEN   3392
#define XCD_BAR_WORDS 3456
#define XB_SPIN_CAP (1u << 22)
#define LAS __attribute__((address_space(3)))

__device__ __forceinline__ unsigned xb_ld(unsigned* p)              { return __hip_atomic_load(p, __ATOMIC_RELAXED, __HIP_MEMORY_SCOPE_AGENT); }
__device__ __forceinline__ unsigned xb_add(unsigned* p, unsigned v) { return __hip_atomic_fetch_add(p, v, __ATOMIC_RELAXED, __HIP_MEMORY_SCOPE_AGENT); }
__device__ __forceinline__ unsigned xb_xcc_id() { return (unsigned)__builtin_amdgcn_s_getreg((3 << 11) | 20) & 0xFu; }
#define XB_SPIN(cond, bar) do { unsigned _sp = 0; while (cond) { __builtin_amdgcn_s_sleep(1); \
    if ((++_sp & 255u) == 0u) { if (xb_ld(&(bar)[XB_TMO])) break; if (_sp > XB_SPIN_CAP) { atomicAdd(&(bar)[XB_TMO], 1u); break; } } } } while (0)

struct XcdBarrier { unsigned* bar; unsigned x; volatile LAS unsigned* st; };

__device__ __forceinline__ XcdBarrier xcd_barrier_post(unsigned* bar, volatile LAS unsigned* st) {
    XcdBarrier b; b.bar = bar; b.x = xb_xcc_id(); b.st = st;
    if (threadIdx.x == 0) (void)xb_add(&bar[XB_XCNT(b.x)], 1u);
    return b;
}
__device__ __forceinline__ void xcd_barrier_complete(unsigned* bar, unsigned x, unsigned& nloc, unsigned& nx) {
    const unsigned G = gridDim.x * gridDim.y * gridDim.z;
    unsigned sum, cnt, mine, sp = 0u;
    for (;;) {
        sum = 0u; cnt = 0u; mine = 0u;
#pragma unroll
        for (unsigned j = 0; j < 16; ++j) { const unsigned c = xb_ld(&bar[XB_XCNT(j)]); sum += c; cnt += (c > 0u) ? 1u : 0u; mine = (j == x) ? c : mine; }
        if (sum == G) break;
        __builtin_amdgcn_s_sleep(1);
        if ((++sp & 255u) == 0u) { if (xb_ld(&bar[XB_TMO])) break; if (sp > XB_SPIN_CAP) { atomicAdd(&bar[XB_TMO], 1u); break; } }
    }
    nloc = mine > 0u ? mine : 1u; nx = cnt > 0u ? cnt : 1u;
}
__device__ __forceinline__ void xcd_barrier(const XcdBarrier& b) {
    asm volatile("s_waitcnt vmcnt(0)" ::: "memory");
    __syncthreads();
    if (threadIdx.x == 0) {
        unsigned* bar = b.bar;
        __builtin_amdgcn_s_waitcnt(0);
        unsigned nloc = b.st[0], nx = b.st[1];
        if (nloc == 0u) { xcd_barrier_complete(bar, b.x, nloc, nx); b.st[0] = nloc; b.st[1] = nx; }
        const unsigned old = xb_add(&bar[XB_XSUB(b.x)], 1u);
        const unsigned gen = old / nloc;
        if (old + 1u == (gen + 1u) * nloc) {
            __builtin_amdgcn_fence(__ATOMIC_RELEASE, "agent");
            asm volatile("s_waitcnt vmcnt(0)" ::: "memory");
            const unsigned og = xb_add(&bar[XB_TOP], 1u);
            const unsigned tg = og / nx;
            if (og + 1u == (tg + 1u) * nx) xb_add(&bar[XB_TOPGEN], 1u);
            else XB_SPIN(xb_ld(&bar[XB_TOPGEN]) == tg, bar);
            __builtin_amdgcn_fence(__ATOMIC_ACQUIRE, "agent");
            xb_add(&bar[XB_XGEN(b.x)], 1u);
            asm volatile("s_waitcnt vmcnt(0)" ::: "memory");
        } else {
            XB_SPIN(xb_ld(&bar[XB_XGEN(b.x)]) == gen, bar);
            __builtin_amdgcn_fence(__ATOMIC_ACQUIRE, "agent");
            asm volatile("s_waitcnt vmcnt(0)" ::: "memory");
        }
    }
    __syncthreads();
}

struct Args {
    const float* in[23];
    float* out;
    unsigned char* ws;
    int ph_lo, ph_hi;
};

struct GemmThread {
    int a_w0;
    int b_w0;
    int a_r, b_r;
    int c8;
    int r0;
    int kg, ng;
    int wm, wn, l15, lq;
    int arow0, achunk;
    int rrow0, rchunk;
    int rfr;
    int imgw0;
    int f8r0, f8r1;
    int f8w0;
    int s8r0, s8r1;
};
__host__ __device__ constexpr int sw4(int c) { return (0x9C >> (2 * c)) & 3; }
__host__ __device__ constexpr int sw4inv(int p) { return (0x78 >> (2 * p)) & 3; }
template <bool OPQ = false>
__device__ __forceinline__ GemmThread gemm_thread_init() {
    GemmThread g;
    int tid = threadIdx.x; if (OPQ) asm volatile("" : "+v"(tid));
    const int lane = tid & 63, wave = __builtin_amdgcn_readfirstlane(tid >> 6);
    const int c = tid & 7; g.r0 = tid >> 3; g.c8 = c * 8;
    g.a_w0 = g.r0 * 128 + ((c ^ (g.r0 & 7)) << 4);
    g.kg = lane & 7; g.ng = (lane >> 3) + 8 * wave;
    g.b_w0 = 32768 + (4 * g.ng) * 128 + ((g.kg ^ ((4 * g.ng) & 7)) << 4);
    g.wm = wave >> 1; g.wn = wave & 1; g.l15 = lane & 15; g.lq = lane >> 4;
    const int sw = ((g.lq ^ (g.l15 & 7)) << 4);
    g.a_r = (64 * g.wm + g.l15) * 128 + sw;
    g.b_r = 32768 + (128 * g.wn + g.l15) * 128 + sw;
    g.arow0 = 32 * wave + (lane >> 3); g.achunk = ((lane & 7) ^ (lane >> 3)) * 16;
    g.rrow0 = 32 * wave + (lane >> 2); g.rchunk = sw4inv((lane & 3) ^ ((lane >> 4) & 3)) * 16;
    g.rfr = g.l15 * 64 + ((((g.l15 >> 2) & 3) ^ sw4(g.lq)) << 4);
    g.imgw0 = (g.kg >> 2) * 16384 + (4 * g.ng) * 64 + (((g.ng & 3) ^ sw4(g.kg & 3)) << 4);
    g.f8r0 = g.l15 * 64 + ((((g.l15 >> 2) & 3) ^ sw4(g.lq >> 1)) << 4) + 8 * (g.lq & 1);
    g.f8r1 = g.l15 * 64 + ((((g.l15 >> 2) & 3) ^ sw4(2 + (g.lq >> 1))) << 4) + 8 * (g.lq & 1);
    g.f8w0 = (4 * g.ng) * 64 + (((g.ng & 3) ^ sw4(g.kg >> 1)) << 4) + 8 * (g.kg & 1);
    { const int r32 = lane & 31, hh = lane >> 5, qq = (r32 >> 2) & 3;
      const int c0 = S8_KMAP ? hh : 2 * hh, c1 = S8_KMAP ? 2 + hh : 2 * hh + 1;
      g.s8r0 = r32 * 64 + ((qq ^ sw4(c0)) << 4); g.s8r1 = r32 * 64 + ((qq ^ sw4(c1)) << 4); }
    return g;
}

template <class T> __device__ __forceinline__ T* sgpr_ptr(T* p) {
    const unsigned long long v = (unsigned long long)p;
    const unsigned lo = __builtin_amdgcn_readfirstlane((unsigned)v), hi = __builtin_amdgcn_readfirstlane((unsigned)(v >> 32));
    typedef __attribute__((address_space(1))) T* gptr_t;
    return (T*)(gptr_t)(((unsigned long long)hi << 32) | lo);
}
__device__ __forceinline__ f32x4 ld_nt_async(const char* sbase, unsigned voff) {
    f32x4 r; asm volatile("global_load_dwordx4 %0, %1, %2 nt" : "=v"(r) : "v"(voff), "s"(sbase) : "memory"); return r;
}
#define RB_PIN(WAITSTR, RB) asm volatile(WAITSTR : "+v"(RB[0]), "+v"(RB[1]), "+v"(RB[2]), "+v"(RB[3]), "+v"(RB[4]), "+v"(RB[5]), "+v"(RB[6]), "+v"(RB[7]) :: "memory")
__device__ __forceinline__ void glds16(const void* src, char* lds_wave_base) {
    __builtin_amdgcn_global_load_lds((const unsigned*)src, (LAS unsigned*)lds_wave_base, 16, 0, 0);
}
#define G_AF(ks)  _Pragma("unroll") for (int i_ = 0; i_ < 4; ++i_) af[i_] = *(const bf16x8*)(sb + ((g.a_r ^ ((ks) << 6)) + i_ * 2048));
#define G_BF(ks, jh) _Pragma("unroll") for (int j_ = 0; j_ < 4; ++j_) bfr[j_] = *(const bf16x8*)(sb + ((g.b_r ^ ((ks) << 6)) + ((jh) * 4 + j_) * 2048));
#define G_MM(jh) _Pragma("unroll") for (int j_ = 0; j_ < 4; ++j_) _Pragma("unroll") for (int i_ = 0; i_ < 4; ++i_) \
        acc[i_][(jh) * 4 + j_] = __builtin_amdgcn_mfma_f32_16x16x32_bf16(bfr[j_], af[i_], acc[i_][(jh) * 4 + j_], 0, 0, 0);
#define G_WRB(sn, j_) do { u32x4 w_; \
        w_[0] = cvt_pk_bf16(rb[0][j_], rb[1][j_]); w_[1] = cvt_pk_bf16(rb[2][j_], rb[3][j_]); \
        w_[2] = cvt_pk_bf16(rb[4][j_], rb[5][j_]); w_[3] = cvt_pk_bf16(rb[6][j_], rb[7][j_]); \
        *(u32x4*)((sn) + (bw0_ ^ ((j_) * 0x90))) = w_; \
        if (IMG) *(u32x4*)(imgk + g.imgw0 + (j_) * 64) = w_; } while (0)
template <bool TWO_SEG, bool WR, bool LD, bool IMG>
__device__ __forceinline__ void gemm_step(f32x4 (&acc)[4][8], char* lds, const GemmThread& g, const int wave, f32x4 (&rb)[8], const int kt,
                                          const char* Abase, const unsigned (&aoffb)[4], const char* Bbase, const unsigned boffb, const int ldbB,
                                          const char* Abase2, const char* Bbase2, const int nk1, char* img) {
    asm volatile("s_waitcnt vmcnt(0)" ::: "memory");
    __syncthreads();
    const char* sb = lds + (kt & 1) * 65536; char* sn = lds + ((kt + 1) & 1) * 65536;
    char* imgk = img + (size_t)(kt + 1) * 32768;
    if (WR) {
        const int k1 = kt + 1; const bool s1 = TWO_SEG && k1 >= nk1; const char* ak = (s1 ? Abase2 : Abase) + (size_t)(s1 ? k1 - nk1 : k1) * 128;
#pragma unroll
        for (int i = 0; i < 4; ++i) glds16(ak + aoffb[i], sn + (4 * wave + i) * 1024);
    }
    int bw0_ = g.b_w0; asm volatile("" : "+v"(bw0_));
    bf16x8 af[4], bfr[4];
    G_AF(0) G_BF(0, 0) G_MM(0)
    if (WR) { G_WRB(sn, 0); G_WRB(sn, 1); }
    __builtin_amdgcn_sched_barrier(0);
    G_BF(0, 1) G_MM(1)
    if (WR) { G_WRB(sn, 2); G_WRB(sn, 3); }
    if (LD) {
        const int k2 = kt + 2; const bool s2 = TWO_SEG && k2 >= nk1; const int kk = s2 ? k2 - nk1 : k2;
        const char* bk = (s2 ? Bbase2 : Bbase) + (size_t)kk * 64 * ldbB;
#pragma unroll
        for (int k = 0; k < 8; ++k) rb[k] = *(const f32x4*)(bk + (size_t)k * ldbB + boffb);
    }
    __builtin_amdgcn_sched_barrier(0);
    G_AF(1) G_BF(1, 0) G_MM(0)
    __builtin_amdgcn_sched_barrier(0);
    G_BF(1, 1) G_MM(1)
}

template <bool TWO_SEG = false, bool IMG = false>
__device__ __forceinline__ void gemm_accum(f32x4 (&acc)[4][8], char* lds, const GemmThread& g, const int wave,
                                           const char* Abase, const unsigned (&aoffb)[4],
                                           const char* Bbase, const unsigned boffb, const int ldbB, const int nk,
                                           const char* Abase2 = nullptr, const char* Bbase2 = nullptr, const int nk1 = 0, char* img = nullptr) {
    f32x4 rb[8];
#define G_LOADB(kt) do { const char* bk_ = Bbase + (size_t)(kt) * 64 * ldbB; \
        _Pragma("unroll") for (int k_ = 0; k_ < 8; ++k_) rb[k_] = *(const f32x4*)(bk_ + (size_t)k_ * ldbB + boffb); } while (0)
#pragma unroll
    for (int i = 0; i < 4; ++i) glds16(Abase + aoffb[i], lds + (4 * wave + i) * 1024);
    G_LOADB(0);
    { char* sn = lds; char* imgk = img; const int bw0_ = g.b_w0; G_WRB(sn, 0); G_WRB(sn, 1); G_WRB(sn, 2); G_WRB(sn, 3); }
    G_LOADB(1);
    for (int kt = 0; kt < nk - 2; ++kt) gemm_step<TWO_SEG, true, true, IMG>(acc, lds, g, wave, rb, kt, Abase, aoffb, Bbase, boffb, ldbB, Abase2, Bbase2, nk1, img);
    gemm_step<TWO_SEG, true, false, IMG>(acc, lds, g, wave, rb, nk - 2, Abase, aoffb, Bbase, boffb, ldbB, Abase2, Bbase2, nk1, img);
    gemm_step<TWO_SEG, false, false, IMG>(acc, lds, g, wave, rb, nk - 1, Abase, aoffb, Bbase, boffb, ldbB, Abase2, Bbase2, nk1, img);
    __syncthreads();
#undef G_LOADB
}

#define R_MMJ(AF, BF, jh, j) do { _Pragma("unroll") for (int i_ = 0; i_ < 4; ++i_) \
        acc[i_][(jh) * 4 + (j)] = __builtin_amdgcn_mfma_f32_16x16x32_bf16(BF[j], AF[i_], acc[i_][(jh) * 4 + (j)], 0, 0, 0); } while (0)
#define R_SB() __builtin_amdgcn_sched_barrier(0)
#define R_MMI(AF, BF, i) do { _Pragma("unroll") for (int j_ = 0; j_ < 4; ++j_) \
        acc[i][4 + j_] = __builtin_amdgcn_mfma_f32_16x16x32_bf16(BF[j_], AF[i], acc[i][4 + j_], 0, 0, 0); } while (0)
__device__ __forceinline__ void gemm_accum_ring(f32x4 (&acc)[4][8], char* lds, const GemmThread& g, const int wave, const int lane,
                                                const char* Abase, const unsigned (&aoffb)[2], const char* Bimg, const int nk) {
    const unsigned boffl = (unsigned)wave * 2048u + (unsigned)lane * 16u;
    const int NS = 2 * nk;
    const int saoff = g.rfr + (64 * g.wm) * 64, sboff = 16384 + g.rfr + (128 * g.wn) * 64;
#pragma unroll
    for (int s = 0; s < 4; ++s) { char* sd = lds + s * 32768 + wave * 2048; const char* ak = sgpr_ptr(Abase + (size_t)s * 64); const char* bk = sgpr_ptr(Bimg + (size_t)s * 16384);
        glds16(ak + aoffb[0], sd); glds16(bk + boffl, sd + 16384); glds16(ak + aoffb[1], sd + 1024); glds16(bk + (boffl + 1024u), sd + 16384 + 1024); }
    asm volatile("s_waitcnt vmcnt(12)" ::: "memory");
    __builtin_amdgcn_s_barrier();
    asm volatile("" ::: "memory");
    bf16x8 a0[4], b0[4], b1[4];
#pragma unroll
    for (int i = 0; i < 4; ++i) a0[i] = *(const bf16x8*)(lds + saoff + i * 1024);
#pragma unroll
    for (int j = 0; j < 4; ++j) b0[j] = *(const bf16x8*)(lds + sboff + j * 1024);
#pragma unroll
    for (int j = 0; j < 4; ++j) b1[j] = *(const bf16x8*)(lds + sboff + (4 + j) * 1024);
#pragma unroll 1
    for (int s = 0; s < NS; ++s) {
        R_MMJ(a0, b0, 0, 0); R_MMJ(a0, b0, 0, 1); R_MMJ(a0, b0, 0, 2); R_MMJ(a0, b0, 0, 3);
        R_SB();
        asm volatile("s_waitcnt vmcnt(8)" ::: "memory");
        asm volatile("s_waitcnt lgkmcnt(0)" ::: "memory");
        __builtin_amdgcn_s_barrier();
        asm volatile("" ::: "memory");
        const bool ld = s + 4 < NS;
        const char* sn = lds + ((s + 1) & 3) * 32768;
        char* sd = lds + (s & 3) * 32768 + wave * 2048;
        const char* ak = sgpr_ptr(ld ? Abase + (size_t)(s + 4) * 64 : Bimg); const char* bk = sgpr_ptr(ld ? Bimg + (size_t)(s + 4) * 16384 : Bimg);
        const char* p0 = ak + (ld ? aoffb[0] : 0u); const char* p1 = bk + (ld ? boffl : 0u); const char* p2 = ak + (ld ? aoffb[1] : 0u); const char* p3 = bk + (ld ? boffl + 1024u : 0u);
#pragma unroll
        for (int j = 0; j < 4; ++j) b0[j] = *(const bf16x8*)(sn + sboff + j * 1024);
        glds16(p0, sd); R_SB();
        R_MMI(a0, b1, 0); R_SB();
        a0[0] = *(const bf16x8*)(sn + saoff); glds16(p1, sd + 16384); R_SB();
        R_MMI(a0, b1, 1); R_SB();
        a0[1] = *(const bf16x8*)(sn + saoff + 1024); glds16(p2, sd + 1024); R_SB();
        R_MMI(a0, b1, 2); R_SB();
        a0[2] = *(const bf16x8*)(sn + saoff + 2048); glds16(p3, sd + 16384 + 1024); R_SB();
        R_MMI(a0, b1, 3); R_SB();
        a0[3] = *(const bf16x8*)(sn + saoff + 3072);
#pragma unroll
        for (int j = 0; j < 4; ++j) b1[j] = *(const bf16x8*)(sn + sboff + (4 + j) * 1024);
        R_SB();
    }
    __syncthreads();
}

typedef long f8x8;
__device__ __forceinline__ unsigned cvt4_fp8(float a, float b, float c, float d) {
    unsigned w = 0; w = __builtin_amdgcn_cvt_pk_fp8_f32(a, b, w, false); w = __builtin_amdgcn_cvt_pk_fp8_f32(c, d, w, true); return w;
}
#define F8_RA(AF, off) _Pragma("unroll") for (int i_ = 0; i_ < 4; ++i_) AF[i_] = *(const f8x8*)(sa + (off) + i_ * 1024);
#define F8_RB(BF, off) _Pragma("unroll") for (int j_ = 0; j_ < 8; ++j_) BF[j_] = *(const f8x8*)(sbb + (off) + j_ * 1024);
#define F8_MMJ(AF, BF, j) do { _Pragma("unroll") for (int i_ = 0; i_ < 4; ++i_) \
        acc[i_][j] = __builtin_amdgcn_mfma_f32_16x16x32_fp8_fp8(BF[j], AF[i_], acc[i_][j], 0, 0, 0); } while (0)
template <int WAITN, bool LD>
__device__ __forceinline__ void f8_ring_step(f32x4 (&acc)[4][8], char* lds, const GemmThread& g, const int wave, const int s,
                                             const char* Abase, const unsigned (&aoffb)[2], const char* Bimg, const unsigned boffl) {
    if (WAITN == 8) asm volatile("s_waitcnt vmcnt(8)" ::: "memory"); else if (WAITN == 4) asm volatile("s_waitcnt vmcnt(4)" ::: "memory"); else asm volatile("s_waitcnt vmcnt(0)" ::: "memory");
    asm volatile("s_waitcnt lgkmcnt(0)" ::: "memory");
    __builtin_amdgcn_s_barrier();
    asm volatile("" ::: "memory");
    const char* sa = lds + (s & 3) * 32768 + (64 * g.wm) * 64; const char* sbb = lds + (s & 3) * 32768 + 16384 + (128 * g.wn) * 64;
    char* sd = lds + ((s + 3) & 3) * 32768 + wave * 2048;
    const char* ak = Abase + (size_t)(s + 3) * 64; const char* bk = Bimg + (size_t)(s + 3) * 16384 + boffl;
    f8x8 a0[4], b0[8], a1[4], b1[8];
    F8_RA(a0, g.f8r0) F8_RB(b0, g.f8r0)
    R_SB();
    F8_MMJ(a0, b0, 0); R_SB(); if (LD) glds16(ak + aoffb[0], sd); R_SB();
    F8_MMJ(a0, b0, 1); R_SB(); if (LD) glds16(bk, sd + 16384); R_SB();
    F8_MMJ(a0, b0, 2); R_SB(); if (LD) glds16(ak + aoffb[1], sd + 1024); R_SB();
    F8_MMJ(a0, b0, 3); R_SB(); if (LD) glds16(bk + 1024, sd + 16384 + 1024); R_SB();
    F8_RA(a1, g.f8r1) F8_RB(b1, g.f8r1)
    R_SB();
    F8_MMJ(a0, b0, 4); F8_MMJ(a0, b0, 5); F8_MMJ(a0, b0, 6); F8_MMJ(a0, b0, 7);
    R_SB();
    F8_MMJ(a1, b1, 0); F8_MMJ(a1, b1, 1); F8_MMJ(a1, b1, 2); F8_MMJ(a1, b1, 3); F8_MMJ(a1, b1, 4); F8_MMJ(a1, b1, 5); F8_MMJ(a1, b1, 6); F8_MMJ(a1, b1, 7);
}
__device__ __forceinline__ void f8_accum_ring(f32x4 (&acc)[4][8], char* lds, const GemmThread& g, const int wave, const int lane,
                                              const char* Abase, const unsigned (&aoffb)[2], const char* Bimg, const int nk) {
    const unsigned boffl = (unsigned)wave * 2048u + (unsigned)lane * 16u;
#pragma unroll
    for (int s = 0; s < 3; ++s) { char* sd = lds + s * 32768 + wave * 2048; const char* ak = Abase + (size_t)s * 64; const char* bk = Bimg + (size_t)s * 16384 + boffl;
        glds16(ak + aoffb[0], sd); glds16(bk, sd + 16384); glds16(ak + aoffb[1], sd + 1024); glds16(bk + 1024, sd + 16384 + 1024); }
    for (int s = 0; s < nk - 3; ++s) f8_ring_step<8, true>(acc, lds, g, wave, s, Abase, aoffb, Bimg, boffl);
    f8_ring_step<8, false>(acc, lds, g, wave, nk - 3, Abase, aoffb, Bimg, boffl);
    f8_ring_step<4, false>(acc, lds, g, wave, nk - 2, Abase, aoffb, Bimg, boffl);
    f8_ring_step<0, false>(acc, lds, g, wave, nk - 1, Abase, aoffb, Bimg, boffl);
    __syncthreads();
}
typedef int i32x8 __attribute__((ext_vector_type(8)));
typedef int i32x4 __attribute__((ext_vector_type(4)));
__device__ __forceinline__ i32x8 s8_frag(const char* p0, const char* p1) {
    const i32x4 lo = *(const i32x4*)p0, hi = *(const i32x4*)p1;
    return __builtin_shufflevector(lo, hi, 0, 1, 2, 3, 4, 5, 6, 7);
}
#define S8_MM(i, j) acc[i][j] = __builtin_amdgcn_mfma_scale_f32_32x32x64_f8f6f4(bf[j], af[i], acc[i][j], 0, 0, 0, 0x7F7F7F7F, 0, 0x7F7F7F7F)
#define S8_FR(base) s8_frag((base) + g.s8r0, (base) + g.s8r1)
__device__ __forceinline__ void s8_accum_ring(f32x16 (&acc)[2][4], char* lds, const GemmThread& g, const int wave, const int lane,
                                              const char* Abase, const unsigned (&aoffb)[2], const char* Bimg, const int nk, const unsigned astr = 64) {
    const unsigned boffl = (unsigned)wave * 2048u + (unsigned)lane * 16u;
    const int saoff = (64 * g.wm) * 64, sboff = 16384 + (128 * g.wn) * 64;
#pragma unroll
    for (int s = 0; s < 4; ++s) { char* sd = lds + s * 32768 + wave * 2048; const char* ak = sgpr_ptr(Abase + (size_t)s * astr); const char* bk = sgpr_ptr(Bimg + (size_t)s * 16384);
        glds16(ak + aoffb[0], sd); glds16(bk + boffl, sd + 16384); glds16(ak + aoffb[1], sd + 1024); glds16(bk + (boffl + 1024u), sd + 16384 + 1024); }
    asm volatile("s_waitcnt vmcnt(12)" ::: "memory");
    __builtin_amdgcn_s_barrier();
    asm volatile("" ::: "memory");
    i32x8 af[2], bf[4];
    af[0] = S8_FR(lds + saoff);
#pragma unroll
    for (int j = 0; j < 4; ++j) bf[j] = S8_FR(lds + sboff + j * 2048);
    af[1] = S8_FR(lds + saoff + 2048);
#pragma unroll 1
    for (int s = 0; s < nk; ++s) {
        S8_MM(0, 0); S8_MM(0, 1); S8_MM(0, 2); S8_MM(0, 3);
        R_SB();
        asm volatile("s_waitcnt vmcnt(8)" ::: "memory");
        asm volatile("s_waitcnt lgkmcnt(0)" ::: "memory");
        __builtin_amdgcn_s_barrier();
        asm volatile("" ::: "memory");
        const bool ld = s + 4 < nk;
        const char* sn = lds + ((s + 1) & 3) * 32768;
        char* sd = lds + (s & 3) * 32768 + wave * 2048;
        const char* ak = sgpr_ptr(ld ? Abase + (size_t)(s + 4) * astr : Bimg); const char* bk = sgpr_ptr(ld ? Bimg + (size_t)(s + 4) * 16384 : Bimg);
        const char* p0 = ak + (ld ? aoffb[0] : 0u); const char* p1 = bk + (ld ? boffl : 0u); const char* p2 = ak + (ld ? aoffb[1] : 0u); const char* p3 = bk + (ld ? boffl + 1024u : 0u);
        af[0] = S8_FR(sn + saoff); glds16(p0, sd); R_SB();
        S8_MM(1, 0); R_SB();
        bf[0] = S8_FR(sn + sboff); glds16(p1, sd + 16384); R_SB();
        S8_MM(1, 1); R_SB();
        bf[1] = S8_FR(sn + sboff + 2048); glds16(p2, sd + 1024); R_SB();
        S8_MM(1, 2); R_SB();
        bf[2] = S8_FR(sn + sboff + 4096); glds16(p3, sd + 16384 + 1024); R_SB();
        S8_MM(1, 3); R_SB();
        bf[3] = S8_FR(sn + sboff + 6144); af[1] = S8_FR(sn + saoff + 2048); R_SB();
    }
    __syncthreads();
}
__device__ __forceinline__ void s8_accum_ring_h(f32x16 (&acc)[2][2], char* lds, const GemmThread& g, const int wave, const int lane,
                                                const char* Abase, const unsigned (&aoffb)[2], const char* Bimg, const int nk, const unsigned astr) {
    const unsigned boffl = (unsigned)wave * 1024u + (unsigned)lane * 16u;
    const int saoff = (64 * g.wm) * 64, sboff = 16384 + (64 * g.wn) * 64;
#pragma unroll
    for (int s = 0; s < 4; ++s) { char* sd = lds + s * 32768; const char* ak = Abase + (size_t)s * astr; const char* bk = Bimg + (size_t)s * 16384 + boffl;
        glds16(ak + aoffb[0], sd + wave * 2048); glds16(bk, sd + 16384 + wave * 1024); glds16(ak + aoffb[1], sd + wave * 2048 + 1024); }
    asm volatile("s_waitcnt vmcnt(9)" ::: "memory");
    __builtin_amdgcn_s_barrier();
    asm volatile("" ::: "memory");
    i32x8 af[2], bf[2];
    af[0] = S8_FR(lds + saoff); bf[0] = S8_FR(lds + sboff); bf[1] = S8_FR(lds + sboff + 2048); af[1] = S8_FR(lds + saoff + 2048);
#pragma unroll 1
    for (int s = 0; s < nk; ++s) {
        S8_MM(0, 0); S8_MM(0, 1);
        R_SB();
        asm volatile("s_waitcnt vmcnt(6)" ::: "memory");
        asm volatile("s_waitcnt lgkmcnt(0)" ::: "memory");
        __builtin_amdgcn_s_barrier();
        asm volatile("" ::: "memory");
        const bool ld = s + 4 < nk;
        const char* sn = lds + ((s + 1) & 3) * 32768;
        char* sd = lds + (s & 3) * 32768;
        const char* ak = Abase + (size_t)(s + 4) * astr; const char* bk = Bimg + (size_t)(s + 4) * 16384 + boffl;
        const char* p0 = ld ? ak + aoffb[0] : Bimg; const char* p1 = ld ? bk : Bimg; const char* p2 = ld ? ak + aoffb[1] : Bimg;
        af[0] = S8_FR(sn + saoff); glds16(p0, sd + wave * 2048); R_SB();
        S8_MM(1, 0); R_SB();
        bf[0] = S8_FR(sn + sboff); glds16(p1, sd + 16384 + wave * 1024); R_SB();
        S8_MM(1, 1); R_SB();
        bf[1] = S8_FR(sn + sboff + 2048); af[1] = S8_FR(sn + saoff + 2048); glds16(p2, sd + wave * 2048 + 1024); R_SB();
    }
    __syncthreads();
}
#define F8_WRB(sn, j_) do { u32x2 w_; \
        w_[0] = cvt4_fp8(rb[0][j_] * FP8_SW, rb[1][j_] * FP8_SW, rb[2][j_] * FP8_SW, rb[3][j_] * FP8_SW); \
        w_[1] = cvt4_fp8(rb[4][j_] * FP8_SW, rb[5][j_] * FP8_SW, rb[6][j_] * FP8_SW, rb[7][j_] * FP8_SW); \
        *(u32x2*)((sn) + 16384 + bw8_ + (j_) * 64) = w_; } while (0)
template <bool WR, bool LD, bool W8>
__device__ __forceinline__ void f8_w32_step(f32x4 (&acc)[4][8], char* lds, const GemmThread& g, const int wave, f32x4 (&rb)[8], const int kt,
                                            const char* Abase, const unsigned (&aoffb)[2], const char* Bbase, const unsigned boffb, const int ldbB, char* img, const unsigned astr) {
    if (WR) { if (W8) RB_PIN("s_waitcnt vmcnt(8)", rb); else RB_PIN("s_waitcnt vmcnt(0)", rb); }
    else { if (W8) asm volatile("s_waitcnt vmcnt(8)" ::: "memory"); else asm volatile("s_waitcnt vmcnt(0)" ::: "memory"); }
    asm volatile("s_waitcnt lgkmcnt(0)" ::: "memory");
    __builtin_amdgcn_s_barrier();
    asm volatile("" ::: "memory");
    const char* sa = lds + (kt & 1) * 32768 + (64 * g.wm) * 64; const char* sbb = lds + (kt & 1) * 32768 + 16384 + (128 * g.wn) * 64;
    char* sn = lds + ((kt + 1) & 1) * 32768;
    if (WR) { const char* ak = Abase + (size_t)(kt + 1) * astr; glds16(ak + aoffb[0], sn + (2 * wave) * 1024); glds16(ak + aoffb[1], sn + (2 * wave + 1) * 1024); }
    {
        int to = (int)threadIdx.x * 16; asm volatile("" : "+v"(to));
        const char* sbi = lds + (kt & 1) * 32768 + 16384; char* imgk = img + (size_t)kt * 16384;
        const u32x4 i0 = *(const u32x4*)(sbi + to), i1 = *(const u32x4*)(sbi + 8192 + to);
        *(u32x4*)(imgk + to) = i0; *(u32x4*)(imgk + 8192 + to) = i1; }
    int bw8_ = g.f8w0; asm volatile("" : "+v"(bw8_));
    f8x8 a0[4], b0[8];
    F8_RA(a0, g.f8r0) F8_RB(b0, g.f8r0)
    F8_MMJ(a0, b0, 0); F8_MMJ(a0, b0, 1); F8_MMJ(a0, b0, 2); F8_MMJ(a0, b0, 3);
    if (WR) { F8_WRB(sn, 0); F8_WRB(sn, 1); }
    __builtin_amdgcn_sched_barrier(0);
    F8_MMJ(a0, b0, 4); F8_MMJ(a0, b0, 5); F8_MMJ(a0, b0, 6); F8_MMJ(a0, b0, 7);
    if (WR) { F8_WRB(sn, 2); F8_WRB(sn, 3); }
    if (LD) { const char* bk = Bbase + (size_t)(kt + 3) * 64 * ldbB;
#pragma unroll
        for (int k = 0; k < 8; ++k) rb[k] = ld_nt_async(sgpr_ptr(bk + (size_t)k * ldbB), boffb); }
    __builtin_amdgcn_sched_barrier(0);
    F8_RA(a0, g.f8r1) F8_RB(b0, g.f8r1)
    F8_MMJ(a0, b0, 0); F8_MMJ(a0, b0, 1); F8_MMJ(a0, b0, 2); F8_MMJ(a0, b0, 3);
    __builtin_amdgcn_sched_barrier(0);
    F8_MMJ(a0, b0, 4); F8_MMJ(a0, b0, 5); F8_MMJ(a0, b0, 6); F8_MMJ(a0, b0, 7);
}
__device__ __forceinline__ void f8_accum_w32(f32x4 (&acc)[4][8], char* lds, const GemmThread& g, const int wave,
                                             const char* Abase, const unsigned (&aoffb)[2], const char* Bbase, const unsigned boffb, const int ldbB, const int nk, char* img, const unsigned astr = 64) {
    f32x4 rbA[8], rbB[8];
#define F8_LOADB(RB, kt) do { const char* bk_ = Bbase + (size_t)(kt) * 64 * ldbB; \
        _Pragma("unroll") for (int k_ = 0; k_ < 8; ++k_) RB[k_] = ld_nt_async(sgpr_ptr(bk_ + (size_t)k_ * ldbB), boffb); } while (0)
    glds16(Abase + aoffb[0], lds + (2 * wave) * 1024); glds16(Abase + aoffb[1], lds + (2 * wave + 1) * 1024);
    F8_LOADB(rbA, 0);
    RB_PIN("s_waitcnt vmcnt(0)", rbA);
    { f32x4 (&rb)[8] = rbA; char* sn = lds; const int bw8_ = g.f8w0; F8_WRB(sn, 0); F8_WRB(sn, 1); F8_WRB(sn, 2); F8_WRB(sn, 3); }
    F8_LOADB(rbA, 1);
    F8_LOADB(rbB, 2);
#pragma unroll 1
    for (int kt = 0; kt < nk - 4; kt += 2) {
        f8_w32_step<true, true, true>(acc, lds, g, wave, rbA, kt, Abase, aoffb, Bbase, boffb, ldbB, img, astr);
        f8_w32_step<true, true, true>(acc, lds, g, wave, rbB, kt + 1, Abase, aoffb, Bbase, boffb, ldbB, img, astr);
    }
    f8_w32_step<true, true, true>(acc, lds, g, wave, rbA, nk - 4, Abase, aoffb, Bbase, boffb, ldbB, img, astr);
    f8_w32_step<true, false, true>(acc, lds, g, wave, rbB, nk - 3, Abase, aoffb, Bbase, boffb, ldbB, img, astr);
    f8_w32_step<true, false, false>(acc, lds, g, wave, rbA, nk - 2, Abase, aoffb, Bbase, boffb, ldbB, img, astr);
    f8_w32_step<false, false, false>(acc, lds, g, wave, rbB, nk - 1, Abase, aoffb, Bbase, boffb, ldbB, img, astr);
    __syncthreads();
#undef F8_LOADB
}
#define W32S_MM(i, j) acc[i][j] = __builtin_amdgcn_mfma_scale_f32_32x32x64_f8f6f4(bf, af[i], acc[i][j], 0, 0, 0, 0x7F7F7F7F, 0, 0x7F7F7F7F)
template <bool WR, bool LD, bool W8>
__device__ __forceinline__ void f8_w32s_step(f32x16 (&acc)[2][4], char* lds, const GemmThread& g, const int wave, f32x4 (&rb)[8], const int kt,
                                            const char* Abase, const unsigned (&aoffb)[2], const char* Bbase, const unsigned boffb, const int ldbB, char* img, const unsigned astr) {
    if (WR) { if (W8) RB_PIN("s_waitcnt vmcnt(8)", rb); else RB_PIN("s_waitcnt vmcnt(0)", rb); }
    else { if (W8) asm volatile("s_waitcnt vmcnt(8)" ::: "memory"); else asm volatile("s_waitcnt vmcnt(0)" ::: "memory"); }
    asm volatile("s_waitcnt lgkmcnt(0)" ::: "memory");
    __builtin_amdgcn_s_barrier();
    asm volatile("" ::: "memory");
    const char* sa = lds + (kt & 1) * 32768 + (64 * g.wm) * 64; const char* sbb = lds + (kt & 1) * 32768 + 16384 + (128 * g.wn) * 64;
    char* sn = lds + ((kt + 1) & 1) * 32768;
    if (WR) { const char* ak = Abase + (size_t)(kt + 1) * astr; glds16(ak + aoffb[0], sn + (2 * wave) * 1024); glds16(ak + aoffb[1], sn + (2 * wave + 1) * 1024); }
    {
        int to = (int)threadIdx.x * 16; asm volatile("" : "+v"(to));
        const char* sbi = lds + (kt & 1) * 32768 + 16384; char* imgk = img + (size_t)kt * 16384;
        const u32x4 i0 = *(const u32x4*)(sbi + to), i1 = *(const u32x4*)(sbi + 8192 + to);
        *(u32x4*)(imgk + to) = i0; *(u32x4*)(imgk + 8192 + to) = i1; }
    int bw8_ = g.f8w0; asm volatile("" : "+v"(bw8_));
    i32x8 af[2], bf;
#pragma unroll
    for (int i = 0; i < 2; ++i) af[i] = s8_frag(sa + i * 2048 + g.s8r0, sa + i * 2048 + g.s8r1);
    bf = s8_frag(sbb + g.s8r0, sbb + g.s8r1);
    W32S_MM(0, 0); W32S_MM(1, 0);
    __builtin_amdgcn_sched_barrier(0);
    bf = s8_frag(sbb + 2048 + g.s8r0, sbb + 2048 + g.s8r1);
    if (WR) { F8_WRB(sn, 0); F8_WRB(sn, 1); }
    W32S_MM(0, 1); W32S_MM(1, 1);
    __builtin_amdgcn_sched_barrier(0);
    bf = s8_frag(sbb + 4096 + g.s8r0, sbb + 4096 + g.s8r1);
    if (WR) { F8_WRB(sn, 2); F8_WRB(sn, 3); }
    if (LD) { const char* bk = Bbase + (size_t)(kt + 3) * 64 * ldbB;
#pragma unroll
        for (int k = 0; k < 8; ++k) rb[k] = ld_nt_async(sgpr_ptr(bk + (size_t)k * ldbB), boffb); }
    W32S_MM(0, 2); W32S_MM(1, 2);
    __builtin_amdgcn_sched_barrier(0);
    bf = s8_frag(sbb + 6144 + g.s8r0, sbb + 6144 + g.s8r1);
    W32S_MM(0, 3); W32S_MM(1, 3);
}
__device__ __forceinline__ void f8_accum_w32s(f32x16 (&acc)[2][4], char* lds, const GemmThread& g, const int wave,
                                             const char* Abase, const unsigned (&aoffb)[2], const char* Bbase, const unsigned boffb, const int ldbB, const int nk, char* img, const unsigned astr = 64) {
    f32x4 rbA[8], rbB[8];
#define F8_LOADB(RB, kt) do { const char* bk_ = Bbase + (size_t)(kt) * 64 * ldbB; \
        _Pragma("unroll") for (int k_ = 0; k_ < 8; ++k_) RB[k_] = ld_nt_async(sgpr_ptr(bk_ + (size_t)k_ * ldbB), boffb); } while (0)
    glds16(Abase + aoffb[0], lds + (2 * wave) * 1024); glds16(Abase + aoffb[1], lds + (2 * wave + 1) * 1024);
    F8_LOADB(rbA, 0);
    RB_PIN("s_waitcnt vmcnt(0)", rbA);
    { f32x4 (&rb)[8] = rbA; char* sn = lds; const int bw8_ = g.f8w0; F8_WRB(sn, 0); F8_WRB(sn, 1); F8_WRB(sn, 2); F8_WRB(sn, 3); }
    F8_LOADB(rbA, 1);
    F8_LOADB(rbB, 2);
#pragma unroll 1
    for (int kt = 0; kt < nk - 4; kt += 2) {
        f8_w32s_step<true, true, true>(acc, lds, g, wave, rbA, kt, Abase, aoffb, Bbase, boffb, ldbB, img, astr);
        f8_w32s_step<true, true, true>(acc, lds, g, wave, rbB, kt + 1, Abase, aoffb, Bbase, boffb, ldbB, img, astr);
    }
    f8_w32s_step<true, true, true>(acc, lds, g, wave, rbA, nk - 4, Abase, aoffb, Bbase, boffb, ldbB, img, astr);
    f8_w32s_step<true, false, true>(acc, lds, g, wave, rbB, nk - 3, Abase, aoffb, Bbase, boffb, ldbB, img, astr);
    f8_w32s_step<true, false, false>(acc, lds, g, wave, rbA, nk - 2, Abase, aoffb, Bbase, boffb, ldbB, img, astr);
    f8_w32s_step<false, false, false>(acc, lds, g, wave, rbB, nk - 1, Abase, aoffb, Bbase, boffb, ldbB, img, astr);
    __syncthreads();
#undef F8_LOADB
}

struct EpiLane { int l15, lq, wm, wn; };
__device__ __forceinline__ EpiLane epi_lane(const GemmThread& g) { EpiLane e; e.l15 = g.l15; e.lq = g.lq; e.wm = g.wm; e.wn = g.wn; asm volatile("" : "+v"(e.l15), "+v"(e.lq)); return e; }
constexpr int STG_PITCH = 272, STG_WAVE = 64 * STG_PITCH;
#define stg_base(F) ((F).lds + (F).wave * STG_WAVE)
__device__ __forceinline__ void stg_put(char* tw, const EpiLane& el, int i, int j, u32x2 w) { *(u32x2*)(tw + (16 * i + el.l15) * STG_PITCH + (16 * j + 4 * el.lq) * 2) = w; }
__device__ __forceinline__ void stg_flush_(int lane, char* tw, bf16_t* dst, size_t ld) {
    int ln = lane; asm volatile("" : "+v"(ln));
#pragma unroll 4
    for (int q = 0; q < 16; ++q) { const int rl = q * 4 + (ln >> 4), chunk = ln & 15;
        *(u32x4*)(dst + (size_t)rl * ld + chunk * 8) = *(const u32x4*)(tw + rl * STG_PITCH + chunk * 16); }
    __syncthreads();
}
#define stg_flush(F, tw, dst, ld) stg_flush_((F).lane, tw, dst, ld)
__device__ __forceinline__ void acc_zero(f32x4 (&acc)[4][8]) {
#pragma unroll
    for (int i = 0; i < 4; ++i)
#pragma unroll
        for (int j = 0; j < 8; ++j) acc[i][j] = (f32x4){0.f, 0.f, 0.f, 0.f};
}
__device__ __forceinline__ bool patch_unit(int u, int nMt, int nNt, int& mt, int& nt) {
    const int pM = nMt / 8, p = u >> 5, q = u & 31;
    mt = (p % pM) * 8 + (q & 7); nt = (p / pM) * 4 + (q >> 3);
    return nt < nNt;
}
__device__ __forceinline__ int vcu_of_block(int bx, int G) { return (G % 8 == 0) ? (bx % 8) * (G / 8) + bx / 8 : bx; }

namespace attn {
constexpr int D = 128, NW = 8, QBLK = 32, KVBLK = 64;
constexpr float SCALE = 0.088388347648318440f;
constexpr float THR = 8.f;
constexpr int LDQ = AW, LDK = KVW, LDO = DM;
constexpr size_t SHM_V = KVBLK * D * 2, SHM_K = KVBLK * D * 2, SHM_ATTN = 2 * SHM_V + 2 * SHM_K + NW * 64 * 4;
#define KSWZ(row, colB) ((row) * 256 + ((colB) ^ (((row) & 7) << 4)))
#define SBAR() __builtin_amdgcn_sched_barrier(0)
__device__ __forceinline__ int crow(int r, int hi) { return (r & 3) + 8 * (r >> 2) + 4 * hi; }
__device__ __forceinline__ unsigned cvtpk(float lo, float hi) { return cvt_pk_bf16(lo, hi); }

__device__ __forceinline__ void partialSM(f32x16& p0, f32x16& p1, float& m_reg, float& mn, float& alpha) {
  constexpr float C = SCALE * 1.4426950408889634f;
  float pmax = p0[0]; for (int r = 1; r < 16; ++r) pmax = fmaxf(pmax, p0[r]); for (int r = 0; r < 16; ++r) pmax = fmaxf(pmax, p1[r]);
  { auto rr = __builtin_amdgcn_permlane32_swap(__float_as_uint(pmax), __float_as_uint(pmax), false, false);
    pmax = fmaxf(__uint_as_float(rr[0]), __uint_as_float(rr[1])); }
  if (__builtin_expect(__all(pmax - m_reg <= THR / SCALE), 1)) { mn = m_reg; alpha = 1.f; }
  else { mn = fmaxf(m_reg, pmax); alpha = __builtin_amdgcn_exp2f((m_reg - mn) * C); m_reg = mn; }
  float mnC = -mn * C;
  for (int r = 0; r < 16; ++r) p0[r] = fmaf(p0[r], C, mnC); for (int r = 0; r < 16; ++r) p1[r] = fmaf(p1[r], C, mnC);
  for (int r = 0; r < 16; ++r) p0[r] = __builtin_amdgcn_exp2f(p0[r]);
}
__device__ __forceinline__ void finishSM(f32x16& p0, f32x16& p1, float alpha, float& l_reg, bf16x8& pa0, bf16x8& pa1, bf16x8& pa2, bf16x8& pa3) {
  for (int r = 0; r < 16; ++r) p1[r] = __builtin_amdgcn_exp2f(p1[r]);
  float ps = 0; for (int r = 0; r < 16; ++r) ps += p0[r]; for (int r = 0; r < 16; ++r) ps += p1[r];
  { auto rr = __builtin_amdgcn_permlane32_swap(__float_as_uint(ps), __float_as_uint(ps), false, false);
    ps = __uint_as_float(rr[0]) + __uint_as_float(rr[1]); }
  l_reg = l_reg * alpha + ps;
#define PK4(P, BASE, OUT) do { unsigned a0 = cvtpk(P[BASE + 0], P[BASE + 1]), a1 = cvtpk(P[BASE + 2], P[BASE + 3]);   \
    unsigned b0 = cvtpk(P[BASE + 4], P[BASE + 5]), b1 = cvtpk(P[BASE + 6], P[BASE + 7]);                              \
    auto r0 = __builtin_amdgcn_permlane32_swap(a0, b0, false, false); auto r1 = __builtin_amdgcn_permlane32_swap(a1, b1, false, false); \
    u32x4 w = {r0[0], r1[0], r0[1], r1[1]}; OUT = *reinterpret_cast<bf16x8*>(&w); } while (0)
  PK4(p0, 0, pa0); PK4(p0, 8, pa1); PK4(p1, 0, pa2); PK4(p1, 8, pa3);
#undef PK4
}
__device__ __forceinline__ void qkt(f32x16& p0, f32x16& p1, const bf16_t* Ks, const bf16x8* qr, int r32, int hi) {
  p0 = f32x16{}; p1 = f32x16{};
  for (int d0 = 0; d0 < 8; ++d0) { int cb = (d0 * 16 + hi * 8) * 2;
    bf16x8 b0 = *reinterpret_cast<const bf16x8*>((const char*)Ks + KSWZ(r32, cb));
    bf16x8 b1 = *reinterpret_cast<const bf16x8*>((const char*)Ks + KSWZ(32 + r32, cb));
    p0 = __builtin_amdgcn_mfma_f32_32x32x16_bf16(b0, qr[d0], p0, 0, 0, 0);
    p1 = __builtin_amdgcn_mfma_f32_32x32x16_bf16(b1, qr[d0], p1, 0, 0, 0); }
}
__device__ __forceinline__ int v_st(int k, int c) { const int kk = (k & ~0xC) | ((k & 4) << 1) | ((k & 8) >> 1); return ((kk >> 3) * 4 + (c >> 5)) * 512 + ((kk & 7) * 32 + (c & 31)) * 2; }
__device__ __forceinline__ int v_rd_base(int lane) { return ((lane & 3) << 3) | (((lane >> 2) & 3) << 6) | (((lane >> 4) & 1) << 5) | (((lane >> 5) & 1) << 8); }
constexpr int v_rd_off(int d0, int ks, int half) { return d0 * 512 + ks * 4096 + half * 2048; }
template <int OFF> __device__ __forceinline__ s16x4 tr_read(int vb) {
  s16x4 r; asm volatile("ds_read_b64_tr_b16 %0, %1 offset:%2" : "=&v"(r) : "v"(vb), "i"(OFF) : "memory"); return r;
}
template <int D0> __device__ __forceinline__ void pv_one(f32x16& od, int vb, bf16x8 pa0, bf16x8 pa1, bf16x8 pa2, bf16x8 pa3) {
  const s16x4 l0 = tr_read<v_rd_off(D0, 0, 0)>(vb), h0 = tr_read<v_rd_off(D0, 0, 1)>(vb), l1 = tr_read<v_rd_off(D0, 1, 0)>(vb), h1 = tr_read<v_rd_off(D0, 1, 1)>(vb);
  const s16x4 l2 = tr_read<v_rd_off(D0, 2, 0)>(vb), h2 = tr_read<v_rd_off(D0, 2, 1)>(vb), l3 = tr_read<v_rd_off(D0, 3, 0)>(vb), h3 = tr_read<v_rd_off(D0, 3, 1)>(vb);
  asm volatile("s_waitcnt lgkmcnt(0)" ::: "memory"); SBAR();
#define PK(L, H) (bf16x8){L[0], L[1], L[2], L[3], H[0], H[1], H[2], H[3]}
  od = __builtin_amdgcn_mfma_f32_32x32x16_bf16(pa0, PK(l0, h0), od, 0, 0, 0);
  od = __builtin_amdgcn_mfma_f32_32x32x16_bf16(pa1, PK(l1, h1), od, 0, 0, 0);
  od = __builtin_amdgcn_mfma_f32_32x32x16_bf16(pa2, PK(l2, h2), od, 0, 0, 0);
  od = __builtin_amdgcn_mfma_f32_32x32x16_bf16(pa3, PK(l3, h3), od, 0, 0, 0);
#undef PK
}
__device__ __forceinline__ void pv_d0(f32x16* o, int vb, bf16x8 pa0, bf16x8 pa1, bf16x8 pa2, bf16x8 pa3) {
  pv_one<0>(o[0], vb, pa0, pa1, pa2, pa3); pv_one<1>(o[1], vb, pa0, pa1, pa2, pa3); pv_one<2>(o[2], vb, pa0, pa1, pa2, pa3); pv_one<3>(o[3], vb, pa0, pa1, pa2, pa3);
}
__device__ __forceinline__ void attn_dense_body(const bf16_t* __restrict__ Qb, const bf16_t* __restrict__ Kh, const bf16_t* __restrict__ Vh, bf16_t* __restrict__ Ob, int seq, char* lds) {
  const int tid = threadIdx.x, wid = tid >> 6, lane = tid & 63, r32 = lane & 31, hi = lane >> 5;
  bf16_t* V_lds = (bf16_t*)lds; bf16_t* K_lds = (bf16_t*)(lds + 2 * SHM_V);
  float* ws = (float*)(lds + 2 * SHM_V + 2 * SHM_K) + wid * 64; float* li_l = ws; float* al_l = ws + 32;
  float m_reg = -1e30f, l_reg = 0; f32x16 o[4] = {}; bf16x8 qr[8];
  const bf16_t* Qw = Qb + (long)(wid * QBLK + r32) * LDQ + hi * 8;
#pragma unroll
  for (int d0 = 0; d0 < 8; ++d0) qr[d0] = *reinterpret_cast<const bf16x8*>(Qw + d0 * 16);
  const int sr = tid >> 4, sc = (tid & 15) * 8, vst0 = v_st(sr, sc), vst1 = v_st(32 + sr, sc);
  const int vb0 = (int)(uintptr_t)V_lds + v_rd_base(lane);
  struct { bf16x8 vs0, vs1, ks0, ks1; } sr_[2];
#define LD8(p) (*reinterpret_cast<const bf16x8*>(p))
#define SLOAD(i, k0) do { sr_[i].vs0 = LD8(&Vh[(long)((k0) + sr) * LDK + sc]); sr_[i].vs1 = LD8(&Vh[(long)((k0) + 32 + sr) * LDK + sc]); \
    sr_[i].ks0 = LD8(&Kh[(long)((k0) + sr) * LDK + sc]); sr_[i].ks1 = LD8(&Kh[(long)((k0) + 32 + sr) * LDK + sc]); } while (0)
#define SWRITE(b, i) do { *(bf16x8*)((char*)V_lds + (b) * SHM_V + vst0) = sr_[i].vs0;          \
    *(bf16x8*)((char*)V_lds + (b) * SHM_V + vst1) = sr_[i].vs1; int kc = sc * 2;               \
    *(bf16x8*)((char*)K_lds + (b) * SHM_K + KSWZ(sr, kc)) = sr_[i].ks0;                       \
    *(bf16x8*)((char*)K_lds + (b) * SHM_K + KSWZ(32 + sr, kc)) = sr_[i].ks1; } while (0)
#define SWAIT() do { asm volatile("s_waitcnt vmcnt(4)" ::: "memory"); } while (0)
#define RESC(a) do { if (__any((a) < 1.f)) { if (hi == 0) al_l[r32] = (a); asm volatile("s_waitcnt lgkmcnt(0)" ::: "memory"); \
    for (int d = 0; d < 4; ++d) for (int r = 0; r < 16; ++r) o[d][r] *= al_l[crow(r, hi)]; } } while (0)
  f32x16 pA0, pA1, pB0, pB1; float mnA, mnB, alA, alB; bf16x8 pa0, pa1, pa2, pa3; const int NT = seq / KVBLK;
  constexpr int SE = 0, SO = 1;
  SLOAD(SE, 0); asm volatile("s_waitcnt vmcnt(0)" ::: "memory"); SWRITE(0, SE); __syncthreads();
  qkt(pA0, pA1, K_lds, qr, r32, hi); partialSM(pA0, pA1, m_reg, mnA, alA);
  SLOAD(SO, KVBLK); if (2 < NT) SLOAD(SE, 2 * KVBLK);
  SWAIT(); SWRITE(1, SO); __syncthreads();
  for (int j = 1; j + 1 < NT; j += 2) {
    SBAR(); qkt(pB0, pB1, (bf16_t*)((char*)K_lds + SHM_K), qr, r32, hi);
    finishSM(pA0, pA1, alA, l_reg, pa0, pa1, pa2, pa3); SBAR();
    SLOAD(SO, (j + 2) * KVBLK); SBAR();
    pv_d0(o, vb0, pa0, pa1, pa2, pa3); partialSM(pB0, pB1, m_reg, mnB, alB);
    __syncthreads(); SWAIT(); SWRITE(0, SE);
    RESC(alB); __syncthreads();
    SBAR(); qkt(pA0, pA1, K_lds, qr, r32, hi);
    finishSM(pB0, pB1, alB, l_reg, pa0, pa1, pa2, pa3); SBAR();
    if (j + 3 < NT) SLOAD(SE, (j + 3) * KVBLK); SBAR();
    pv_d0(o, vb0 + (int)SHM_V, pa0, pa1, pa2, pa3); partialSM(pA0, pA1, m_reg, mnA, alA);
    __syncthreads(); SWAIT(); SWRITE(1, SO);
    RESC(alA); __syncthreads();
  }
  SBAR(); qkt(pB0, pB1, (bf16_t*)((char*)K_lds + SHM_K), qr, r32, hi);
  finishSM(pA0, pA1, alA, l_reg, pa0, pa1, pa2, pa3); SBAR();
  pv_d0(o, vb0, pa0, pa1, pa2, pa3); partialSM(pB0, pB1, m_reg, mnB, alB);
  __syncthreads(); RESC(alB);
  finishSM(pB0, pB1, alB, l_reg, pa0, pa1, pa2, pa3); SBAR();
  pv_d0(o, vb0 + (int)SHM_V, pa0, pa1, pa2, pa3);
  if (hi == 0) li_l[r32] = l_reg; asm volatile("s_waitcnt lgkmcnt(0)" ::: "memory");
  float rli[16];
#pragma unroll
  for (int r = 0; r < 16; ++r) rli[r] = __builtin_amdgcn_rcpf(li_l[crow(r, hi)]);
  bf16_t* Ow = Ob + (long)(wid * QBLK) * LDO;
#pragma unroll
  for (int r = 0; r < 16; ++r) { int orow = crow(r, hi);
    for (int d0 = 0; d0 < 4; ++d0) Ow[(long)orow * LDO + d0 * 32 + r32] = f2bf(o[d0][r] * rli[r]); }
#undef LD8
#undef SLOAD
#undef SWRITE
#undef SWAIT
#undef RESC
}
}

struct Frame {
    char* lds;
    const Args* a;
    int tid, lane, wave, G, bx;
    int xl, rk;
};
template <class T> __device__ __forceinline__ T* uni(T* p) {
    const unsigned long long v = (unsigned long long)p;
    const unsigned lo = __builtin_amdgcn_readfirstlane((unsigned)v), hi = __builtin_amdgcn_readfirstlane((unsigned)(v >> 32));
    typedef __attribute__((address_space(1))) T* gptr_t;
    return (T*)(gptr_t)(((unsigned long long)hi << 32) | lo);
}
#define WSB() (uni(F.a->ws))
#define WSP(T, off) ((T*)(WSB() + (off)))
#define INP(i) (uni(F.a->in[i]))

__device__ __forceinline__ float mod_at(const Frame& F, int idx) { const float* mp = WSP(const float, WS_MODP); return mp[idx] + mp[4 * 12288 + idx]; }

__device__ __forceinline__ void build_cs(const Frame& F, int idx0, int idx1, int step) {
    bf16_t* cm = WSP(bf16_t, WS_CMAT);
    for (int idx = idx0; idx < idx1; idx += step) {
        const int mat = idx >> 19, s = (idx >> 8) & 2047, t0 = (idx & 255) * 8;
        float v[8];
#pragma unroll
        for (int e = 0; e < 8; ++e) { const float fr = (float)((s * (t0 + e)) & 2047) * (1.f / 2048.f);
            v[e] = mat ? -__builtin_amdgcn_sinf(fr) : __builtin_amdgcn_cosf(fr); }
        u32x4 w = {cvt_pk_bf16(v[0], v[1]), cvt_pk_bf16(v[2], v[3]), cvt_pk_bf16(v[4], v[5]), cvt_pk_bf16(v[6], v[7])};
        *(u32x4*)(cm + (size_t)s * 4096 + mat * 2048 + t0) = w;
    }
}
__device__ __forceinline__ void build_wimg(const Frame& F, const GemmThread& g, int t0, int t1, int step) {
    const float* w_in = INP(5); const float* w_out = INP(11);
    for (int t = t0; t < t1; t += step) {
        const float* srcp; char* dst; const int kt = t & 31, nt = t >> 5;
        if (nt < 10) { srcp = w_in + (size_t)(kt * 64 + 8 * g.kg) * INW + 512 + nt * 256 + 4 * g.ng; dst = (char*)(WSB() + WS_IMGIN) + (size_t)((nt + 4) * 32 + kt) * 32768; }
        else { srcp = w_out + (size_t)(kt * 64 + 8 * g.kg) * DM + (nt - 10) * 256 + 4 * g.ng; dst = (char*)(WSB() + WS_IMGOUT) + (size_t)((nt - 10) * 32 + kt) * 32768; }
        const size_t ld = nt < 10 ? INW : DM;
        f32x4 rb[8];
#pragma unroll
        for (int k = 0; k < 8; ++k) rb[k] = *(const f32x4*)(srcp + (size_t)k * ld);
#pragma unroll
        for (int j = 0; j < 4; ++j) { u32x4 w;
            w[0] = cvt_pk_bf16(rb[0][j], rb[1][j]); w[1] = cvt_pk_bf16(rb[2][j], rb[3][j]); w[2] = cvt_pk_bf16(rb[4][j], rb[5][j]); w[3] = cvt_pk_bf16(rb[6][j], rb[7][j]);
            *(u32x4*)(dst + g.imgw0 + j * 64) = w; }
    }
}
__device__ __forceinline__ void p0_prologue(const Frame& F) {
    const int tid = F.tid;
    const float* c = INP(1); const float* w_ada = INP(2); const float* b_ada = INP(3); const float* wf = INP(6);
    float* modp = WSP(float, WS_MODP);
    for (int item = F.bx; item < 256; item += F.G) {
        const int half = item & 1, cg = item >> 1;
        float* sc = (float*)F.lds;
        float* red = (float*)(F.lds + 16384);
        __syncthreads();
        for (int i = tid; i < 4096; i += NTHREADS) { const int b = i >> 10, k = i & 1023; const float cv = c[b * DM + half * 1024 + k]; sc[i] = cv / (1.f + __expf(-cv)); }
        __syncthreads();
        const int cq = tid % 24, kg = tid / 24;
        f32x4 am[4]; for (int b = 0; b < 4; ++b) am[b] = (f32x4){0.f, 0.f, 0.f, 0.f};
        if (kg < 21) {
            const float* wp = w_ada + (size_t)(half * 1024) * (NMOD * DM) + cg * 96 + cq * 4;
#pragma unroll 7
            for (int k = kg; k < 1024; k += 21) {
                const f32x4 w = *(const f32x4*)(wp + (size_t)k * (NMOD * DM));
#pragma unroll
                for (int b = 0; b < 4; ++b) am[b] += sc[b * 1024 + k] * w;
            }
#pragma unroll
            for (int b = 0; b < 4; ++b) *(f32x4*)(red + ((kg * 4 + b) * 96 + cq * 4)) = am[b];
        }
        __syncthreads();
        if (tid < 384) { const int b = tid / 96, col = tid % 96; float s = 0.f;
            for (int k2 = 0; k2 < 21; ++k2) s += red[(k2 * 4 + b) * 96 + col];
            if (half == 0) s += b_ada[cg * 96 + col];
            modp[(half * 4 + b) * 12288 + cg * 96 + col] = s; }
    }
    __syncthreads();
    {
        float* tc = (float*)F.lds; float* ts = tc + 128;
        if (tid < 128) { tc[tid] = cospif((float)tid / 64.f); ts[tid] = sinpif((float)tid / 64.f); }
        __syncthreads();
        float* g12 = WSP(float, WS_G12);
        const int lane = tid & 63, l15 = lane & 15, lq = lane >> 4;
        for (int item = F.bx * 8 + F.wave; item < 512; item += F.G * 8) {
            const int gp = item >> 6, g = gp >> 1, part = gp & 1, mt = (item >> 3) & 7, nt = item & 7;
            const float* tb = part ? ts : tc; const float* wp = wf + (size_t)g * 128 * 128 + nt * 16 + l15 + (size_t)(8 * lq) * 128;
            const int cc = mt * 16 + l15;
            f32x4 dacc = {0.f, 0.f, 0.f, 0.f};
            float wv[4][8];
#pragma unroll
            for (int ks = 0; ks < 4; ++ks)
#pragma unroll
                for (int q = 0; q < 8; ++q) wv[ks][q] = wp[(size_t)(ks * 32 + q) * 128];
#pragma unroll
            for (int ks = 0; ks < 4; ++ks) {
                u32x4 th, tl, wh, wl;
#pragma unroll
                for (int q = 0; q < 4; ++q) {
                    const int c2 = ks * 32 + 8 * lq + 2 * q;
                    const float t0 = tb[(cc * c2) & 127], t1 = tb[(cc * (c2 + 1)) & 127];
                    th[q] = cvt_pk_bf16(t0, t1); tl[q] = cvt_pk_bf16(t0 - bflo(th[q]), t1 - bfhi(th[q]));
                    wh[q] = cvt_pk_bf16(wv[ks][2 * q], wv[ks][2 * q + 1]); wl[q] = cvt_pk_bf16(wv[ks][2 * q] - bflo(wh[q]), wv[ks][2 * q + 1] - bfhi(wh[q]));
                }
                const bf16x8 ah = __builtin_bit_cast(bf16x8, th), al = __builtin_bit_cast(bf16x8, tl), bh = __builtin_bit_cast(bf16x8, wh), bl = __builtin_bit_cast(bf16x8, wl);
                dacc = __builtin_amdgcn_mfma_f32_16x16x32_bf16(ah, bh, dacc, 0, 0, 0);
                dacc = __builtin_amdgcn_mfma_f32_16x16x32_bf16(ah, bl, dacc, 0, 0, 0);
                dacc = __builtin_amdgcn_mfma_f32_16x16x32_bf16(al, bh, dacc, 0, 0, 0);
            }
#pragma unroll
            for (int r = 0; r < 4; ++r) g12[((size_t)g * 128 + mt * 16 + 4 * lq + r) * 256 + part * 128 + nt * 16 + l15] = dacc[r] * (1.f / 512.f);
        }
        __syncthreads();
    }
    {
        const GemmThread g = gemm_thread_init();
        if (F.G != 256) { build_cs(F, F.bx * NTHREADS + tid, 2 * 2048 * 256, F.G * NTHREADS); build_wimg(F, g, F.bx, (10 + 8) * 32, F.G); }
        else build_wimg(F, g, F.bx, 10 * 32, F.G);
    }
    {
        f32x2* rp = WSP(f32x2, WS_ROPE);
        for (int idx = F.bx * NTHREADS + tid; idx < 2048 * 64; idx += F.G * NTHREADS) {
            const int s = idx >> 6, p = idx & 63, i = p & 31; const float pos = (float)(p < 32 ? (s >> 6) : (s & 63));
            const float inv = 1.0f / powf(10000.f, (float)(2 * i) / 64.f);
            float sn, cs; sincosf(pos * inv, &sn, &cs);
            rp[idx] = (f32x2){cs, sn};
        }
    }
}

__device__ __forceinline__ void p1_norm(const Frame& F) {
    const int tid = F.tid, lane = F.lane, wave = F.wave;
    const float* x = INP(0); const float* gpm = INP(4); const float* w_in = INP(5);
    bf16_t* h = WSP(bf16_t, WS_H);
    float* av = (float*)F.lds; float* sv = av + DM;
    for (int grp = F.bx; grp < NTOK / 32; grp += F.G) {
        const int row0 = grp * 32, b = row0 / SEQ;
        f32x4 xv[4][8];
#pragma unroll
        for (int rr = 0; rr < 4; ++rr) { const float* xr = x + (size_t)(row0 + wave * 4 + rr) * DM;
#pragma unroll
            for (int i = 0; i < 8; ++i) xv[rr][i] = *(const f32x4*)(xr + i * 256 + lane * 4); }
        __syncthreads();
        for (int k = tid; k < DM; k += NTHREADS) { av[k] = gpm[k] * (1.f + mod_at(F, b * 12288 + DM + k)); sv[k] = mod_at(F, b * 12288 + k); }
        __syncthreads();
#pragma unroll
        for (int rr = 0; rr < 4; ++rr) {
            const int row = row0 + wave * 4 + rr; float ss = 0.f;
#pragma unroll
            for (int i = 0; i < 8; ++i) ss += xv[rr][i][0] * xv[rr][i][0] + xv[rr][i][1] * xv[rr][i][1] + xv[rr][i][2] * xv[rr][i][2] + xv[rr][i][3] * xv[rr][i][3];
            ss = wave_sum(ss); const float rstd = rsqrtf(ss * (1.f / DM) + EPS);
#pragma unroll
            for (int i = 0; i < 8; ++i) { const int k = i * 256 + lane * 4; const f32x4 a4 = *(const f32x4*)(av + k), s4 = *(const f32x4*)(sv + k);
                u32x2 w = {cvt_pk_bf16(xv[rr][i][0] * rstd * a4[0] + s4[0], xv[rr][i][1] * rstd * a4[1] + s4[1]), cvt_pk_bf16(xv[rr][i][2] * rstd * a4[2] + s4[2], xv[rr][i][3] * rstd * a4[3] + s4[3])};
                *(u32x2*)(h + (size_t)row * DM + k) = w; }
        }
    }
    const float* g12 = WSP(const float, WS_G12);
    for (int item = F.bx * 8 + wave; item < 2048; item += F.G * 8) {
        const int ntile = item & 63, mgrp = item >> 6, l15 = lane & 15, lq = lane >> 4;
        const int n = ntile * 16 + l15, half = n >> 9, g = (n >> 7) & 3, j = n & 127;
        const float* gp = g12 + (size_t)g * 128 * 256 + half * 128 + j + (size_t)(8 * lq) * 256;
        bf16x8 yh[4], yl[4];
#pragma unroll
        for (int ks = 0; ks < 4; ++ks) {
            float v[8];
#pragma unroll
            for (int q = 0; q < 8; ++q) v[q] = gp[(size_t)(ks * 32 + q) * 256];
            u32x4 h, l;
#pragma unroll
            for (int q = 0; q < 4; ++q) { h[q] = cvt_pk_bf16(v[2 * q], v[2 * q + 1]); l[q] = cvt_pk_bf16(v[2 * q] - bflo(h[q]), v[2 * q + 1] - bfhi(h[q])); }
            yh[ks] = __builtin_bit_cast(bf16x8, h); yl[ks] = __builtin_bit_cast(bf16x8, l);
        }
        f32x4 xva[4][4][2];
#pragma unroll
        for (int mi = 0; mi < 4; ++mi) { const float* wp = w_in + (size_t)((mgrp * 4 + mi) * 16 + l15) * INW + g * 128 + 8 * lq;
#pragma unroll
            for (int ks = 0; ks < 4; ++ks) { xva[mi][ks][0] = *(const f32x4*)(wp + ks * 32); xva[mi][ks][1] = *(const f32x4*)(wp + ks * 32 + 4); } }
#pragma unroll
        for (int mi = 0; mi < 4; ++mi) {
            const int m0 = (mgrp * 4 + mi) * 16;
            f32x4 (&xv)[4][2] = xva[mi];
            f32x4 d = {0.f, 0.f, 0.f, 0.f};
#pragma unroll
            for (int ks = 0; ks < 4; ++ks) {
                u32x4 h, l;
#pragma unroll
                for (int q = 0; q < 2; ++q) {
                    h[2 * q] = cvt_pk_bf16(xv[ks][q][0], xv[ks][q][1]); h[2 * q + 1] = cvt_pk_bf16(xv[ks][q][2], xv[ks][q][3]);
                    l[2 * q] = cvt_pk_bf16(xv[ks][q][0] - bflo(h[2 * q]), xv[ks][q][1] - bfhi(h[2 * q])); l[2 * q + 1] = cvt_pk_bf16(xv[ks][q][2] - bflo(h[2 * q + 1]), xv[ks][q][3] - bfhi(h[2 * q + 1]));
                }
                const bf16x8 xh = __builtin_bit_cast(bf16x8, h), xl = __builtin_bit_cast(bf16x8, l);
                d = __builtin_amdgcn_mfma_f32_16x16x32_bf16(xh, yh[ks], d, 0, 0, 0);
                d = __builtin_amdgcn_mfma_f32_16x16x32_bf16(xh, yl[ks], d, 0, 0, 0);
                d = __builtin_amdgcn_mfma_f32_16x16x32_bf16(xl, yh[ks], d, 0, 0, 0);
            }
            const int k = m0 + 4 * lq, nt = n >> 8, brow = n & 255, kt = k >> 6, chunk = (k & 63) >> 3;
            u32x2 w = {cvt_pk_bf16(d[0], d[1]), cvt_pk_bf16(d[2], d[3])};
            *(u32x2*)((char*)(WSB() + WS_IMGIN) + (size_t)(nt * 32 + kt) * 32768 + (chunk >> 2) * 16384 + brow * 64 + ((((brow >> 2) & 3) ^ sw4(chunk & 3)) << 4) + (k & 4) * 2) = w;
        }
    }
}

__device__ __forceinline__ void p2_inproj(const Frame& F) {
    const GemmThread g = gemm_thread_init();
    const bf16_t* h = WSP(const bf16_t, WS_H);
    const float* qg = INP(7); const float* kgn = INP(8);
    const f32x2* rope = WSP(const f32x2, WS_ROPE);
    const int vcu = (F.G & 7) ? F.bx : F.xl * (F.G >> 3) + F.rk;
    for (int u = vcu; u < 512; u += F.G) {
        int mt, nt;
        if (!patch_unit(u, 32, 14, mt, nt)) {
            if (F.G == 256) { const int idle = ((u >> 5) - 12) * 16 + ((u & 31) - 16);
                int to = F.tid; asm volatile("" : "+v"(to));
                build_cs(F, idle * 16384 + to, (idle + 1) * 16384, NTHREADS);
                const GemmThread g2 = gemm_thread_init<true>();
                build_wimg(F, g2, 10 * 32 + idle * 4, 10 * 32 + idle * 4 + 4, 1); }
            continue; }
        f32x4 acc[4][8]; acc_zero(acc);
        unsigned aoff[2];
#pragma unroll
        for (int i = 0; i < 2; ++i) aoff[i] = (unsigned)(g.rrow0 + 16 * i) * (DM * 2u) + g.rchunk;
        const char* ab = (const char*)(h + (size_t)mt * 256 * DM);
        gemm_accum_ring(acc, F.lds, g, F.wave, F.lane, ab, aoff, (const char*)(WSB() + WS_IMGIN) + (size_t)(nt * 32) * 32768, DM / 64);
        const EpiLane el = epi_lane(g);
        if (nt < 4) {
            char* img = (char*)(WSB() + WS_IMGZ) + (size_t)((((mt >> 3) * 2 + (nt & 1)) * 64) + (nt >> 1) * 32 + (mt & 7) * 4 + el.wm) * 32768;
            char* tw = F.lds + F.wave * 16384;
#pragma unroll
            for (int i = 0; i < 4; ++i)
#pragma unroll
                for (int j = 0; j < 8; ++j)
#pragma unroll
                    for (int r = 0; r < 4; ++r) *(bf16_t*)(tw + (16 * j + 4 * el.lq + r) * 128 + (16 * i + el.l15) * 2) = f2bf(acc[i][j][r]);
            int ln = F.lane; asm volatile("" : "+v"(ln));
#pragma unroll
            for (int q = 0; q < 16; ++q) { const int idx = q * 64 + ln, nl = idx >> 3, chunk = idx & 7, n = 128 * el.wn + nl;
                const u32x4 v = *(const u32x4*)(tw + nl * 128 + chunk * 16);
                *(u32x4*)(img + (chunk >> 2) * 16384 + n * 64 + ((((n >> 2) & 3) ^ sw4(chunk & 3)) << 4)) = v; }
            __syncthreads();
        } else if (nt < 12) {
            const bool isq = nt < 10;
            const int head = isq ? (nt - 4) * 2 + el.wn : (nt - 10) * 2 + el.wn;
            const float* gn = isq ? qg : kgn;
            bf16_t* dstb = isq ? WSP(bf16_t, WS_Q) : WSP(bf16_t, WS_K); const int ldo = isq ? AW : KVW;
            char* twq = stg_base(F);
            float rstd[4];
#pragma unroll
            for (int i = 0; i < 4; ++i) {
                float ss = 0.f;
#pragma unroll
                for (int j = 0; j < 8; ++j) ss += acc[i][j][0] * acc[i][j][0] + acc[i][j][1] * acc[i][j][1] + acc[i][j][2] * acc[i][j][2] + acc[i][j][3] * acc[i][j][3];
                ss += __shfl_xor(ss, 16, 64); ss += __shfl_xor(ss, 32, 64);
                rstd[i] = rsqrtf(ss * (1.f / 128.f) + EPS);
            }
#pragma unroll
            for (int jb = 0; jb < 8; jb += 2) {
                f32x4 gvv[2], csv[2][4];
#pragma unroll
                for (int jj = 0; jj < 2; ++jj) { const int d = 16 * (jb + jj) + 4 * el.lq;
                    gvv[jj] = *(const f32x4*)(gn + d);
#pragma unroll
                    for (int i = 0; i < 4; ++i) { const int t = mt * 256 + 64 * el.wm + 16 * i + el.l15, sq = t & (SEQ - 1);
                        csv[jj][i] = *(const f32x4*)(rope + (size_t)sq * 64 + (d >> 1)); } }
#pragma unroll
                for (int jj = 0; jj < 2; ++jj) { const int j = jb + jj, d = 16 * j + 4 * el.lq;
                    const f32x4 gv = gvv[jj];
#pragma unroll
                    for (int i = 0; i < 4; ++i) {
                        const int t = mt * 256 + 64 * el.wm + 16 * i + el.l15; const f32x4 cs = csv[jj][i];
                        const float x0 = acc[i][j][0] * rstd[i] * gv[0], x1 = acc[i][j][1] * rstd[i] * gv[1];
                        const float x2 = acc[i][j][2] * rstd[i] * gv[2], x3 = acc[i][j][3] * rstd[i] * gv[3];
                        u32x2 w = {cvt_pk_bf16(x0 * cs[0] - x1 * cs[1], x0 * cs[1] + x1 * cs[0]), cvt_pk_bf16(x2 * cs[2] - x3 * cs[3], x2 * cs[3] + x3 * cs[2])};
                        stg_put(twq, el, i, j, w);
                    }
                }
            }
            stg_flush(F, twq, dstb + (size_t)(mt * 256 + 64 * el.wm) * ldo + head * 128, ldo);
        } else {
            bf16_t* vb = WSP(bf16_t, WS_V);
            char* tw = stg_base(F);
#pragma unroll
            for (int i = 0; i < 4; ++i)
#pragma unroll
                for (int j = 0; j < 8; ++j) stg_put(tw, el, i, j, (u32x2){cvt_pk_bf16(acc[i][j][0], acc[i][j][1]), cvt_pk_bf16(acc[i][j][2], acc[i][j][3])});
            stg_flush(F, tw, vb + (size_t)(mt * 256 + 64 * el.wm) * KVW + (nt - 12) * 256 + 128 * el.wn, KVW);
        }
    }
}

__device__ __forceinline__ void p3_dft_unit(const Frame& F, const GemmThread& g, int du) {
    const int mt = du & 7, nt = du >> 3, b = nt >> 1, g0 = (nt & 1) * 2;
    const bf16_t* cs = WSP(const bf16_t, WS_CMAT);
    f32x4 acc[4][8]; acc_zero(acc);
    unsigned aoff[2];
#pragma unroll
    for (int i = 0; i < 2; ++i) aoff[i] = (unsigned)(g.rrow0 + 16 * i) * 8192u + g.rchunk;
    gemm_accum_ring(acc, F.lds, g, F.wave, F.lane, (const char*)(cs + (size_t)mt * 256 * 4096), aoff, (const char*)(WSB() + WS_IMGZ) + (size_t)(nt * 64) * 32768, 64);
    bf16_t* mrg = WSP(bf16_t, WS_MRG);
    const EpiLane el = epi_lane(g);
    char* tw = stg_base(F);
#pragma unroll
    for (int i = 0; i < 4; ++i)
#pragma unroll
        for (int j = 0; j < 8; ++j) stg_put(tw, el, i, j, (u32x2){cvt_pk_bf16(acc[i][j][0], acc[i][j][1]), cvt_pk_bf16(acc[i][j][2], acc[i][j][3])});
    stg_flush(F, tw, mrg + (size_t)(b * SEQ + mt * 256 + 64 * el.wm) * DM + g0 * 128 + 128 * el.wn, DM);
}
__device__ __forceinline__ void p3_attn_unit(const Frame& F, int kvh  , int sub  ) {
    const int b = kvh >> 2, kv = kvh & 3, hq = kv * 3 + sub / 8, qb = sub % 8;
    const bf16_t* q = WSP(const bf16_t, WS_Q) + (size_t)(b * SEQ + qb * 256) * AW + hq * 128;
    const bf16_t* k = WSP(const bf16_t, WS_K) + (size_t)(b * SEQ) * KVW + kv * 128;
    const bf16_t* v = WSP(const bf16_t, WS_V) + (size_t)(b * SEQ) * KVW + kv * 128;
    bf16_t* o = WSP(bf16_t, WS_MRG) + (size_t)(b * SEQ + qb * 256) * DM + FW + hq * 128;
    attn::attn_dense_body(q, k, v, o, SEQ, F.lds);
}
__device__ __forceinline__ void p3_mixers(const Frame& F) {
    const GemmThread g = gemm_thread_init();
    const bool std = (F.G == 256); const int xl = F.xl, r = F.rk;
    int na, a0, astep, nd, d0, dstep;
    if (std) { na = (r < 24) ? 2 : 0; a0 = xl * 24 + r; astep = 8 * 24; nd = (r < 24) ? 0 : 1; d0 = xl * 8 + (r - 24); dstep = 1; }
    else { na = (384 - F.bx + F.G - 1) / F.G; if (F.bx >= 384) na = 0; a0 = F.bx; astep = F.G; nd = (64 - F.bx + F.G - 1) / F.G; if (F.bx >= 64) nd = 0; d0 = F.bx; dstep = F.G; }
#if (P3_MASK & 1)
    for (int it = 0; it < na; ++it) { const int u = a0 + it * astep; __syncthreads(); p3_attn_unit(F, u / 24, u % 24); }
#endif
#if (P3_MASK & 2)
    for (int it = 0; it < nd; ++it) { __syncthreads(); p3_dft_unit(F, g, d0 + it * dstep); }
#endif
}

__device__ __forceinline__ void p4_merge_norm(const Frame& F) {
    const float* gf = INP(9); const float* ga = INP(10);
    bf16_t* mrg = WSP(bf16_t, WS_MRG);
    for (int base = F.bx * 8 + F.wave; base < NTOK; base += 4 * F.G * 8) {
        u32x4 v[4][4];
#pragma unroll
        for (int q = 0; q < 4; ++q) { const int row = base + q * F.G * 8;
            if (row < NTOK) {
#pragma unroll
                for (int i = 0; i < 4; ++i) v[q][i] = *(const u32x4*)(mrg + (size_t)row * DM + (i * 64 + F.lane) * 8); } }
#pragma unroll
        for (int q = 0; q < 4; ++q) { const int row = base + q * F.G * 8;
            if (row < NTOK) {
                bf16_t* rp = mrg + (size_t)row * DM;
                float ssf = 0.f, ssa = 0.f;
#pragma unroll
                for (int i = 0; i < 4; ++i) { float s2 = 0.f;
#pragma unroll
                    for (int e = 0; e < 4; ++e) { const float a = bflo(v[q][i][e]), b2 = bfhi(v[q][i][e]); s2 += a * a + b2 * b2; }
                    if (i == 0) ssf = s2; else ssa += s2; }
                ssf = wave_sum(ssf); ssa = wave_sum(ssa);
                const float rf = rsqrtf(ssf * (1.f / FW) + EPS), ra = rsqrtf(ssa * (1.f / AW) + EPS);
#pragma unroll
                for (int i = 0; i < 4; ++i) { const int k = (i * 64 + F.lane) * 8; const float rs = (i == 0) ? rf : ra; const float* gp = (i == 0) ? (gf + k) : (ga + (k - FW));
                    const f32x4 g0 = *(const f32x4*)gp, g1 = *(const f32x4*)(gp + 4);
                    u32x4 w;
                    w[0] = cvt_pk_bf16(bflo(v[q][i][0]) * rs * g0[0], bfhi(v[q][i][0]) * rs * g0[1]); w[1] = cvt_pk_bf16(bflo(v[q][i][1]) * rs * g0[2], bfhi(v[q][i][1]) * rs * g0[3]);
                    w[2] = cvt_pk_bf16(bflo(v[q][i][2]) * rs * g1[0], bfhi(v[q][i][2]) * rs * g1[1]); w[3] = cvt_pk_bf16(bflo(v[q][i][3]) * rs * g1[2], bfhi(v[q][i][3]) * rs * g1[3]);
                    *(u32x4*)(rp + k) = w; }
            } }
    }
}

__device__ __forceinline__ void p5_outproj(const Frame& F) {
    const GemmThread g = gemm_thread_init();
    const bf16_t* mrg = WSP(const bf16_t, WS_MRG); bf16_t* mix = WSP(bf16_t, WS_MIX);
    const int vcu = (F.G & 7) ? F.bx : F.xl * (F.G >> 3) + F.rk;
    for (int u = vcu; u < 256; u += F.G) {
        int mt, nt; if (!patch_unit(u, 32, 8, mt, nt)) continue;
        f32x4 acc[4][8]; acc_zero(acc);
        unsigned aoff[2];
#pragma unroll
        for (int i = 0; i < 2; ++i) aoff[i] = (unsigned)(g.rrow0 + 16 * i) * (DM * 2u) + g.rchunk;
        gemm_accum_ring(acc, F.lds, g, F.wave, F.lane, (const char*)(mrg + (size_t)mt * 256 * DM), aoff, (const char*)(WSB() + WS_IMGOUT) + (size_t)(nt * 32) * 32768, DM / 64);
        const EpiLane el = epi_lane(g);
        char* tw = stg_base(F);
#pragma unroll
        for (int i = 0; i < 4; ++i)
#pragma unroll
            for (int j = 0; j < 8; ++j) stg_put(tw, el, i, j, (u32x2){cvt_pk_bf16(acc[i][j][0], acc[i][j][1]), cvt_pk_bf16(acc[i][j][2], acc[i][j][3])});
        stg_flush(F, tw, mix + (size_t)(mt * 256 + 64 * el.wm) * DM + nt * 256 + 128 * el.wn, DM);
    }
}

__device__ __forceinline__ void p6_postmix(const Frame& F) {
    const int tid = F.tid, lane = F.lane, wave = F.wave;
    const float* x = INP(0); const float* gpost = INP(12); const float* gpre = INP(13);
    const float* w_router = INP(14); const float* b_router = INP(15);
    const bf16_t* mix = WSP(const bf16_t, WS_MIX); float* x1b = WSP(float, WS_X1); unsigned char* h2b = WSP(unsigned char, WS_H2);
    int* list = WSP(int, WS_LIST); float* gatev = WSP(float, WS_GATEV); unsigned* cnt = (unsigned*)(WSB() + WS_CTL + CTL_CNT_OFF);
    float* gm = (float*)F.lds; float* af = gm + DM; float* sf = af + DM;
    constexpr int RP = 528;
    char* HAh = F.lds + 24576; char* HAl = HAh + 32 * RP; char* WBh = HAl + 32 * RP; char* WBl = WBh + 32 * RP;
    float* RED = (float*)(WBl + 32 * RP);
    float* LOG = RED + 8 * 32 * 32;
    int* s_cnt = (int*)(LOG + 32 * 32); int* s_base = s_cnt + 32; int* s_e = s_base + 32; int* s_lr = s_e + 128;
    for (int grp = F.bx; grp < NTOK / 32; grp += F.G) {
        const int row0 = grp * 32, b = row0 / SEQ;
        __syncthreads();
        for (int k = tid; k < DM; k += NTHREADS) {
            gm[k] = mod_at(F, b * 12288 + 2 * DM + k) * gpost[k];
            af[k] = gpre[k] * (1.f + mod_at(F, b * 12288 + 4 * DM + k));
            sf[k] = mod_at(F, b * 12288 + 3 * DM + k); }
        if (tid < 32) s_cnt[tid] = 0;
        __syncthreads();
        const unsigned lo16 = (unsigned)lane * 16u, lo8 = (unsigned)lane * 8u;
        float r2v[4];
#pragma unroll
        for (int rr = 0; rr < 4; ++rr) r2v[rr] = 0.f;
#pragma unroll 1
        for (int rr = 0; rr < 4; ++rr) {
            const int row = row0 + wave * 4 + rr;
            float ss = 0.f; f32x4 mv[8];
#pragma unroll
            for (int i = 0; i < 8; ++i) { const u32x2 m2 = *(const u32x2*)((const char*)(mix + (size_t)row * DM + i * 256) + lo8);
                mv[i] = (f32x4){bflo(m2[0]), bfhi(m2[0]), bflo(m2[1]), bfhi(m2[1])};
                ss += mv[i][0] * mv[i][0] + mv[i][1] * mv[i][1] + mv[i][2] * mv[i][2] + mv[i][3] * mv[i][3]; }
            ss = wave_sum(ss); const float r1 = rsqrtf(ss * (1.f / DM) + EPS);
            float s2 = 0.f;
            f32x4 xrow[8];
#pragma unroll
            for (int i = 0; i < 8; ++i) xrow[i] = *(const f32x4*)((const char*)(x + (size_t)row * DM + i * 256) + lo16);
#pragma unroll
            for (int i = 0; i < 8; ++i) { const int k = i * 256 + lane * 4; const f32x4 xv = xrow[i]; const f32x4 g4 = *(const f32x4*)(gm + k);
                f32x4 v1; for (int e = 0; e < 4; ++e) v1[e] = xv[e] + g4[e] * (mv[i][e] * r1);
                *(f32x4*)((char*)(x1b + (size_t)row * DM + i * 256) + lo16) = v1; mv[i] = v1;
#if DEBUG_X1
                *(f32x4*)((char*)(uni(F.a->out) + (size_t)row * DM + i * 256) + lo16) = v1;
#endif
                s2 += v1[0] * v1[0] + v1[1] * v1[1] + v1[2] * v1[2] + v1[3] * v1[3]; }
            s2 = wave_sum(s2); const float r2 = rsqrtf(s2 * (1.f / DM) + EPS);
            r2v[0] = rr == 0 ? r2 : r2v[0]; r2v[1] = rr == 1 ? r2 : r2v[1]; r2v[2] = rr == 2 ? r2 : r2v[2]; r2v[3] = rr == 3 ? r2 : r2v[3];
#pragma unroll
            for (int i = 0; i < 8; ++i) { const int k = i * 256 + lane * 4; const f32x4 a4 = *(const f32x4*)(af + k), s4 = *(const f32x4*)(sf + k);
                float h0 = (mv[i][0] * r2 * a4[0] + s4[0]) * FP8_SA, h1 = (mv[i][1] * r2 * a4[1] + s4[1]) * FP8_SA, h2_ = (mv[i][2] * r2 * a4[2] + s4[2]) * FP8_SA, h3 = (mv[i][3] * r2 * a4[3] + s4[3]) * FP8_SA;
                h0 = fminf(fmaxf(h0, -448.f), 448.f); h1 = fminf(fmaxf(h1, -448.f), 448.f); h2_ = fminf(fmaxf(h2_, -448.f), 448.f); h3 = fminf(fmaxf(h3, -448.f), 448.f);
                *(unsigned*)(h2b + (size_t)row * DM + i * 256 + lane * 4) = cvt4_fp8(h0, h1, h2_, h3); }
        }
        f32x4 racc[2][2];
#pragma unroll
        for (int m = 0; m < 2; ++m)
#pragma unroll
            for (int n = 0; n < 2; ++n) racc[m][n] = (f32x4){0.f, 0.f, 0.f, 0.f};
        const int l15 = lane & 15, lq = lane >> 4;
#pragma unroll 1
        for (int i = 0; i < 8; ++i) {
            __syncthreads();
            {
                const int k = i * 256 + lane * 4; const f32x4 a4 = *(const f32x4*)(af + k), s4 = *(const f32x4*)(sf + k);
#pragma unroll
                for (int rr = 0; rr < 4; ++rr) {
                    const f32x4 xv = *(const f32x4*)((const char*)(x1b + (size_t)(row0 + wave * 4 + rr) * DM + i * 256) + lo16);
                    const float r2 = rr == 0 ? r2v[0] : rr == 1 ? r2v[1] : rr == 2 ? r2v[2] : r2v[3];
                    float h0 = xv[0] * r2 * a4[0] + s4[0], h1 = xv[1] * r2 * a4[1] + s4[1], h2_ = xv[2] * r2 * a4[2] + s4[2], h3 = xv[3] * r2 * a4[3] + s4[3];
                    const unsigned p0 = cvt_pk_bf16(h0, h1), p1 = cvt_pk_bf16(h2_, h3);
                    const unsigned q0 = cvt_pk_bf16(h0 - bflo(p0), h1 - bfhi(p0)), q1 = cvt_pk_bf16(h2_ - bflo(p1), h3 - bfhi(p1));
                    const int off = (wave * 4 + rr) * RP + lane * 8;
                    *(u32x2*)(HAh + off) = (u32x2){p0, p1}; *(u32x2*)(HAl + off) = (u32x2){q0, q1};
                }
            }
            {
                const int k4 = tid & 63, e4 = tid >> 6;
                f32x4 wv[4];
#pragma unroll
                for (int kk = 0; kk < 4; ++kk) wv[kk] = *(const f32x4*)(w_router + (size_t)(i * 256 + 4 * k4 + kk) * NEXP + 4 * e4);
#pragma unroll
                for (int j = 0; j < 4; ++j) {
                    const unsigned p0 = cvt_pk_bf16(wv[0][j], wv[1][j]), p1 = cvt_pk_bf16(wv[2][j], wv[3][j]);
                    const unsigned q0 = cvt_pk_bf16(wv[0][j] - bflo(p0), wv[1][j] - bfhi(p0)), q1 = cvt_pk_bf16(wv[2][j] - bflo(p1), wv[3][j] - bfhi(p1));
                    const int off = (4 * e4 + j) * RP + k4 * 8;
                    *(u32x2*)(WBh + off) = (u32x2){p0, p1}; *(u32x2*)(WBl + off) = (u32x2){q0, q1};
                }
            }
            __syncthreads();
            bf16x8 ah[2], al[2], bh[2], bl[2];
            const int fo = l15 * RP + wave * 64 + lq * 16;
#pragma unroll
            for (int m = 0; m < 2; ++m) { ah[m] = *(const bf16x8*)(HAh + fo + m * 16 * RP); al[m] = *(const bf16x8*)(HAl + fo + m * 16 * RP);
                                          bh[m] = *(const bf16x8*)(WBh + fo + m * 16 * RP); bl[m] = *(const bf16x8*)(WBl + fo + m * 16 * RP); }
#pragma unroll
            for (int m = 0; m < 2; ++m)
#pragma unroll
                for (int n = 0; n < 2; ++n) {
                    racc[m][n] = __builtin_amdgcn_mfma_f32_16x16x32_bf16(ah[m], bh[n], racc[m][n], 0, 0, 0);
                    racc[m][n] = __builtin_amdgcn_mfma_f32_16x16x32_bf16(ah[m], bl[n], racc[m][n], 0, 0, 0);
                    racc[m][n] = __builtin_amdgcn_mfma_f32_16x16x32_bf16(al[m], bh[n], racc[m][n], 0, 0, 0);
                }
        }
#pragma unroll
        for (int m = 0; m < 2; ++m)
#pragma unroll
            for (int n = 0; n < 2; ++n)
#pragma unroll
                for (int r = 0; r < 4; ++r) RED[(wave * 32 + 16 * m + 4 * lq + r) * 32 + 16 * n + l15] = racc[m][n][r];
        __syncthreads();
        { const int tk = tid >> 4, e2 = (tid & 15) * 2; float s0 = b_router[e2], s1 = b_router[e2 + 1];
#pragma unroll
            for (int w = 0; w < 8; ++w) { s0 += RED[(w * 32 + tk) * 32 + e2]; s1 += RED[(w * 32 + tk) * 32 + e2 + 1]; }
            LOG[tk * 32 + e2] = s0; LOG[tk * 32 + e2 + 1] = s1; }
        __syncthreads();
#pragma unroll 1
        for (int rr = 0; rr < 4; ++rr) {
            float val = LOG[(wave * 4 + rr) * 32 + (lane & 31)];
            float tv[4]; int te[4];
#pragma unroll
            for (int kk = 0; kk < 4; ++kk) {
                float m = val;
#pragma unroll
                for (int o = 16; o >= 1; o >>= 1) m = fmaxf(m, __shfl_xor(m, o, 64));
                const unsigned long long bal = __ballot(val == m);
                const int e = __ffsll((long long)bal) - 1;
                tv[kk] = m; te[kk] = e & 31; if ((lane & 31) == (e & 31)) val = -INFINITY;
            }
            const float p1 = __expf(tv[1] - tv[0]), p2 = __expf(tv[2] - tv[0]), p3 = __expf(tv[3] - tv[0]); const float inv = 1.f / (1.f + p1 + p2 + p3);
            if (lane < 4) {
                const int e = lane == 0 ? te[0] : lane == 1 ? te[1] : lane == 2 ? te[2] : te[3];
                const float gt = (lane == 0 ? 1.f : lane == 1 ? p1 : lane == 2 ? p2 : p3) * inv;
                const int al = (wave * 4 + rr) * 4 + lane;
                s_e[al] = e; s_lr[al] = atomicAdd(&s_cnt[e], 1);
                gatev[row0 * 4 + al] = gt;
            }
        }
        __syncthreads();
        if (tid < 32) { int t2 = tid; asm volatile("" : "+v"(t2));
            s_base[tid] = (int)__hip_atomic_fetch_add(&cnt[t2], (unsigned)s_cnt[tid], __ATOMIC_RELAXED, __HIP_MEMORY_SCOPE_AGENT); }
        __syncthreads();
        if (tid < 128) { const int e = s_e[tid]; list[e * 8192 + s_base[e] + s_lr[tid]] = row0 * 4 + tid; }
    }
}

struct MoeTab { int* tiles; int* rowbase; int* cnt; int* pt; };
__device__ __forceinline__ MoeTab moe_tab(const Frame& F) {
    MoeTab t; t.tiles = (int*)(F.lds + LDS_MISC + 64); t.rowbase = t.tiles + 32; t.cnt = t.rowbase + 32; t.pt = t.cnt + 32;
    unsigned* cnt = (unsigned*)(WSB() + WS_CTL + CTL_CNT_OFF);
    __syncthreads();
    if (F.tid < 32) { const int n = (int)__hip_atomic_load(&cnt[F.tid], __ATOMIC_RELAXED, __HIP_MEMORY_SCOPE_AGENT); t.cnt[F.tid] = n; t.tiles[F.tid] = (n + 255) >> 8; }
    __syncthreads();
    if (F.tid == 0) { int s = 0, p = 0; for (int e = 0; e < 32; ++e) { t.rowbase[e] = s; s += t.tiles[e] * 256; t.pt[e] = p; p += t.tiles[e] > 2 ? t.tiles[e] - 2 : 0; } t.pt[32] = p; }
    __syncthreads();
    return t;
}
__device__ __forceinline__ void moe_tile_of(const MoeTab& t, int tix, int& e, int& mt) {
    int ee = 0;
#pragma unroll 1
    for (int k = 1; k < 32; ++k) ee = (tix >= t.pt[k]) ? k : ee;
    e = ee; mt = 2 + tix - t.pt[ee];
}

__device__ __forceinline__ void moe_up_epilogue(const Frame& F, const GemmThread& g, const f32x4 (&acc)[4][8], int e, int mt, int nt, int ne, int rowb) {
    const float* b_gate = INP(17); const float* b_up = INP(19); unsigned char* act = WSP(unsigned char, WS_ACT);
    const EpiLane el = epi_lane(g);
    char* tw = F.lds + F.wave * 4096;
    f32x4 bg[4], bu[4];
#pragma unroll
    for (int j = 0; j < 4; ++j) { const int col = nt * 128 + 64 * el.wn + 16 * j + 4 * el.lq;
        bg[j] = *(const f32x4*)(b_gate + (size_t)e * DM + col); bu[j] = *(const f32x4*)(b_up + (size_t)e * DM + col); }
#pragma unroll
    for (int j = 0; j < 4; ++j) {
        const int col = nt * 128 + 64 * el.wn + 16 * j + 4 * el.lq;
#pragma unroll
        for (int i = 0; i < 4; ++i) {
            const int ml = 64 * el.wm + 16 * i + el.l15;
            float o[4];
#pragma unroll
            for (int q = 0; q < 4; ++q) { float gg = acc[i][j][q] * (1.f / (FP8_SA * FP8_SW)) + bg[j][q], uu = acc[i][j + 4][q] * (1.f / (FP8_SA * FP8_SW)) + bu[j][q];
                gg = fminf(gg, 7.f); uu = fminf(fmaxf(uu, -7.f), 7.f);
                o[q] = (uu + 1.f) * gg * __builtin_amdgcn_rcpf(1.f + __expf(-1.702f * gg)); }
            *(unsigned*)(tw + (16 * i + el.l15) * 64 + 16 * j + 4 * el.lq) = cvt4_fp8(o[0] * FP8_SACT, o[1] * FP8_SACT, o[2] * FP8_SACT, o[3] * FP8_SACT);
        }
    }
    { int ln = F.lane; asm volatile("" : "+v"(ln));
      char* dst = (char*)act + ((size_t)(rowb >> 8) * 32 + nt * 2 + el.wn) * 16384 + (64 * el.wm) * 64;
#pragma unroll
      for (int q = 0; q < 4; ++q) *(u32x4*)(dst + q * 1024 + ln * 16) = *(const u32x4*)(tw + q * 1024 + ln * 16); }
    __syncthreads();
}
__device__ __forceinline__ void moe_dn_epilogue(const Frame& F, const GemmThread& g, const f32x4 (&acc)[4][8], int e, int mt, int nt, int ne) {
    const float* b_down = INP(21); const int* list = WSP(const int, WS_LIST); const float* gatev = WSP(const float, WS_GATEV); bf16_t* outb = WSP(bf16_t, WS_OUTB);
    const EpiLane el = epi_lane(g);
    constexpr float RS = 1.f / (FP8_SACT * FP8_SW);
    int av[4]; float gtv[4]; f32x4 bd[8];
#pragma unroll
    for (int i = 0; i < 4; ++i) { int rk = mt * 256 + 64 * el.wm + 16 * i + el.l15; rk = rk < ne ? rk : ne - 1; av[i] = list[e * 8192 + rk]; }
#pragma unroll
    for (int j = 0; j < 8; ++j) bd[j] = *(const f32x4*)(b_down + (size_t)e * DM + nt * 256 + 128 * el.wn + 16 * j + 4 * el.lq);
#pragma unroll
    for (int i = 0; i < 4; ++i) gtv[i] = gatev[av[i]];
    char* tw = F.lds + F.wave * 8704;
    int ln = F.lane; asm volatile("" : "+v"(ln));
#pragma unroll
    for (int hf = 0; hf < 2; ++hf) {
#pragma unroll
        for (int ii = 0; ii < 2; ++ii) { const int i = 2 * hf + ii; const float gt = gtv[i];
#pragma unroll
            for (int j = 0; j < 8; ++j) {
                u32x2 w = {cvt_pk_bf16((acc[i][j][0] * RS + bd[j][0]) * gt, (acc[i][j][1] * RS + bd[j][1]) * gt), cvt_pk_bf16((acc[i][j][2] * RS + bd[j][2]) * gt, (acc[i][j][3] * RS + bd[j][3]) * gt)};
                *(u32x2*)(tw + (16 * ii + el.l15) * 272 + (16 * j + 4 * el.lq) * 2) = w; } }
#pragma unroll
        for (int q = 0; q < 8; ++q) {
            const int rl = q * 4 + (ln >> 4), chunk = ln & 15;
            const int a = __shfl(av[2 * hf + (q >> 2)], rl & 15, 64);
            const u32x4 v = *(const u32x4*)(tw + rl * 272 + chunk * 16);
            if (mt * 256 + 64 * el.wm + 32 * hf + rl < ne) *(u32x4*)(outb + (size_t)a * DM + nt * 256 + 128 * el.wn + chunk * 8) = v;
        }
    }
    __syncthreads();
}
__device__ __forceinline__ void moe_up_epilogue32(const Frame& F, const GemmThread& g, const f32x16 (&acc)[2][4], int e, int mt, int nt, int ne, int rowb) {
    const float* b_gate = INP(17); const float* b_up = INP(19); unsigned char* act = WSP(unsigned char, WS_ACT);
    int l31 = F.lane & 31, lh = F.lane >> 5; asm volatile("" : "+v"(l31), "+v"(lh));
    char* tw = F.lds + F.wave * 4096;
    f32x4 bg[2][4], bu[2][4];
#pragma unroll
    for (int j = 0; j < 2; ++j)
#pragma unroll
        for (int q4 = 0; q4 < 4; ++q4) { const int col = nt * 128 + 64 * g.wn + 32 * j + 8 * q4 + 4 * lh;
            bg[j][q4] = *(const f32x4*)(b_gate + (size_t)e * DM + col); bu[j][q4] = *(const f32x4*)(b_up + (size_t)e * DM + col); }
#pragma unroll
    for (int j = 0; j < 2; ++j)
#pragma unroll
        for (int q4 = 0; q4 < 4; ++q4) {
            const int col = nt * 128 + 64 * g.wn + 32 * j + 8 * q4 + 4 * lh;
#pragma unroll
            for (int i = 0; i < 2; ++i) {
                const int ml = 64 * g.wm + 32 * i + l31;
                float o[4];
#pragma unroll
                for (int q = 0; q < 4; ++q) { float gg = acc[i][j][4 * q4 + q] * (1.f / (FP8_SA * FP8_SW)) + bg[j][q4][q], uu = acc[i][j + 2][4 * q4 + q] * (1.f / (FP8_SA * FP8_SW)) + bu[j][q4][q];
                    gg = fminf(gg, 7.f); uu = fminf(fmaxf(uu, -7.f), 7.f);
                    o[q] = (uu + 1.f) * gg * __builtin_amdgcn_rcpf(1.f + __expf(-1.702f * gg)); }
                *(unsigned*)(tw + (32 * i + l31) * 64 + 32 * j + 8 * q4 + 4 * lh) = cvt4_fp8(o[0] * FP8_SACT, o[1] * FP8_SACT, o[2] * FP8_SACT, o[3] * FP8_SACT);
            }
        }
    { int ln = F.lane; asm volatile("" : "+v"(ln));
      char* dst = (char*)act + ((size_t)(rowb >> 8) * 32 + nt * 2 + g.wn) * 16384 + (64 * g.wm) * 64;
#pragma unroll
      for (int q = 0; q < 4; ++q) *(u32x4*)(dst + q * 1024 + ln * 16) = *(const u32x4*)(tw + q * 1024 + ln * 16); }
    __syncthreads();
}
__device__ __forceinline__ void moe_dn_epilogue32(const Frame& F, const GemmThread& g, const f32x16 (&acc)[2][4], int e, int mt, int nt, int ne) {
    const float* b_down = INP(21); const int* list = WSP(const int, WS_LIST); const float* gatev = WSP(const float, WS_GATEV); bf16_t* outb = WSP(bf16_t, WS_OUTB);
    int l31 = F.lane & 31, lh = F.lane >> 5; asm volatile("" : "+v"(l31), "+v"(lh));
    constexpr float RS = 1.f / (FP8_SACT * FP8_SW);
    int av[2]; float gtv[2]; f32x4 bd[4][4];
#pragma unroll
    for (int i = 0; i < 2; ++i) { int rk = mt * 256 + 64 * g.wm + 32 * i + l31; rk = rk < ne ? rk : ne - 1; av[i] = list[e * 8192 + rk]; }
#pragma unroll
    for (int j = 0; j < 4; ++j)
#pragma unroll
        for (int q4 = 0; q4 < 4; ++q4) bd[j][q4] = *(const f32x4*)(b_down + (size_t)e * DM + nt * 256 + 128 * g.wn + 32 * j + 8 * q4 + 4 * lh);
#pragma unroll
    for (int i = 0; i < 2; ++i) gtv[i] = gatev[av[i]];
    char* tw = F.lds + F.wave * 8704;
    int ln = F.lane; asm volatile("" : "+v"(ln));
#pragma unroll
    for (int i = 0; i < 2; ++i) {
        const float gt = gtv[i];
#pragma unroll
        for (int j = 0; j < 4; ++j)
#pragma unroll
            for (int q4 = 0; q4 < 4; ++q4) {
                u32x2 w = {cvt_pk_bf16((acc[i][j][4 * q4 + 0] * RS + bd[j][q4][0]) * gt, (acc[i][j][4 * q4 + 1] * RS + bd[j][q4][1]) * gt), cvt_pk_bf16((acc[i][j][4 * q4 + 2] * RS + bd[j][q4][2]) * gt, (acc[i][j][4 * q4 + 3] * RS + bd[j][q4][3]) * gt)};
                *(u32x2*)(tw + l31 * 272 + (32 * j + 8 * q4 + 4 * lh) * 2) = w; }
#pragma unroll
        for (int q = 0; q < 8; ++q) {
            const int rl = q * 4 + (ln >> 4), chunk = ln & 15;
            const int a = __shfl(av[i], rl, 64);
            const u32x4 v = *(const u32x4*)(tw + rl * 272 + chunk * 16);
            if (mt * 256 + 64 * g.wm + 32 * i + rl < ne) *(u32x4*)(outb + (size_t)a * DM + nt * 256 + 128 * g.wn + chunk * 8) = v;
        }
    }
    __syncthreads();
}
__device__ __forceinline__ void moe_up_unit_first(const Frame& F, const GemmThread& g, const MoeTab& tb, int e, int nt) {
    const int ne = __builtin_amdgcn_readfirstlane(tb.cnt[e]); if (ne == 0) return;
    const int* list = WSP(const int, WS_LIST); const unsigned char* h2 = WSP(const unsigned char, WS_H2);
    const float* w_gate = INP(16); const float* w_up = INP(18);
    f32x16 acc[2][4];
#pragma unroll
    for (int i = 0; i < 2; ++i)
#pragma unroll
        for (int j = 0; j < 4; ++j) acc[i][j] = f32x16{};
    int achunk = g.rchunk, arow = g.rrow0, kg = g.kg, ng = g.ng; asm volatile("" : "+v"(achunk), "+v"(arow), "+v"(kg), "+v"(ng));
    unsigned aoff[2];
#pragma unroll
    for (int i = 0; i < 2; ++i) { int rk = arow + 16 * i; rk = rk < ne ? rk : ne - 1; const int a = list[e * 8192 + rk]; aoff[i] = (unsigned)(a >> 2) * (unsigned)DM + achunk; }
    const int isup = (F.wave >> 1) & 1;
    const char* bb = (const char*)((isup ? w_up : w_gate) + (size_t)e * DM * DM + nt * 128);
    const unsigned boff = (unsigned)(8 * kg) * (DM * 4u) + (unsigned)((ng >> 5) * 64 + (ng & 15) * 4) * 4u;
    f8_accum_w32s(acc, F.lds, g, F.wave, (const char*)h2, aoff, bb, boff, DM * 4, DM / 64, (char*)(WSB() + WS_IMGGU) + (size_t)((e * 16 + nt) * 32) * 16384);
    moe_up_epilogue32(F, g, acc, e, 0, nt, ne, __builtin_amdgcn_readfirstlane(tb.rowbase[e]));
}
__device__ __forceinline__ void moe_dn_unit_first(const Frame& F, const GemmThread& g, const MoeTab& tb, int e, int nt) {
    const int ne = __builtin_amdgcn_readfirstlane(tb.cnt[e]); if (ne == 0) return;
    const unsigned char* act = WSP(const unsigned char, WS_ACT); const float* w_down = INP(20);
    const int rowb = __builtin_amdgcn_readfirstlane(tb.rowbase[e]);
    f32x4 acc[4][8]; acc_zero(acc);
    int achunk = g.rchunk, arow = g.rrow0, kg = g.kg, ng = g.ng; asm volatile("" : "+v"(achunk), "+v"(arow), "+v"(kg), "+v"(ng));
    unsigned aoff[2];
#pragma unroll
    for (int i = 0; i < 2; ++i) aoff[i] = (unsigned)(arow + 16 * i) * 64u + achunk;
    f8_accum_w32(acc, F.lds, g, F.wave, (const char*)(act + (size_t)(rowb >> 8) * 32 * 16384), aoff, (const char*)(w_down + (size_t)e * DM * DM + nt * 256), (unsigned)(8 * kg) * (DM * 4u) + 16u * ng, DM * 4, DM / 64,
                 (char*)(WSB() + WS_IMGDN) + (size_t)((e * 8 + nt) * 32) * 16384, 16384u);
    moe_dn_epilogue(F, g, acc, e, 0, nt, ne);
}
__device__ __forceinline__ void moe_up_unit_dma(const Frame& F, const GemmThread& g, const MoeTab& tb, int e, int mt, int nt) {
    const int ne = __builtin_amdgcn_readfirstlane(tb.cnt[e]);
    const int* list = WSP(const int, WS_LIST); const unsigned char* h2 = WSP(const unsigned char, WS_H2);
    int achunk = g.rchunk, arow = g.rrow0; asm volatile("" : "+v"(achunk), "+v"(arow));
    f32x16 acc[2][4];
#pragma unroll
    for (int i = 0; i < 2; ++i)
#pragma unroll
        for (int j = 0; j < 4; ++j) acc[i][j] = f32x16{};
    unsigned aoff[2];
#pragma unroll
    for (int i = 0; i < 2; ++i) { int rk = mt * 256 + arow + 16 * i; rk = rk < ne ? rk : ne - 1; const int a = list[e * 8192 + rk]; aoff[i] = (unsigned)(a >> 2) * (unsigned)DM + achunk; }
    s8_accum_ring(acc, F.lds, g, F.wave, F.lane, (const char*)h2, aoff, (const char*)(WSB() + WS_IMGGU) + (size_t)((e * 16 + nt) * 32) * 16384, DM / 64);
    moe_up_epilogue32(F, g, acc, e, mt, nt, ne, __builtin_amdgcn_readfirstlane(tb.rowbase[e]) + mt * 256);
}
__device__ __forceinline__ void moe_dn_unit_dma(const Frame& F, const GemmThread& g, const MoeTab& tb, int e, int mt, int nt) {
    const int ne = __builtin_amdgcn_readfirstlane(tb.cnt[e]), rowb = __builtin_amdgcn_readfirstlane(tb.rowbase[e]) + mt * 256;
    const unsigned char* act = WSP(const unsigned char, WS_ACT);
    int achunk = g.rchunk, arow = g.rrow0; asm volatile("" : "+v"(achunk), "+v"(arow));
    f32x16 acc[2][4];
#pragma unroll
    for (int i = 0; i < 2; ++i)
#pragma unroll
        for (int j = 0; j < 4; ++j) acc[i][j] = f32x16{};
    unsigned aoff[2];
#pragma unroll
    for (int i = 0; i < 2; ++i) aoff[i] = (unsigned)(arow + 16 * i) * 64u + achunk;
    s8_accum_ring(acc, F.lds, g, F.wave, F.lane, (const char*)(act + (size_t)(rowb >> 8) * 32 * 16384), aoff, (const char*)(WSB() + WS_IMGDN) + (size_t)((e * 8 + nt) * 32) * 16384, DM / 64, 16384u);
    moe_dn_epilogue32(F, g, acc, e, mt, nt, ne);
}

__device__ __forceinline__ void moe_dn_unit_dma_h(const Frame& F, const GemmThread& g, const MoeTab& tb, int e, int mt, int nt, int nh) {
    const int ne = __builtin_amdgcn_readfirstlane(tb.cnt[e]), rowb = __builtin_amdgcn_readfirstlane(tb.rowbase[e]) + mt * 256;
    const unsigned char* act = WSP(const unsigned char, WS_ACT);
    int achunk = g.rchunk, arow = g.rrow0; asm volatile("" : "+v"(achunk), "+v"(arow));
    f32x16 acc[2][2];
#pragma unroll
    for (int i = 0; i < 2; ++i)
#pragma unroll
        for (int j = 0; j < 2; ++j) acc[i][j] = f32x16{};
    unsigned aoff[2];
#pragma unroll
    for (int i = 0; i < 2; ++i) aoff[i] = (unsigned)(arow + 16 * i) * 64u + achunk;
    s8_accum_ring_h(acc, F.lds, g, F.wave, F.lane, (const char*)(act + (size_t)(rowb >> 8) * 32 * 16384), aoff, (const char*)(WSB() + WS_IMGDN) + (size_t)((e * 8 + nt) * 32) * 16384 + nh * 8192, DM / 64, 16384u);
    const float* b_down = INP(21); const int* list = WSP(const int, WS_LIST); const float* gatev = WSP(const float, WS_GATEV); bf16_t* outb = WSP(bf16_t, WS_OUTB);
    int l31 = F.lane & 31, lh = F.lane >> 5; asm volatile("" : "+v"(l31), "+v"(lh));
    constexpr float RS = 1.f / (FP8_SACT * FP8_SW);
    int av[2]; float gtv[2]; f32x4 bd[2][4];
#pragma unroll
    for (int i = 0; i < 2; ++i) { int rk = mt * 256 + 64 * g.wm + 32 * i + l31; rk = rk < ne ? rk : ne - 1; av[i] = list[e * 8192 + rk]; }
#pragma unroll
    for (int j = 0; j < 2; ++j)
#pragma unroll
        for (int q4 = 0; q4 < 4; ++q4) bd[j][q4] = *(const f32x4*)(b_down + (size_t)e * DM + nt * 256 + nh * 128 + 64 * g.wn + 32 * j + 8 * q4 + 4 * lh);
#pragma unroll
    for (int i = 0; i < 2; ++i) gtv[i] = gatev[av[i]];
#pragma unroll
    for (int i = 0; i < 2; ++i) {
        const int ml = 64 * g.wm + 32 * i + l31, rk = mt * 256 + ml;
        if (rk < ne) {
            const int a = av[i]; const float gt = gtv[i];
#pragma unroll
            for (int j = 0; j < 2; ++j)
#pragma unroll
                for (int q4 = 0; q4 < 4; ++q4) { const int col = nt * 256 + nh * 128 + 64 * g.wn + 32 * j + 8 * q4 + 4 * lh;
                    u32x2 w = {cvt_pk_bf16((acc[i][j][4 * q4 + 0] * RS + bd[j][q4][0]) * gt, (acc[i][j][4 * q4 + 1] * RS + bd[j][q4][1]) * gt), cvt_pk_bf16((acc[i][j][4 * q4 + 2] * RS + bd[j][q4][2]) * gt, (acc[i][j][4 * q4 + 3] * RS + bd[j][q4][3]) * gt)};
                    *(u32x2*)(outb + (size_t)a * DM + col) = w; }
        }
    }
}

__device__ __forceinline__ void p7_moe_a(const Frame& F) {
    const GemmThread g = gemm_thread_init();
    const MoeTab tb = moe_tab(F);
    const int vcu = (F.G & 7) ? F.bx : F.xl * (F.G >> 3) + F.rk;
#pragma unroll 1
    for (int u = vcu; u < 32 * 16; u += F.G) { const int e = u >> 4, nt = u & 15;
        moe_up_unit_first(F, g, tb, e, nt);
        if (__builtin_amdgcn_readfirstlane(tb.tiles[e]) >= 2) { const GemmThread g2 = gemm_thread_init<true>(); moe_up_unit_dma(F, g2, tb, e, 1, nt); } }
}
__device__ __forceinline__ void p8_moe_b(const Frame& F) {
    const GemmThread g = gemm_thread_init();
    const MoeTab tb = moe_tab(F);
    const int nb = __builtin_amdgcn_readfirstlane(tb.pt[32]) * 16;
    const int vcu = (F.G & 7) ? F.bx : F.xl * (F.G >> 3) + F.rk;
    int u = vcu;
#pragma unroll 1
    for (; u < 256; u += F.G) { const int e = u >> 3, nt = u & 7;
        moe_dn_unit_first(F, g, tb, e, nt);
        if (__builtin_amdgcn_readfirstlane(tb.tiles[e]) >= 2) { const GemmThread g2 = gemm_thread_init<true>(); moe_dn_unit_dma(F, g2, tb, e, 1, nt); } }
    if (F.G == 256) {
        const int T = nb >> 4, ngrp = 2 * ((T + 3) >> 2);
        for (int gi = F.xl; gi < ngrp; gi += 8) { const int tix = (gi >> 1) * 4 + (F.rk >> 3), nt = (gi & 1) * 8 + (F.rk & 7);
            if (tix < T) { int e, mt; moe_tile_of(tb, tix, e, mt); e = __builtin_amdgcn_readfirstlane(e); mt = __builtin_amdgcn_readfirstlane(mt); moe_up_unit_dma(F, g, tb, e, mt, nt); } }
    } else
    for (u = F.bx; u < nb; u += F.G) { int e, mt; moe_tile_of(tb, u >> 4, e, mt); e = __builtin_amdgcn_readfirstlane(e); mt = __builtin_amdgcn_readfirstlane(mt); moe_up_unit_dma(F, g, tb, e, mt, u & 15); }
}
__device__ __forceinline__ void p9_moe_c(const Frame& F) {
    const GemmThread g = gemm_thread_init();
    const MoeTab tb = moe_tab(F);
    const int nb = __builtin_amdgcn_readfirstlane(tb.pt[32]) * 8;
    if (F.G == 256) {
        const int T = nb >> 3, ngrp = (T + 3) >> 2;
        const int rem = ngrp & 7, nfull = (rem >= 1 && rem <= 4) ? ngrp - rem : ngrp;
        for (int gi = F.xl; gi < nfull; gi += 8) { const int tix = gi * 4 + (F.rk >> 3), nt = F.rk & 7;
            if (tix < T) { int e, mt; moe_tile_of(tb, tix, e, mt); e = __builtin_amdgcn_readfirstlane(e); mt = __builtin_amdgcn_readfirstlane(mt); moe_dn_unit_dma(F, g, tb, e, mt, nt); } }
        if (nfull < ngrp && F.xl < 2 * rem) { const int gi = nfull + (F.xl >> 1), nh = F.xl & 1, tix = gi * 4 + (F.rk >> 3), nt = F.rk & 7;
            if (tix < T) { int e, mt; moe_tile_of(tb, tix, e, mt); e = __builtin_amdgcn_readfirstlane(e); mt = __builtin_amdgcn_readfirstlane(mt); moe_dn_unit_dma_h(F, g, tb, e, mt, nt, nh); } }
    } else
    for (int u = F.bx; u < nb; u += F.G) { int e, mt; moe_tile_of(tb, u >> 3, e, mt); e = __builtin_amdgcn_readfirstlane(e); mt = __builtin_amdgcn_readfirstlane(mt); moe_dn_unit_dma(F, g, tb, e, mt, u & 7); }
}

__device__ __forceinline__ void p10_final(const Frame& F) {
    const int tid = F.tid, lane = F.lane, wave = F.wave;
    const float* gpf = INP(22); const float* x1b = WSP(const float, WS_X1); const bf16_t* outb = WSP(const bf16_t, WS_OUTB);
    float* gfv = (float*)F.lds;
    for (int grp = F.bx; grp < NTOK / 32; grp += F.G) {
        const int row0 = grp * 32, b = row0 / SEQ;
        __syncthreads();
        for (int k = tid; k < DM; k += NTHREADS) gfv[k] = mod_at(F, b * 12288 + 5 * DM + k) * gpf[k];
        __syncthreads();
#pragma unroll 1
        for (int rp = 0; rp < 4; rp += 2) {
            u32x2 m2v[2][8][4]; f32x4 xvv[2][8];
#pragma unroll
            for (int q = 0; q < 2; ++q) { const int row = row0 + wave * 4 + rp + q;
#pragma unroll
                for (int i = 0; i < 8; ++i) {
#pragma unroll
                    for (int kk = 0; kk < 4; ++kk) m2v[q][i][kk] = *(const u32x2*)(outb + (size_t)(row * 4 + kk) * DM + i * 256 + lane * 4);
                    xvv[q][i] = *(const f32x4*)(x1b + (size_t)row * DM + i * 256 + lane * 4); } }
#pragma unroll
            for (int q = 0; q < 2; ++q) { const int row = row0 + wave * 4 + rp + q;
                f32x4 y[8]; float ss = 0.f;
#pragma unroll
                for (int i = 0; i < 8; ++i) { y[i] = (f32x4){0.f, 0.f, 0.f, 0.f};
#pragma unroll
                    for (int kk = 0; kk < 4; ++kk) { const u32x2 m2 = m2v[q][i][kk];
                        y[i][0] += bflo(m2[0]); y[i][1] += bfhi(m2[0]); y[i][2] += bflo(m2[1]); y[i][3] += bfhi(m2[1]); }
                    ss += y[i][0] * y[i][0] + y[i][1] * y[i][1] + y[i][2] * y[i][2] + y[i][3] * y[i][3]; }
                ss = wave_sum(ss); const float rs = rsqrtf(ss * (1.f / DM) + EPS);
#pragma unroll
                for (int i = 0; i < 8; ++i) { const int k = i * 256 + lane * 4; const f32x4 g4 = *(const f32x4*)(gfv + k);
                    f32x4 o; for (int e = 0; e < 4; ++e) o[e] = xvv[q][i][e] + g4[e] * (y[i][e] * rs);
                    *(f32x4*)(uni(F.a->out) + (size_t)row * DM + k) = o; }
            }
        }
    }
}


__global__ void __launch_bounds__(NTHREADS, 2) fwd_kernel(Args args) {
    extern __shared__ __attribute__((aligned(16))) char lds[];
    Frame F;
    F.lds = lds; F.a = &args;
    F.tid = threadIdx.x; F.lane = F.tid & 63; F.wave = __builtin_amdgcn_readfirstlane(F.tid >> 6); F.G = gridDim.x; F.bx = blockIdx.x;
    const int lo = args.ph_lo, hi = args.ph_hi;
    F.xl = F.bx & 7; F.rk = F.bx >> 3;
    XcdBarrier bar; bar.bar = (unsigned*)(args.ws + WS_CTL); bar.x = 0; bar.st = (volatile LAS unsigned*)(lds + LDS_MISC);
    if (hi - lo > 1) {
        if (F.tid == 0) { *(volatile LAS unsigned*)(lds + LDS_MISC) = 0u; *(volatile LAS unsigned*)(lds + LDS_MISC + 4) = 0u; }
        __syncthreads();
        bar = xcd_barrier_post((unsigned*)(args.ws + WS_CTL), (volatile LAS unsigned*)(lds + LDS_MISC));
        if (F.tid == 0) *(volatile LAS unsigned*)(lds + LDS_MISC + 16) = xb_add((unsigned*)(args.ws + WS_CTL + CTL_RANK_OFF) + bar.x, 1u);
    }
#ifndef PH_MASK
#define PH_MASK 0x7ff
#endif
#define IN(k) (((PH_MASK >> (k)) & 1) && lo <= (k) && (k) < hi)
#define SEAM(k) do { if (IN(k) && IN((k) + 1)) xcd_barrier(bar); } while (0)
    if (IN(0)) { p0_prologue(F); } SEAM(0);
    if (hi - lo > 1 && (F.G & 7) == 0) {
        if (F.tid == 0) { unsigned ok = 1u; for (int j = 0; j < 8; ++j) ok &= (xb_ld(&bar.bar[XB_XCNT(j)]) == (unsigned)(F.G >> 3)) ? 1u : 0u; *(volatile LAS unsigned*)(lds + LDS_MISC + 20) = ok; }
        __syncthreads();
        if (*(volatile LAS unsigned*)(lds + LDS_MISC + 20) && bar.x < 8u) { F.xl = (int)bar.x; F.rk = (int)*(volatile LAS unsigned*)(lds + LDS_MISC + 16); }
        F.xl = __builtin_amdgcn_readfirstlane(F.xl); F.rk = __builtin_amdgcn_readfirstlane(F.rk);
    }
    if (IN(1)) { p1_norm(F); } SEAM(1);
    if (IN(2)) { p2_inproj(F); } SEAM(2);
    if (IN(3)) { p3_mixers(F); } SEAM(3);
    if (IN(4)) { p4_merge_norm(F); } SEAM(4);
    if (IN(5)) { p5_outproj(F); } SEAM(5);
    if (IN(6)) { p6_postmix(F); } SEAM(6);
    if (IN(7)) { p7_moe_a(F); } SEAM(7);
    if (IN(8)) { p8_moe_b(F); } SEAM(8);
    if (IN(9)) { p9_moe_c(F); } SEAM(9);
    if (IN(10)) { p10_final(F); }
#undef IN
#undef SEAM
}

}

extern "C" void kernel_launch(void* const* d_in, const int* in_sizes, int n_in, void* d_out, int out_size, void* d_ws, size_t ws_size, hipStream_t stream) {
    static int grid = 0;
    if (grid == 0) {
        if (n_in != 23 || out_size != NTOK * DM || ws_size < WS_END) { fprintf(stderr, "kernel_launch: unexpected shapes (n_in %d out %d ws %zu need %zu)\n", n_in, out_size, ws_size, (size_t)WS_END); grid = -1; return; }
        int dev = 0, cus = 0, per_cu = 0;
        if (hipGetDevice(&dev) != hipSuccess || hipDeviceGetAttribute(&cus, hipDeviceAttributeMultiprocessorCount, dev) != hipSuccess) { grid = -1; return; }
        if (hipFuncSetAttribute((const void*)fwd_kernel, hipFuncAttributeMaxDynamicSharedMemorySize, LDS_BYTES) != hipSuccess) { fprintf(stderr, "kernel_launch: hipFuncSetAttribute failed\n"); grid = -1; return; }
        if (hipOccupancyMaxActiveBlocksPerMultiprocessor(&per_cu, (const void*)fwd_kernel, NTHREADS, LDS_BYTES) != hipSuccess || per_cu < 1)
            fprintf(stderr, "kernel_launch: occupancy query reports %d blocks per CU\n", per_cu);
        (void)hipGetLastError();
        grid = cus;
    }
    if (grid < 0) return;
    (void)hipMemsetAsync((char*)d_ws + WS_CTL, 0, CTL_BYTES, stream);
    Args a{};
    for (int i = 0; i < 23; ++i) a.in[i] = (const float*)d_in[i];
    a.out = (float*)d_out; a.ws = (unsigned char*)d_ws;
#if MK_N_LAUNCHES == 1
    a.ph_lo = 0; a.ph_hi = NPHASE;
    hipLaunchKernelGGL(fwd_kernel, dim3(grid), dim3(NTHREADS), LDS_BYTES, stream, a);
#else
    for (int p = 0; p < NPHASE; ++p) { a.ph_lo = p; a.ph_hi = p + 1; hipLaunchKernelGGL(fwd_kernel, dim3(grid), dim3(NTHREADS), LDS_BYTES, stream, a);
        if ((REP_MASK >> p) & 1) hipLaunchKernelGGL(fwd_kernel, dim3(grid), dim3(NTHREADS), LDS_BYTES, stream, a); }
#endif
    const hipError_t le = hipPeekAtLastError();
    if (le != hipSuccess) fprintf(stderr, "kernel_launch: launch failed: %s\n", hipGetErrorName(le));
}
```

```cpp
#include <hip/hip_runtime.h>
#include <stdint.h>
#include <stdio.h>

#ifndef DEBUG_X1
#define DEBUG_X1 0
#endif
#ifndef STAMP_A
#define STAMP_A 0
#endif
#ifndef STAMP_B
#define STAMP_B 0
#endif
#ifndef S8_KMAP
#define S8_KMAP 0
#endif
#ifndef REP_MASK
#define REP_MASK 0
#endif
#ifndef DEBUG_PROBE
#define DEBUG_PROBE 0
#endif
#ifndef P3_MASK
#define P3_MASK 3
#endif
#ifndef MK_N_LAUNCHES
#define MK_N_LAUNCHES 1
#endif

namespace {

constexpr int DM = 2048, NBATCH = 4, SEQ = 2048, NTOK = NBATCH * SEQ;
constexpr int FW = 512, AW = 1536, KVW = 512, INW = 3072;
constexpr int NEXP = 32, TOPK = 4, NMOD = 6;
constexpr int NPHASE = 11;
constexpr float EPS = 1e-6f;
constexpr int NTHREADS = 512;
constexpr float FP8_SA = 16.f, FP8_SW = 256.f, FP8_SACT = 4.f;

typedef unsigned short bf16_t;
typedef short bf16x8 __attribute__((ext_vector_type(8)));
typedef short s16x4 __attribute__((ext_vector_type(4)));
typedef float f32x4 __attribute__((ext_vector_type(4)));
typedef float f32x2 __attribute__((ext_vector_type(2)));
typedef float f32x16 __attribute__((ext_vector_type(16)));
typedef unsigned u32x4 __attribute__((ext_vector_type(4)));
typedef unsigned u32x2 __attribute__((ext_vector_type(2)));

constexpr size_t al256(size_t x) { return (x + 255) / 256 * 256; }
constexpr size_t WS_CTL   = 0;
constexpr size_t CTL_BAR_BYTES = 16384;
constexpr size_t CTL_CNT_OFF = CTL_BAR_BYTES;
constexpr size_t CTL_RANK_OFF = CTL_BAR_BYTES + 256;
constexpr size_t CTL_BYTES = CTL_BAR_BYTES + 512;
constexpr size_t WS_MODP  = al256(WS_CTL + CTL_BYTES);
constexpr size_t WS_G12   = al256(WS_MODP + 2ull * 4 * 12288 * 4);
constexpr size_t WS_ROPE  = al256(WS_G12 + 4ull * 128 * 256 * 4);
constexpr size_t WS_WZ    = al256(WS_ROPE + 2048ull * 64 * 2 * 4);
constexpr size_t WS_CMAT  = al256(WS_WZ + 2048ull * 1024 * 4);
constexpr size_t WS_SMAT  = al256(WS_CMAT + 2048ull * 2048 * 2);
constexpr size_t WS_H     = al256(WS_SMAT + 2048ull * 2048 * 2);
constexpr size_t WS_ZC    = al256(WS_H + (size_t)NTOK * DM * 2);
constexpr size_t WS_ZS    = al256(WS_ZC + (size_t)NTOK * 512 * 4);
constexpr size_t WS_Q     = al256(WS_ZS + (size_t)NTOK * 512 * 4);
constexpr size_t WS_K     = al256(WS_Q + (size_t)NTOK * AW * 2);
constexpr size_t WS_V     = al256(WS_K + (size_t)NTOK * KVW * 2);
constexpr size_t WS_MRG   = al256(WS_V + (size_t)NTOK * KVW * 2);
constexpr size_t WS_MIX   = al256(WS_MRG + (size_t)NTOK * DM * 2);
constexpr size_t WS_X1    = al256(WS_MIX + (size_t)NTOK * DM * 2);
constexpr size_t WS_H2    = al256(WS_X1 + (size_t)NTOK * DM * 4);
constexpr size_t WS_LIST  = al256(WS_H2 + (size_t)NTOK * DM * 2);
constexpr size_t WS_GATEV = al256(WS_LIST + 32ull * 8192 * 4);
constexpr int ACT_ROWS = NTOK * TOPK + NEXP * 256;
constexpr size_t WS_ACT   = al256(WS_GATEV + 32768ull * 4);
constexpr size_t WS_OUTB  = al256(WS_ACT + (size_t)ACT_ROWS * DM * 2);
constexpr size_t WS_IMGGU = al256(WS_OUTB + (size_t)NTOK * TOPK * DM * 2);
constexpr size_t WS_IMGDN = al256(WS_IMGGU + 32ull * 16 * 32 * 16384);
constexpr size_t WS_IMGIN = al256(WS_IMGDN + 32ull * 8 * 32 * 16384);
constexpr size_t WS_IMGOUT= al256(WS_IMGIN + 14ull * 32 * 32768);
constexpr size_t WS_IMGZ  = al256(WS_IMGOUT + 8ull * 32 * 32768);
constexpr size_t WS_END   = al256(WS_IMGZ + 8ull * 64 * 32768);

constexpr int LDS_GEMM = 147456;
constexpr int LDS_MISC = LDS_GEMM;
constexpr int LDS_BYTES = LDS_GEMM + 1024;

typedef __bf16 bf16x2_t __attribute__((ext_vector_type(2)));
__device__ __forceinline__ unsigned cvt_pk_bf16(float lo, float hi) { f32x2 v = {lo, hi}; bf16x2_t b = __builtin_convertvector(v, bf16x2_t); return __builtin_bit_cast(unsigned, b); }
__device__ __forceinline__ bf16_t f2bf(float f) { return (bf16_t)(cvt_pk_bf16(f, 0.f) & 0xffffu); }
__device__ __forceinline__ float bf2f(unsigned h) { return __uint_as_float(h << 16); }
__device__ __forceinline__ float bflo(unsigned w) { return __uint_as_float(w << 16); }
__device__ __forceinline__ float bfhi(unsigned w) { return __uint_as_float(w & 0xffff0000u); }
__device__ __forceinline__ float wave_sum(float v) {
#pragma unroll
    for (int o = 32; o >= 1; o >>= 1) v += __shfl_xor(v, o, 64);
    return v;
}

#define XB_TMO      128
#define XB_XCNT(j)  (256  + 64 * (j))
#define XB_XSUB(j)  (1280 + 64 * (j))
#define XB_XGEN(j)  (2304 + 64 * (j))
#define XB_TOP      3328
#define XB_TOPGEN   3392
#define XCD_BAR_WORDS 3456
#define XB_SPIN_CAP (1u << 22)
#define LAS __attribute__((address_space(3)))

__device__ __forceinline__ unsigned xb_ld(unsigned* p)              { return __hip_atomic_load(p, __ATOMIC_RELAXED, __HIP_MEMORY_SCOPE_AGENT); }
__device__ __forceinline__ unsigned xb_add(unsigned* p, unsigned v) { return __hip_atomic_fetch_add(p, v, __ATOMIC_RELAXED, __HIP_MEMORY_SCOPE_AGENT); }
__device__ __forceinline__ unsigned xb_xcc_id() { return (unsigned)__builtin_amdgcn_s_getreg((3 << 11) | 20) & 0xFu; }
#define XB_SPIN(cond, bar) do { unsigned _sp = 0; while (cond) { __builtin_amdgcn_s_sleep(1); \
    if ((++_sp & 255u) == 0u) { if (xb_ld(&(bar)[XB_TMO])) break; if (_sp > XB_SPIN_CAP) { atomicAdd(&(bar)[XB_TMO], 1u); break; } } } } while (0)

struct XcdBarrier { unsigned* bar; unsigned x; volatile LAS unsigned* st; };

__device__ __forceinline__ XcdBarrier xcd_barrier_post(unsigned* bar, volatile LAS unsigned* st) {
    XcdBarrier b; b.bar = bar; b.x = xb_xcc_id(); b.st = st;
    if (threadIdx.x == 0) (void)xb_add(&bar[XB_XCNT(b.x)], 1u);
    return b;
}
__device__ __forceinline__ void xcd_barrier_complete(unsigned* bar, unsigned x, unsigned& nloc, unsigned& nx) {
    const unsigned G = gridDim.x * gridDim.y * gridDim.z;
    unsigned sum, cnt, mine, sp = 0u;
    for (;;) {
        sum = 0u; cnt = 0u; mine = 0u;
#pragma unroll
        for (unsigned j = 0; j < 16; ++j) { const unsigned c = xb_ld(&bar[XB_XCNT(j)]); sum += c; cnt += (c > 0u) ? 1u : 0u; mine = (j == x) ? c : mine; }
        if (sum == G) break;
        __builtin_amdgcn_s_sleep(1);
        if ((++sp & 255u) == 0u) { if (xb_ld(&bar[XB_TMO])) break; if (sp > XB_SPIN_CAP) { atomicAdd(&bar[XB_TMO], 1u); break; } }
    }
    nloc = mine > 0u ? mine : 1u; nx = cnt > 0u ? cnt : 1u;
}
__device__ __forceinline__ void xcd_barrier(const XcdBarrier& b) {
    asm volatile("s_waitcnt vmcnt(0)" ::: "memory");
    __syncthreads();
    if (threadIdx.x == 0) {
        unsigned* bar = b.bar;
        __builtin_amdgcn_s_waitcnt(0);
        unsigned nloc = b.st[0], nx = b.st[1];
        if (nloc == 0u) { xcd_barrier_complete(bar, b.x, nloc, nx); b.st[0] = nloc; b.st[1] = nx; }
        const unsigned old = xb_add(&bar[XB_XSUB(b.x)], 1u);
        const unsigned gen = old / nloc;
        if (old + 1u == (gen + 1u) * nloc) {
            __builtin_amdgcn_fence(__ATOMIC_RELEASE, "agent");
            asm volatile("s_waitcnt vmcnt(0)" ::: "memory");
            const unsigned og = xb_add(&bar[XB_TOP], 1u);
            const unsigned tg = og / nx;
            if (og + 1u == (tg + 1u) * nx) xb_add(&bar[XB_TOPGEN], 1u);
            else XB_SPIN(xb_ld(&bar[XB_TOPGEN]) == tg, bar);
            __builtin_amdgcn_fence(__ATOMIC_ACQUIRE, "agent");
            xb_add(&bar[XB_XGEN(b.x)], 1u);
            asm volatile("s_waitcnt vmcnt(0)" ::: "memory");
        } else {
            XB_SPIN(xb_ld(&bar[XB_XGEN(b.x)]) == gen, bar);
            __builtin_amdgcn_fence(__ATOMIC_ACQUIRE, "agent");
            asm volatile("s_waitcnt vmcnt(0)" ::: "memory");
        }
    }
    __syncthreads();
}

struct Args {
    const float* in[23];
    float* out;
    unsigned char* ws;
    int ph_lo, ph_hi;
};

struct GemmThread {
    int a_w0;
    int b_w0;
    int a_r, b_r;
    int c8;
    int r0;
    int kg, ng;
    int wm, wn, l15, lq;
    int arow0, achunk;
    int rrow0, rchunk;
    int rfr;
    int imgw0;
    int f8r0, f8r1;
    int f8w0;
    int s8r0, s8r1;
};
__host__ __device__ constexpr int sw4(int c) { return (0x9C >> (2 * c)) & 3; }
__host__ __device__ constexpr int sw4inv(int p) { return (0x78 >> (2 * p)) & 3; }
template <bool OPQ = false>
__device__ __forceinline__ GemmThread gemm_thread_init() {
    GemmThread g;
    int tid = threadIdx.x; if (OPQ) asm volatile("" : "+v"(tid));
    const int lane = tid & 63, wave = __builtin_amdgcn_readfirstlane(tid >> 6);
    const int c = tid & 7; g.r0 = tid >> 3; g.c8 = c * 8;
    g.a_w0 = g.r0 * 128 + ((c ^ (g.r0 & 7)) << 4);
    g.kg = lane & 7; g.ng = (lane >> 3) + 8 * wave;
    g.b_w0 = 32768 + (4 * g.ng) * 128 + ((g.kg ^ ((4 * g.ng) & 7)) << 4);
    g.wm = wave >> 1; g.wn = wave & 1; g.l15 = lane & 15; g.lq = lane >> 4;
    const int sw = ((g.lq ^ (g.l15 & 7)) << 4);
    g.a_r = (64 * g.wm + g.l15) * 128 + sw;
    g.b_r = 32768 + (128 * g.wn + g.l15) * 128 + sw;
    g.arow0 = 32 * wave + (lane >> 3); g.achunk = ((lane & 7) ^ (lane >> 3)) * 16;
    g.rrow0 = 32 * wave + (lane >> 2); g.rchunk = sw4inv((lane & 3) ^ ((lane >> 4) & 3)) * 16;
    g.rfr = g.l15 * 64 + ((((g.l15 >> 2) & 3) ^ sw4(g.lq)) << 4);
    g.imgw0 = (g.kg >> 2) * 16384 + (4 * g.ng) * 64 + (((g.ng & 3) ^ sw4(g.kg & 3)) << 4);
    g.f8r0 = g.l15 * 64 + ((((g.l15 >> 2) & 3) ^ sw4(g.lq >> 1)) << 4) + 8 * (g.lq & 1);
    g.f8r1 = g.l15 * 64 + ((((g.l15 >> 2) & 3) ^ sw4(2 + (g.lq >> 1))) << 4) + 8 * (g.lq & 1);
    g.f8w0 = (4 * g.ng) * 64 + (((g.ng & 3) ^ sw4(g.kg >> 1)) << 4) + 8 * (g.kg & 1);
    { const int r32 = lane & 31, hh = lane >> 5, qq = (r32 >> 2) & 3;
      const int c0 = S8_KMAP ? hh : 2 * hh, c1 = S8_KMAP ? 2 + hh : 2 * hh + 1;
      g.s8r0 = r32 * 64 + ((qq ^ sw4(c0)) << 4); g.s8r1 = r32 * 64 + ((qq ^ sw4(c1)) << 4); }
    return g;
}

template <class T> __device__ __forceinline__ T* sgpr_ptr(T* p) {
    const unsigned long long v = (unsigned long long)p;
    const unsigned lo = __builtin_amdgcn_readfirstlane((unsigned)v), hi = __builtin_amdgcn_readfirstlane((unsigned)(v >> 32));
    typedef __attribute__((address_space(1))) T* gptr_t;
    return (T*)(gptr_t)(((unsigned long long)hi << 32) | lo);
}
__device__ __forceinline__ f32x4 ld_nt_async(const char* sbase, unsigned voff) {
    f32x4 r; asm volatile("global_load_dwordx4 %0, %1, %2 nt" : "=v"(r) : "v"(voff), "s"(sbase) : "memory"); return r;
}
#define RB_PIN(WAITSTR, RB) asm volatile(WAITSTR : "+v"(RB[0]), "+v"(RB[1]), "+v"(RB[2]), "+v"(RB[3]), "+v"(RB[4]), "+v"(RB[5]), "+v"(RB[6]), "+v"(RB[7]) :: "memory")
__device__ __forceinline__ void glds16(const void* src, char* lds_wave_base) {
    __builtin_amdgcn_global_load_lds((const unsigned*)src, (LAS unsigned*)lds_wave_base, 16, 0, 0);
}
#define G_AF(ks)  _Pragma("unroll") for (int i_ = 0; i_ < 4; ++i_) af[i_] = *(const bf16x8*)(sb + ((g.a_r ^ ((ks) << 6)) + i_ * 2048));
#define G_BF(ks, jh) _Pragma("unroll") for (int j_ = 0; j_ < 4; ++j_) bfr[j_] = *(const bf16x8*)(sb + ((g.b_r ^ ((ks) << 6)) + ((jh) * 4 + j_) * 2048));
#define G_MM(jh) _Pragma("unroll") for (int j_ = 0; j_ < 4; ++j_) _Pragma("unroll") for (int i_ = 0; i_ < 4; ++i_) \
        acc[i_][(jh) * 4 + j_] = __builtin_amdgcn_mfma_f32_16x16x32_bf16(bfr[j_], af[i_], acc[i_][(jh) * 4 + j_], 0, 0, 0);
#define G_WRB(sn, j_) do { u32x4 w_; \
        w_[0] = cvt_pk_bf16(rb[0][j_], rb[1][j_]); w_[1] = cvt_pk_bf16(rb[2][j_], rb[3][j_]); \
        w_[2] = cvt_pk_bf16(rb[4][j_], rb[5][j_]); w_[3] = cvt_pk_bf16(rb[6][j_], rb[7][j_]); \
        *(u32x4*)((sn) + (bw0_ ^ ((j_) * 0x90))) = w_; \
        if (IMG) *(u32x4*)(imgk + g.imgw0 + (j_) * 64) = w_; } while (0)
template <bool TWO_SEG, bool WR, bool LD, bool IMG>
__device__ __forceinline__ void gemm_step(f32x4 (&acc)[4][8], char* lds, const GemmThread& g, const int wave, f32x4 (&rb)[8], const int kt,
                                          const char* Abase, const unsigned (&aoffb)[4], const char* Bbase, const unsigned boffb, const int ldbB,
                                          const char* Abase2, const char* Bbase2, const int nk1, char* img) {
    asm volatile("s_waitcnt vmcnt(0)" ::: "memory");
    __syncthreads();
    const char* sb = lds + (kt & 1) * 65536; char* sn = lds + ((kt + 1) & 1) * 65536;
    char* imgk = img + (size_t)(kt + 1) * 32768;
    if (WR) {
        const int k1 = kt + 1; const bool s1 = TWO_SEG && k1 >= nk1; const char* ak = (s1 ? Abase2 : Abase) + (size_t)(s1 ? k1 - nk1 : k1) * 128;
#pragma unroll
        for (int i = 0; i < 4; ++i) glds16(ak + aoffb[i], sn + (4 * wave + i) * 1024);
    }
    int bw0_ = g.b_w0; asm volatile("" : "+v"(bw0_));
    bf16x8 af[4], bfr[4];
    G_AF(0) G_BF(0, 0) G_MM(0)
    if (WR) { G_WRB(sn, 0); G_WRB(sn, 1); }
    __builtin_amdgcn_sched_barrier(0);
    G_BF(0, 1) G_MM(1)
    if (WR) { G_WRB(sn, 2); G_WRB(sn, 3); }
    if (LD) {
        const int k2 = kt + 2; const bool s2 = TWO_SEG && k2 >= nk1; const int kk = s2 ? k2 - nk1 : k2;
        const char* bk = (s2 ? Bbase2 : Bbase) + (size_t)kk * 64 * ldbB;
#pragma unroll
        for (int k = 0; k < 8; ++k) rb[k] = *(const f32x4*)(bk + (size_t)k * ldbB + boffb);
    }
    __builtin_amdgcn_sched_barrier(0);
    G_AF(1) G_BF(1, 0) G_MM(0)
    __builtin_amdgcn_sched_barrier(0);
    G_BF(1, 1) G_MM(1)
}

template <bool TWO_SEG = false, bool IMG = false>
__device__ __forceinline__ void gemm_accum(f32x4 (&acc)[4][8], char* lds, const GemmThread& g, const int wave,
                                           const char* Abase, const unsigned (&aoffb)[4],
                                           const char* Bbase, const unsigned boffb, const int ldbB, const int nk,
                                           const char* Abase2 = nullptr, const char* Bbase2 = nullptr, const int nk1 = 0, char* img = nullptr) {
    f32x4 rb[8];
#define G_LOADB(kt) do { const char* bk_ = Bbase + (size_t)(kt) * 64 * ldbB; \
        _Pragma("unroll") for (int k_ = 0; k_ < 8; ++k_) rb[k_] = *(const f32x4*)(bk_ + (size_t)k_ * ldbB + boffb); } while (0)
#pragma unroll
    for (int i = 0; i < 4; ++i) glds16(Abase + aoffb[i], lds + (4 * wave + i) * 1024);
    G_LOADB(0);
    { char* sn = lds; char* imgk = img; const int bw0_ = g.b_w0; G_WRB(sn, 0); G_WRB(sn, 1); G_WRB(sn, 2); G_WRB(sn, 3); }
    G_LOADB(1);
    for (int kt = 0; kt < nk - 2; ++kt) gemm_step<TWO_SEG, true, true, IMG>(acc, lds, g, wave, rb, kt, Abase, aoffb, Bbase, boffb, ldbB, Abase2, Bbase2, nk1, img);
    gemm_step<TWO_SEG, true, false, IMG>(acc, lds, g, wave, rb, nk - 2, Abase, aoffb, Bbase, boffb, ldbB, Abase2, Bbase2, nk1, img);
    gemm_step<TWO_SEG, false, false, IMG>(acc, lds, g, wave, rb, nk - 1, Abase, aoffb, Bbase, boffb, ldbB, Abase2, Bbase2, nk1, img);
    __syncthreads();
#undef G_LOADB
}

#define R_MMJ(AF, BF, jh, j) do { _Pragma("unroll") for (int i_ = 0; i_ < 4; ++i_) \
        acc[i_][(jh) * 4 + (j)] = __builtin_amdgcn_mfma_f32_16x16x32_bf16(BF[j], AF[i_], acc[i_][(jh) * 4 + (j)], 0, 0, 0); } while (0)
#define R_SB() __builtin_amdgcn_sched_barrier(0)
#define R_MMI(AF, BF, i) do { _Pragma("unroll") for (int j_ = 0; j_ < 4; ++j_) \
        acc[i][4 + j_] = __builtin_amdgcn_mfma_f32_16x16x32_bf16(BF[j_], AF[i], acc[i][4 + j_], 0, 0, 0); } while (0)
__device__ __forceinline__ void gemm_accum_ring(f32x4 (&acc)[4][8], char* lds, const GemmThread& g, const int wave, const int lane,
                                                const char* Abase, const unsigned (&aoffb)[2], const char* Bimg, const int nk) {
    const unsigned boffl = (unsigned)wave * 2048u + (unsigned)lane * 16u;
    const int NS = 2 * nk;
    const int saoff = g.rfr + (64 * g.wm) * 64, sboff = 16384 + g.rfr + (128 * g.wn) * 64;
#pragma unroll
    for (int s = 0; s < 4; ++s) { char* sd = lds + s * 32768 + wave * 2048; const char* ak = sgpr_ptr(Abase + (size_t)s * 64); const char* bk = sgpr_ptr(Bimg + (size_t)s * 16384);
        glds16(ak + aoffb[0], sd); glds16(bk + boffl, sd + 16384); glds16(ak + aoffb[1], sd + 1024); glds16(bk + (boffl + 1024u), sd + 16384 + 1024); }
    asm volatile("s_waitcnt vmcnt(12)" ::: "memory");
    __builtin_amdgcn_s_barrier();
    asm volatile("" ::: "memory");
    bf16x8 a0[4], b0[4], b1[4];
#pragma unroll
    for (int i = 0; i < 4; ++i) a0[i] = *(const bf16x8*)(lds + saoff + i * 1024);
#pragma unroll
    for (int j = 0; j < 4; ++j) b0[j] = *(const bf16x8*)(lds + sboff + j * 1024);
#pragma unroll
    for (int j = 0; j < 4; ++j) b1[j] = *(const bf16x8*)(lds + sboff + (4 + j) * 1024);
#pragma unroll 1
    for (int s = 0; s < NS; ++s) {
        R_MMJ(a0, b0, 0, 0); R_MMJ(a0, b0, 0, 1); R_MMJ(a0, b0, 0, 2); R_MMJ(a0, b0, 0, 3);
        R_SB();
        asm volatile("s_waitcnt vmcnt(8)" ::: "memory");
        asm volatile("s_waitcnt lgkmcnt(0)" ::: "memory");
        __builtin_amdgcn_s_barrier();
        asm volatile("" ::: "memory");
        const bool ld = s + 4 < NS;
        const char* sn = lds + ((s + 1) & 3) * 32768;
        char* sd = lds + (s & 3) * 32768 + wave * 2048;
        const char* ak = sgpr_ptr(ld ? Abase + (size_t)(s + 4) * 64 : Bimg); const char* bk = sgpr_ptr(ld ? Bimg + (size_t)(s + 4) * 16384 : Bimg);
        const char* p0 = ak + (ld ? aoffb[0] : 0u); const char* p1 = bk + (ld ? boffl : 0u); const char* p2 = ak + (ld ? aoffb[1] : 0u); const char* p3 = bk + (ld ? boffl + 1024u : 0u);
#pragma unroll
        for (int j = 0; j < 4; ++j) b0[j] = *(const bf16x8*)(sn + sboff + j * 1024);
        glds16(p0, sd); R_SB();
        R_MMI(a0, b1, 0); R_SB();
        a0[0] = *(const bf16x8*)(sn + saoff); glds16(p1, sd + 16384); R_SB();
        R_MMI(a0, b1, 1); R_SB();
        a0[1] = *(const bf16x8*)(sn + saoff + 1024); glds16(p2, sd + 1024); R_SB();
        R_MMI(a0, b1, 2); R_SB();
        a0[2] = *(const bf16x8*)(sn + saoff + 2048); glds16(p3, sd + 16384 + 1024); R_SB();
        R_MMI(a0, b1, 3); R_SB();
        a0[3] = *(const bf16x8*)(sn + saoff + 3072);
#pragma unroll
        for (int j = 0; j < 4; ++j) b1[j] = *(const bf16x8*)(sn + sboff + (4 + j) * 1024);
        R_SB();
    }
    __syncthreads();
}

typedef long f8x8;
__device__ __forceinline__ unsigned cvt4_fp8(float a, float b, float c, float d) {
    unsigned w = 0; w = __builtin_amdgcn_cvt_pk_fp8_f32(a, b, w, false); w = __builtin_amdgcn_cvt_pk_fp8_f32(c, d, w, true); return w;
}
#define F8_RA(AF, off) _Pragma("unroll") for (int i_ = 0; i_ < 4; ++i_) AF[i_] = *(const f8x8*)(sa + (off) + i_ * 1024);
#define F8_RB(BF, off) _Pragma("unroll") for (int j_ = 0; j_ < 8; ++j_) BF[j_] = *(const f8x8*)(sbb + (off) + j_ * 1024);
#define F8_MMJ(AF, BF, j) do { _Pragma("unroll") for (int i_ = 0; i_ < 4; ++i_) \
        acc[i_][j] = __builtin_amdgcn_mfma_f32_16x16x32_fp8_fp8(BF[j], AF[i_], acc[i_][j], 0, 0, 0); } while (0)
template <int WAITN, bool LD>
__device__ __forceinline__ void f8_ring_step(f32x4 (&acc)[4][8], char* lds, const GemmThread& g, const int wave, const int s,
                                             const char* Abase, const unsigned (&aoffb)[2], const char* Bimg, const unsigned boffl) {
    if (WAITN == 8) asm volatile("s_waitcnt vmcnt(8)" ::: "memory"); else if (WAITN == 4) asm volatile("s_waitcnt vmcnt(4)" ::: "memory"); else asm volatile("s_waitcnt vmcnt(0)" ::: "memory");
    asm volatile("s_waitcnt lgkmcnt(0)" ::: "memory");
    __builtin_amdgcn_s_barrier();
    asm volatile("" ::: "memory");
    const char* sa = lds + (s & 3) * 32768 + (64 * g.wm) * 64; const char* sbb = lds + (s & 3) * 32768 + 16384 + (128 * g.wn) * 64;
    char* sd = lds + ((s + 3) & 3) * 32768 + wave * 2048;
    const char* ak = Abase + (size_t)(s + 3) * 64; const char* bk = Bimg + (size_t)(s + 3) * 16384 + boffl;
    f8x8 a0[4], b0[8], a1[4], b1[8];
    F8_RA(a0, g.f8r0) F8_RB(b0, g.f8r0)
    R_SB();
    F8_MMJ(a0, b0, 0); R_SB(); if (LD) glds16(ak + aoffb[0], sd); R_SB();
    F8_MMJ(a0, b0, 1); R_SB(); if (LD) glds16(bk, sd + 16384); R_SB();
    F8_MMJ(a0, b0, 2); R_SB(); if (LD) glds16(ak + aoffb[1], sd + 1024); R_SB();
    F8_MMJ(a0, b0, 3); R_SB(); if (LD) glds16(bk + 1024, sd + 16384 + 1024); R_SB();
    F8_RA(a1, g.f8r1) F8_RB(b1, g.f8r1)
    R_SB();
    F8_MMJ(a0, b0, 4); F8_MMJ(a0, b0, 5); F8_MMJ(a0, b0, 6); F8_MMJ(a0, b0, 7);
    R_SB();
    F8_MMJ(a1, b1, 0); F8_MMJ(a1, b1, 1); F8_MMJ(a1, b1, 2); F8_MMJ(a1, b1, 3); F8_MMJ(a1, b1, 4); F8_MMJ(a1, b1, 5); F8_MMJ(a1, b1, 6); F8_MMJ(a1, b1, 7);
}
__device__ __forceinline__ void f8_accum_ring(f32x4 (&acc)[4][8], char* lds, const GemmThread& g, const int wave, const int lane,
                                              const char* Abase, const unsigned (&aoffb)[2], const char* Bimg, const int nk) {
    const unsigned boffl = (unsigned)wave * 2048u + (unsigned)lane * 16u;
#pragma unroll
    for (int s = 0; s < 3; ++s) { char* sd = lds + s * 32768 + wave * 2048; const char* ak = Abase + (size_t)s * 64; const char* bk = Bimg + (size_t)s * 16384 + boffl;
        glds16(ak + aoffb[0], sd); glds16(bk, sd + 16384); glds16(ak + aoffb[1], sd + 1024); glds16(bk + 1024, sd + 16384 + 1024); }
    for (int s = 0; s < nk - 3; ++s) f8_ring_step<8, true>(acc, lds, g, wave, s, Abase, aoffb, Bimg, boffl);
    f8_ring_step<8, false>(acc, lds, g, wave, nk - 3, Abase, aoffb, Bimg, boffl);
    f8_ring_step<4, false>(acc, lds, g, wave, nk - 2, Abase, aoffb, Bimg, boffl);
    f8_ring_step<0, false>(acc, lds, g, wave, nk - 1, Abase, aoffb, Bimg, boffl);
    __syncthreads();
}
typedef int i32x8 __attribute__((ext_vector_type(8)));
typedef int i32x4 __attribute__((ext_vector_type(4)));
__device__ __forceinline__ i32x8 s8_frag(const char* p0, const char* p1) {
    const i32x4 lo = *(const i32x4*)p0, hi = *(const i32x4*)p1;
    return __builtin_shufflevector(lo, hi, 0, 1, 2, 3, 4, 5, 6, 7);
}
#define S8_MM(i, j) acc[i][j] = __builtin_amdgcn_mfma_scale_f32_32x32x64_f8f6f4(bf[j], af[i], acc[i][j], 0, 0, 0, 0x7F7F7F7F, 0, 0x7F7F7F7F)
#define S8_FR(base) s8_frag((base) + g.s8r0, (base) + g.s8r1)
__device__ __forceinline__ void s8_accum_ring(f32x16 (&acc)[2][4], char* lds, const GemmThread& g, const int wave, const int lane,
                                              const char* Abase, const unsigned (&aoffb)[2], const char* Bimg, const int nk, const unsigned astr = 64) {
    const unsigned boffl = (unsigned)wave * 2048u + (unsigned)lane * 16u;
    const int saoff = (64 * g.wm) * 64, sboff = 16384 + (128 * g.wn) * 64;
#pragma unroll
    for (int s = 0; s < 4; ++s) { char* sd = lds + s * 32768 + wave * 2048; const char* ak = sgpr_ptr(Abase + (size_t)s * astr); const char* bk = sgpr_ptr(Bimg + (size_t)s * 16384);
        glds16(ak + aoffb[0], sd); glds16(bk + boffl, sd + 16384); glds16(ak + aoffb[1], sd + 1024); glds16(bk + (boffl + 1024u), sd + 16384 + 1024); }
    asm volatile("s_waitcnt vmcnt(12)" ::: "memory");
    __builtin_amdgcn_s_barrier();
    asm volatile("" ::: "memory");
    i32x8 af[2], bf[4];
    af[0] = S8_FR(lds + saoff);
#pragma unroll
    for (int j = 0; j < 4; ++j) bf[j] = S8_FR(lds + sboff + j * 2048);
    af[1] = S8_FR(lds + saoff + 2048);
#pragma unroll 1
    for (int s = 0; s < nk; ++s) {
        S8_MM(0, 0); S8_MM(0, 1); S8_MM(0, 2); S8_MM(0, 3);
        R_SB();
        asm volatile("s_waitcnt vmcnt(8)" ::: "memory");
        asm volatile("s_waitcnt lgkmcnt(0)" ::: "memory");
        __builtin_amdgcn_s_barrier();
        asm volatile("" ::: "memory");
        const bool ld = s + 4 < nk;
        const char* sn = lds + ((s + 1) & 3) * 32768;
        char* sd = lds + (s & 3) * 32768 + wave * 2048;
        const char* ak = sgpr_ptr(ld ? Abase + (size_t)(s + 4) * astr : Bimg); const char* bk = sgpr_ptr(ld ? Bimg + (size_t)(s + 4) * 16384 : Bimg);
        const char* p0 = ak + (ld ? aoffb[0] : 0u); const char* p1 = bk + (ld ? boffl : 0u); const char* p2 = ak + (ld ? aoffb[1] : 0u); const char* p3 = bk + (ld ? boffl + 1024u : 0u);
        af[0] = S8_FR(sn + saoff); glds16(p0, sd); R_SB();
        S8_MM(1, 0); R_SB();
        bf[0] = S8_FR(sn + sboff); glds16(p1, sd + 16384); R_SB();
        S8_MM(1, 1); R_SB();
        bf[1] = S8_FR(sn + sboff + 2048); glds16(p2, sd + 1024); R_SB();
        S8_MM(1, 2); R_SB();
        bf[2] = S8_FR(sn + sboff + 4096); glds16(p3, sd + 16384 + 1024); R_SB();
        S8_MM(1, 3); R_SB();
        bf[3] = S8_FR(sn + sboff + 6144); af[1] = S8_FR(sn + saoff + 2048); R_SB();
    }
    __syncthreads();
}
__device__ __forceinline__ void s8_accum_ring_h(f32x16 (&acc)[2][2], char* lds, const GemmThread& g, const int wave, const int lane,
                                                const char* Abase, const unsigned (&aoffb)[2], const char* Bimg, const int nk, const unsigned astr) {
    const unsigned boffl = (unsigned)wave * 1024u + (unsigned)lane * 16u;
    const int saoff = (64 * g.wm) * 64, sboff = 16384 + (64 * g.wn) * 64;
#pragma unroll
    for (int s = 0; s < 4; ++s) { char* sd = lds + s * 32768; const char* ak = Abase + (size_t)s * astr; const char* bk = Bimg + (size_t)s * 16384 + boffl;
        glds16(ak + aoffb[0], sd + wave * 2048); glds16(bk, sd + 16384 + wave * 1024); glds16(ak + aoffb[1], sd + wave * 2048 + 1024); }
    asm volatile("s_waitcnt vmcnt(9)" ::: "memory");
    __builtin_amdgcn_s_barrier();
    asm volatile("" ::: "memory");
    i32x8 af[2], bf[2];
    af[0] = S8_FR(lds + saoff); bf[0] = S8_FR(lds + sboff); bf[1] = S8_FR(lds + sboff + 2048); af[1] = S8_FR(lds + saoff + 2048);
#pragma unroll 1
    for (int s = 0; s < nk; ++s) {
        S8_MM(0, 0); S8_MM(0, 1);
        R_SB();
        asm volatile("s_waitcnt vmcnt(6)" ::: "memory");
        asm volatile("s_waitcnt lgkmcnt(0)" ::: "memory");
        __builtin_amdgcn_s_barrier();
        asm volatile("" ::: "memory");
        const bool ld = s + 4 < nk;
        const char* sn = lds + ((s + 1) & 3) * 32768;
        char* sd = lds + (s & 3) * 32768;
        const char* ak = Abase + (size_t)(s + 4) * astr; const char* bk = Bimg + (size_t)(s + 4) * 16384 + boffl;
        const char* p0 = ld ? ak + aoffb[0] : Bimg; const char* p1 = ld ? bk : Bimg; const char* p2 = ld ? ak + aoffb[1] : Bimg;
        af[0] = S8_FR(sn + saoff); glds16(p0, sd + wave * 2048); R_SB();
        S8_MM(1, 0); R_SB();
        bf[0] = S8_FR(sn + sboff); glds16(p1, sd + 16384 + wave * 1024); R_SB();
        S8_MM(1, 1); R_SB();
        bf[1] = S8_FR(sn + sboff + 2048); af[1] = S8_FR(sn + saoff + 2048); glds16(p2, sd + wave * 2048 + 1024); R_SB();
    }
    __syncthreads();
}
#define F8_WRB(sn, j_) do { u32x2 w_; \
        w_[0] = cvt4_fp8(rb[0][j_] * FP8_SW, rb[1][j_] * FP8_SW, rb[2][j_] * FP8_SW, rb[3][j_] * FP8_SW); \
        w_[1] = cvt4_fp8(rb[4][j_] * FP8_SW, rb[5][j_] * FP8_SW, rb[6][j_] * FP8_SW, rb[7][j_] * FP8_SW); \
        *(u32x2*)((sn) + 16384 + bw8_ + (j_) * 64) = w_; } while (0)
template <bool WR, bool LD, bool W8>
__device__ __forceinline__ void f8_w32_step(f32x4 (&acc)[4][8], char* lds, const GemmThread& g, const int wave, f32x4 (&rb)[8], const int kt,
                                            const char* Abase, const unsigned (&aoffb)[2], const char* Bbase, const unsigned boffb, const int ldbB, char* img, const unsigned astr) {
    if (WR) { if (W8) RB_PIN("s_waitcnt vmcnt(10)", rb); else RB_PIN("s_waitcnt vmcnt(0)", rb); }
    else { if (W8) asm volatile("s_waitcnt vmcnt(10)" ::: "memory"); else asm volatile("s_waitcnt vmcnt(0)" ::: "memory"); }
    asm volatile("s_waitcnt lgkmcnt(0)" ::: "memory");
    __builtin_amdgcn_s_barrier();
    asm volatile("" ::: "memory");
    const char* sa = lds + (kt & 1) * 32768 + (64 * g.wm) * 64; const char* sbb = lds + (kt & 1) * 32768 + 16384 + (128 * g.wn) * 64;
    char* sn = lds + ((kt + 1) & 1) * 32768;
    if (WR) { const char* ak = Abase + (size_t)(kt + 1) * astr; glds16(ak + aoffb[0], sn + (2 * wave) * 1024); glds16(ak + aoffb[1], sn + (2 * wave + 1) * 1024); }
    int bw8_ = g.f8w0; asm volatile("" : "+v"(bw8_));
    f8x8 a0[4], b0[8];
    F8_RA(a0, g.f8r0) F8_RB(b0, g.f8r0)
    F8_MMJ(a0, b0, 0); F8_MMJ(a0, b0, 1); F8_MMJ(a0, b0, 2); F8_MMJ(a0, b0, 3);
    if (WR) { F8_WRB(sn, 0); F8_WRB(sn, 1); }
    __builtin_amdgcn_sched_barrier(0);
    F8_MMJ(a0, b0, 4); F8_MMJ(a0, b0, 5); F8_MMJ(a0, b0, 6); F8_MMJ(a0, b0, 7);
    if (WR) { F8_WRB(sn, 2); F8_WRB(sn, 3); }
    if (LD) { const char* bk = Bbase + (size_t)(kt + 3) * 64 * ldbB;
#pragma unroll
        for (int k = 0; k < 8; ++k) rb[k] = ld_nt_async(sgpr_ptr(bk + (size_t)k * ldbB), boffb); }
    {
        int to = (int)threadIdx.x * 16; asm volatile("" : "+v"(to));
        const char* sbi = lds + (kt & 1) * 32768 + 16384; char* imgk = img + (size_t)kt * 16384;
        const u32x4 i0 = *(const u32x4*)(sbi + to), i1 = *(const u32x4*)(sbi + 8192 + to);
        *(u32x4*)(imgk + to) = i0; *(u32x4*)(imgk + 8192 + to) = i1; }
    __builtin_amdgcn_sched_barrier(0);
    F8_RA(a0, g.f8r1) F8_RB(b0, g.f8r1)
    F8_MMJ(a0, b0, 0); F8_MMJ(a0, b0, 1); F8_MMJ(a0, b0, 2); F8_MMJ(a0, b0, 3);
    __builtin_amdgcn_sched_barrier(0);
    F8_MMJ(a0, b0, 4); F8_MMJ(a0, b0, 5); F8_MMJ(a0, b0, 6); F8_MMJ(a0, b0, 7);
}
__device__ __forceinline__ void f8_accum_w32(f32x4 (&acc)[4][8], char* lds, const GemmThread& g, const int wave,
                                             const char* Abase, const unsigned (&aoffb)[2], const char* Bbase, const unsigned boffb, const int ldbB, const int nk, char* img, const unsigned astr = 64) {
    f32x4 rbA[8], rbB[8];
#define F8_LOADB(RB, kt) do { const char* bk_ = Bbase + (size_t)(kt) * 64 * ldbB; \
        _Pragma("unroll") for (int k_ = 0; k_ < 8; ++k_) RB[k_] = ld_nt_async(sgpr_ptr(bk_ + (size_t)k_ * ldbB), boffb); } while (0)
    glds16(Abase + aoffb[0], lds + (2 * wave) * 1024); glds16(Abase + aoffb[1], lds + (2 * wave + 1) * 1024);
    F8_LOADB(rbA, 0);
    RB_PIN("s_waitcnt vmcnt(0)", rbA);
    { f32x4 (&rb)[8] = rbA; char* sn = lds; const int bw8_ = g.f8w0; F8_WRB(sn, 0); F8_WRB(sn, 1); F8_WRB(sn, 2); F8_WRB(sn, 3); }
    F8_LOADB(rbA, 1);
    F8_LOADB(rbB, 2);
    RB_PIN("s_waitcnt vmcnt(8)", rbA);
#pragma unroll 1
    for (int kt = 0; kt < nk - 4; kt += 2) {
        f8_w32_step<true, true, true>(acc, lds, g, wave, rbA, kt, Abase, aoffb, Bbase, boffb, ldbB, img, astr);
        f8_w32_step<true, true, true>(acc, lds, g, wave, rbB, kt + 1, Abase, aoffb, Bbase, boffb, ldbB, img, astr);
    }
    f8_w32_step<true, true, true>(acc, lds, g, wave, rbA, nk - 4, Abase, aoffb, Bbase, boffb, ldbB, img, astr);
    f8_w32_step<true, false, true>(acc, lds, g, wave, rbB, nk - 3, Abase, aoffb, Bbase, boffb, ldbB, img, astr);
    f8_w32_step<true, false, false>(acc, lds, g, wave, rbA, nk - 2, Abase, aoffb, Bbase, boffb, ldbB, img, astr);
    f8_w32_step<false, false, false>(acc, lds, g, wave, rbB, nk - 1, Abase, aoffb, Bbase, boffb, ldbB, img, astr);
    __syncthreads();
#undef F8_LOADB
}

struct EpiLane { int l15, lq, wm, wn; };
__device__ __forceinline__ EpiLane epi_lane(const GemmThread& g) { EpiLane e; e.l15 = g.l15; e.lq = g.lq; e.wm = g.wm; e.wn = g.wn; asm volatile("" : "+v"(e.l15), "+v"(e.lq)); return e; }
constexpr int STG_PITCH = 272, STG_WAVE = 64 * STG_PITCH;
#define stg_base(F) ((F).lds + (F).wave * STG_WAVE)
__device__ __forceinline__ void stg_put(char* tw, const EpiLane& el, int i, int j, u32x2 w) { *(u32x2*)(tw + (16 * i + el.l15) * STG_PITCH + (16 * j + 4 * el.lq) * 2) = w; }
__device__ __forceinline__ void stg_flush_(int lane, char* tw, bf16_t* dst, size_t ld) {
    int ln = lane; asm volatile("" : "+v"(ln));
#pragma unroll 4
    for (int q = 0; q < 16; ++q) { const int rl = q * 4 + (ln >> 4), chunk = ln & 15;
        *(u32x4*)(dst + (size_t)rl * ld + chunk * 8) = *(const u32x4*)(tw + rl * STG_PITCH + chunk * 16); }
    __syncthreads();
}
#define stg_flush(F, tw, dst, ld) stg_flush_((F).lane, tw, dst, ld)
__device__ __forceinline__ void acc_zero(f32x4 (&acc)[4][8]) {
#pragma unroll
    for (int i = 0; i < 4; ++i)
#pragma unroll
        for (int j = 0; j < 8; ++j) acc[i][j] = (f32x4){0.f, 0.f, 0.f, 0.f};
}
__device__ __forceinline__ bool patch_unit(int u, int nMt, int nNt, int& mt, int& nt) {
    const int pM = nMt / 8, p = u >> 5, q = u & 31;
    mt = (p % pM) * 8 + (q & 7); nt = (p / pM) * 4 + (q >> 3);
    return nt < nNt;
}
__device__ __forceinline__ int vcu_of_block(int bx, int G) { return (G % 8 == 0) ? (bx % 8) * (G / 8) + bx / 8 : bx; }

namespace attn {
constexpr int D = 128, NW = 8, QBLK = 32, KVBLK = 64;
constexpr float SCALE = 0.088388347648318440f;
constexpr float THR = 8.f;
constexpr int LDQ = AW, LDK = KVW, LDO = DM;
constexpr size_t SHM_V = KVBLK * D * 2, SHM_K = KVBLK * D * 2, SHM_ATTN = 2 * SHM_V + 2 * SHM_K + NW * 64 * 4;
#define KSWZ(row, colB) ((row) * 256 + ((colB) ^ (((row) & 7) << 4)))
#define SBAR() __builtin_amdgcn_sched_barrier(0)
__device__ __forceinline__ int crow(int r, int hi) { return (r & 3) + 8 * (r >> 2) + 4 * hi; }
__device__ __forceinline__ unsigned cvtpk(float lo, float hi) { return cvt_pk_bf16(lo, hi); }

__device__ __forceinline__ void partialSM(f32x16& p0, f32x16& p1, float& m_reg, float& mn, float& alpha) {
  constexpr float C = SCALE * 1.4426950408889634f;
  float pmax = p0[0]; for (int r = 1; r < 16; ++r) pmax = fmaxf(pmax, p0[r]); for (int r = 0; r < 16; ++r) pmax = fmaxf(pmax, p1[r]);
  { auto rr = __builtin_amdgcn_permlane32_swap(__float_as_uint(pmax), __float_as_uint(pmax), false, false);
    pmax = fmaxf(__uint_as_float(rr[0]), __uint_as_float(rr[1])); }
  if (__builtin_expect(__all(pmax - m_reg <= THR / SCALE), 1)) { mn = m_reg; alpha = 1.f; }
  else { mn = fmaxf(m_reg, pmax); alpha = __builtin_amdgcn_exp2f((m_reg - mn) * C); m_reg = mn; }
  float mnC = -mn * C;
  for (int r = 0; r < 16; ++r) p0[r] = fmaf(p0[r], C, mnC); for (int r = 0; r < 16; ++r) p1[r] = fmaf(p1[r], C, mnC);
  for (int r = 0; r < 16; ++r) p0[r] = __builtin_amdgcn_exp2f(p0[r]);
}
__device__ __forceinline__ void finishSM(f32x16& p0, f32x16& p1, float alpha, float& l_reg, bf16x8& pa0, bf16x8& pa1, bf16x8& pa2, bf16x8& pa3) {
  for (int r = 0; r < 16; ++r) p1[r] = __builtin_amdgcn_exp2f(p1[r]);
  float ps = 0; for (int r = 0; r < 16; ++r) ps += p0[r]; for (int r = 0; r < 16; ++r) ps += p1[r];
  { auto rr = __builtin_amdgcn_permlane32_swap(__float_as_uint(ps), __float_as_uint(ps), false, false);
    ps = __uint_as_float(rr[0]) + __uint_as_float(rr[1]); }
  l_reg = l_reg * alpha + ps;
#define PK4(P, BASE, OUT) do { unsigned a0 = cvtpk(P[BASE + 0], P[BASE + 1]), a1 = cvtpk(P[BASE + 2], P[BASE + 3]);   \
    unsigned b0 = cvtpk(P[BASE + 4], P[BASE + 5]), b1 = cvtpk(P[BASE + 6], P[BASE + 7]);                              \
    auto r0 = __builtin_amdgcn_permlane32_swap(a0, b0, false, false); auto r1 = __builtin_amdgcn_permlane32_swap(a1, b1, false, false); \
    u32x4 w = {r0[0], r1[0], r0[1], r1[1]}; OUT = *reinterpret_cast<bf16x8*>(&w); } while (0)
  PK4(p0, 0, pa0); PK4(p0, 8, pa1); PK4(p1, 0, pa2); PK4(p1, 8, pa3);
#undef PK4
}
__device__ __forceinline__ void qkt(f32x16& p0, f32x16& p1, const bf16_t* Ks, const bf16x8* qr, int r32, int hi) {
  p0 = f32x16{}; p1 = f32x16{};
  for (int d0 = 0; d0 < 8; ++d0) { int cb = (d0 * 16 + hi * 8) * 2;
    bf16x8 b0 = *reinterpret_cast<const bf16x8*>((const char*)Ks + KSWZ(r32, cb));
    bf16x8 b1 = *reinterpret_cast<const bf16x8*>((const char*)Ks + KSWZ(32 + r32, cb));
    p0 = __builtin_amdgcn_mfma_f32_32x32x16_bf16(b0, qr[d0], p0, 0, 0, 0);
    p1 = __builtin_amdgcn_mfma_f32_32x32x16_bf16(b1, qr[d0], p1, 0, 0, 0); }
}
__device__ __forceinline__ int v_st(int k, int c) { const int kk = (k & ~0xC) | ((k & 4) << 1) | ((k & 8) >> 1); return ((kk >> 3) * 4 + (c >> 5)) * 512 + ((kk & 7) * 32 + (c & 31)) * 2; }
__device__ __forceinline__ int v_rd_base(int lane) { return ((lane & 3) << 3) | (((lane >> 2) & 3) << 6) | (((lane >> 4) & 1) << 5) | (((lane >> 5) & 1) << 8); }
constexpr int v_rd_off(int d0, int ks, int half) { return d0 * 512 + ks * 4096 + half * 2048; }
template <int OFF> __device__ __forceinline__ s16x4 tr_read(int vb) {
  s16x4 r; asm volatile("ds_read_b64_tr_b16 %0, %1 offset:%2" : "=&v"(r) : "v"(vb), "i"(OFF) : "memory"); return r;
}
template <int D0> __device__ __forceinline__ void pv_one(f32x16& od, int vb, bf16x8 pa0, bf16x8 pa1, bf16x8 pa2, bf16x8 pa3) {
  const s16x4 l0 = tr_read<v_rd_off(D0, 0, 0)>(vb), h0 = tr_read<v_rd_off(D0, 0, 1)>(vb), l1 = tr_read<v_rd_off(D0, 1, 0)>(vb), h1 = tr_read<v_rd_off(D0, 1, 1)>(vb);
  const s16x4 l2 = tr_read<v_rd_off(D0, 2, 0)>(vb), h2 = tr_read<v_rd_off(D0, 2, 1)>(vb), l3 = tr_read<v_rd_off(D0, 3, 0)>(vb), h3 = tr_read<v_rd_off(D0, 3, 1)>(vb);
  asm volatile("s_waitcnt lgkmcnt(0)" ::: "memory"); SBAR();
#define PK(L, H) (bf16x8){L[0], L[1], L[2], L[3], H[0], H[1], H[2], H[3]}
  od = __builtin_amdgcn_mfma_f32_32x32x16_bf16(pa0, PK(l0, h0), od, 0, 0, 0);
  od = __builtin_amdgcn_mfma_f32_32x32x16_bf16(pa1, PK(l1, h1), od, 0, 0, 0);
  od = __builtin_amdgcn_mfma_f32_32x32x16_bf16(pa2, PK(l2, h2), od, 0, 0, 0);
  od = __builtin_amdgcn_mfma_f32_32x32x16_bf16(pa3, PK(l3, h3), od, 0, 0, 0);
#undef PK
}
__device__ __forceinline__ void pv_d0(f32x16* o, int vb, bf16x8 pa0, bf16x8 pa1, bf16x8 pa2, bf16x8 pa3) {
  pv_one<0>(o[0], vb, pa0, pa1, pa2, pa3); pv_one<1>(o[1], vb, pa0, pa1, pa2, pa3); pv_one<2>(o[2], vb, pa0, pa1, pa2, pa3); pv_one<3>(o[3], vb, pa0, pa1, pa2, pa3);
}
__device__ __forceinline__ void attn_dense_body(const bf16_t* __restrict__ Qb, const bf16_t* __restrict__ Kh, const bf16_t* __restrict__ Vh, bf16_t* __restrict__ Ob, int seq, char* lds) {
  const int tid = threadIdx.x, wid = tid >> 6, lane = tid & 63, r32 = lane & 31, hi = lane >> 5;
  bf16_t* V_lds = (bf16_t*)lds; bf16_t* K_lds = (bf16_t*)(lds + 2 * SHM_V);
  float* ws = (float*)(lds + 2 * SHM_V + 2 * SHM_K) + wid * 64; float* li_l = ws; float* al_l = ws + 32;
  float m_reg = -1e30f, l_reg = 0; f32x16 o[4] = {}; bf16x8 qr[8];
  const bf16_t* Qw = Qb + (long)(wid * QBLK + r32) * LDQ + hi * 8;
#pragma unroll
  for (int d0 = 0; d0 < 8; ++d0) qr[d0] = *reinterpret_cast<const bf16x8*>(Qw + d0 * 16);
  const int sr = tid >> 4, sc = (tid & 15) * 8, vst0 = v_st(sr, sc), vst1 = v_st(32 + sr, sc);
  const int vb0 = (int)(uintptr_t)V_lds + v_rd_base(lane);
  struct { bf16x8 vs0, vs1, ks0, ks1; } sr_[2];
#define LD8(p) (*reinterpret_cast<const bf16x8*>(p))
#define SLOAD(i, k0) do { sr_[i].vs0 = LD8(&Vh[(long)((k0) + sr) * LDK + sc]); sr_[i].vs1 = LD8(&Vh[(long)((k0) + 32 + sr) * LDK + sc]); \
    sr_[i].ks0 = LD8(&Kh[(long)((k0) + sr) * LDK + sc]); sr_[i].ks1 = LD8(&Kh[(long)((k0) + 32 + sr) * LDK + sc]); } while (0)
#define SWRITE(b, i) do { *(bf16x8*)((char*)V_lds + (b) * SHM_V + vst0) = sr_[i].vs0;          \
    *(bf16x8*)((char*)V_lds + (b) * SHM_V + vst1) = sr_[i].vs1; int kc = sc * 2;               \
    *(bf16x8*)((char*)K_lds + (b) * SHM_K + KSWZ(sr, kc)) = sr_[i].ks0;                       \
    *(bf16x8*)((char*)K_lds + (b) * SHM_K + KSWZ(32 + sr, kc)) = sr_[i].ks1; } while (0)
#define SWAIT() do { asm volatile("s_waitcnt vmcnt(4)" ::: "memory"); } while (0)
#define RESC(a) do { if (__any((a) < 1.f)) { if (hi == 0) al_l[r32] = (a); asm volatile("s_waitcnt lgkmcnt(0)" ::: "memory"); \
    for (int d = 0; d < 4; ++d) for (int r = 0; r < 16; ++r) o[d][r] *= al_l[crow(r, hi)]; } } while (0)
  f32x16 pA0, pA1, pB0, pB1; float mnA, mnB, alA, alB; bf16x8 pa0, pa1, pa2, pa3; const int NT = seq / KVBLK;
  constexpr int SE = 0, SO = 1;
  SLOAD(SE, 0); asm volatile("s_waitcnt vmcnt(0)" ::: "memory"); SWRITE(0, SE); __syncthreads();
  qkt(pA0, pA1, K_lds, qr, r32, hi); partialSM(pA0, pA1, m_reg, mnA, alA);
  SLOAD(SO, KVBLK); if (2 < NT) SLOAD(SE, 2 * KVBLK);
  SWAIT(); SWRITE(1, SO); __syncthreads();
  for (int j = 1; j + 1 < NT; j += 2) {
    SBAR(); qkt(pB0, pB1, (bf16_t*)((char*)K_lds + SHM_K), qr, r32, hi);
    finishSM(pA0, pA1, alA, l_reg, pa0, pa1, pa2, pa3); SBAR();
    SLOAD(SO, (j + 2) * KVBLK); SBAR();
    pv_d0(o, vb0, pa0, pa1, pa2, pa3); partialSM(pB0, pB1, m_reg, mnB, alB);
    __syncthreads(); SWAIT(); SWRITE(0, SE);
    RESC(alB); __syncthreads();
    SBAR(); qkt(pA0, pA1, K_lds, qr, r32, hi);
    finishSM(pB0, pB1, alB, l_reg, pa0, pa1, pa2, pa3); SBAR();
    if (j + 3 < NT) SLOAD(SE, (j + 3) * KVBLK); SBAR();
    pv_d0(o, vb0 + (int)SHM_V, pa0, pa1, pa2, pa3); partialSM(pA0, pA1, m_reg, mnA, alA);
    __syncthreads(); SWAIT(); SWRITE(1, SO);
    RESC(alA); __syncthreads();
  }
  SBAR(); qkt(pB0, pB1, (bf16_t*)((char*)K_lds + SHM_K), qr, r32, hi);
  finishSM(pA0, pA1, alA, l_reg, pa0, pa1, pa2, pa3); SBAR();
  pv_d0(o, vb0, pa0, pa1, pa2, pa3); partialSM(pB0, pB1, m_reg, mnB, alB);
  __syncthreads(); RESC(alB);
  finishSM(pB0, pB1, alB, l_reg, pa0, pa1, pa2, pa3); SBAR();
  pv_d0(o, vb0 + (int)SHM_V, pa0, pa1, pa2, pa3);
  if (hi == 0) li_l[r32] = l_reg; asm volatile("s_waitcnt lgkmcnt(0)" ::: "memory");
  float rli[16];
#pragma unroll
  for (int r = 0; r < 16; ++r) rli[r] = __builtin_amdgcn_rcpf(li_l[crow(r, hi)]);
  bf16_t* Ow = Ob + (long)(wid * QBLK) * LDO;
#pragma unroll
  for (int r = 0; r < 16; ++r) { int orow = crow(r, hi);
    for (int d0 = 0; d0 < 4; ++d0) Ow[(long)orow * LDO + d0 * 32 + r32] = f2bf(o[d0][r] * rli[r]); }
#undef LD8
#undef SLOAD
#undef SWRITE
#undef SWAIT
#undef RESC
}
}

struct Frame {
    char* lds;
    const Args* a;
    int tid, lane, wave, G, bx;
    int xl, rk;
};
template <class T> __device__ __forceinline__ T* uni(T* p) {
    const unsigned long long v = (unsigned long long)p;
    const unsigned lo = __builtin_amdgcn_readfirstlane((unsigned)v), hi = __builtin_amdgcn_readfirstlane((unsigned)(v >> 32));
    typedef __attribute__((address_space(1))) T* gptr_t;
    return (T*)(gptr_t)(((unsigned long long)hi << 32) | lo);
}
#define WSB() (uni(F.a->ws))
#define WSP(T, off) ((T*)(WSB() + (off)))
#define INP(i) (uni(F.a->in[i]))

__device__ __forceinline__ float mod_at(const Frame& F, int idx) { const float* mp = WSP(const float, WS_MODP); return mp[idx] + mp[4 * 12288 + idx]; }

__device__ __forceinline__ void build_cs(const Frame& F, int idx0, int idx1, int step) {
    bf16_t* cm = WSP(bf16_t, WS_CMAT);
    for (int idx = idx0; idx < idx1; idx += step) {
        const int mat = idx >> 19, s = (idx >> 8) & 2047, t0 = (idx & 255) * 8;
        float v[8];
#pragma unroll
        for (int e = 0; e < 8; ++e) { const float fr = (float)((s * (t0 + e)) & 2047) * (1.f / 2048.f);
            v[e] = mat ? -__builtin_amdgcn_sinf(fr) : __builtin_amdgcn_cosf(fr); }
        u32x4 w = {cvt_pk_bf16(v[0], v[1]), cvt_pk_bf16(v[2], v[3]), cvt_pk_bf16(v[4], v[5]), cvt_pk_bf16(v[6], v[7])};
        *(u32x4*)(cm + (size_t)s * 4096 + mat * 2048 + t0) = w;
    }
}
__device__ __forceinline__ void build_wimg(const Frame& F, const GemmThread& g, int t0, int t1, int step) {
    const float* w_in = INP(5); const float* w_out = INP(11);
    for (int t = t0; t < t1; t += step) {
        const float* srcp; char* dst; const int kt = t & 31, nt = t >> 5;
        if (nt < 10) { srcp = w_in + (size_t)(kt * 64 + 8 * g.kg) * INW + 512 + nt * 256 + 4 * g.ng; dst = (char*)(WSB() + WS_IMGIN) + (size_t)((nt + 4) * 32 + kt) * 32768; }
        else { srcp = w_out + (size_t)(kt * 64 + 8 * g.kg) * DM + (nt - 10) * 256 + 4 * g.ng; dst = (char*)(WSB() + WS_IMGOUT) + (size_t)((nt - 10) * 32 + kt) * 32768; }
        const size_t ld = nt < 10 ? INW : DM;
        f32x4 rb[8];
#pragma unroll
        for (int k = 0; k < 8; ++k) rb[k] = *(const f32x4*)(srcp + (size_t)k * ld);
#pragma unroll
        for (int j = 0; j < 4; ++j) { u32x4 w;
            w[0] = cvt_pk_bf16(rb[0][j], rb[1][j]); w[1] = cvt_pk_bf16(rb[2][j], rb[3][j]); w[2] = cvt_pk_bf16(rb[4][j], rb[5][j]); w[3] = cvt_pk_bf16(rb[6][j], rb[7][j]);
            *(u32x4*)(dst + g.imgw0 + j * 64) = w; }
    }
}
__device__ __forceinline__ void p0_prologue(const Frame& F) {
    const int tid = F.tid;
    const float* c = INP(1); const float* w_ada = INP(2); const float* b_ada = INP(3); const float* wf = INP(6);
    float* modp = WSP(float, WS_MODP);
    for (int item = F.bx; item < 256; item += F.G) {
        const int half = item & 1, cg = item >> 1;
        float* sc = (float*)F.lds;
        float* red = (float*)(F.lds + 16384);
        __syncthreads();
        for (int i = tid; i < 4096; i += NTHREADS) { const int b = i >> 10, k = i & 1023; const float cv = c[b * DM + half * 1024 + k]; sc[i] = cv / (1.f + __expf(-cv)); }
        __syncthreads();
        const int cq = tid % 24, kg = tid / 24;
        f32x4 am[4]; for (int b = 0; b < 4; ++b) am[b] = (f32x4){0.f, 0.f, 0.f, 0.f};
        if (kg < 21) {
            const float* wp = w_ada + (size_t)(half * 1024) * (NMOD * DM) + cg * 96 + cq * 4;
#pragma unroll 7
            for (int k = kg; k < 1024; k += 21) {
                const f32x4 w = *(const f32x4*)(wp + (size_t)k * (NMOD * DM));
#pragma unroll
                for (int b = 0; b < 4; ++b) am[b] += sc[b * 1024 + k] * w;
            }
#pragma unroll
            for (int b = 0; b < 4; ++b) *(f32x4*)(red + ((kg * 4 + b) * 96 + cq * 4)) = am[b];
        }
        __syncthreads();
        if (tid < 384) { const int b = tid / 96, col = tid % 96; float s = 0.f;
            for (int k2 = 0; k2 < 21; ++k2) s += red[(k2 * 4 + b) * 96 + col];
            if (half == 0) s += b_ada[cg * 96 + col];
            modp[(half * 4 + b) * 12288 + cg * 96 + col] = s; }
    }
    __syncthreads();
    {
        float* tc = (float*)F.lds; float* ts = tc + 128;
        if (tid < 128) { tc[tid] = cospif((float)tid / 64.f); ts[tid] = sinpif((float)tid / 64.f); }
        __syncthreads();
        float* g12 = WSP(float, WS_G12);
        const int lane = tid & 63, l15 = lane & 15, lq = lane >> 4;
        for (int item = F.bx * 8 + F.wave; item < 512; item += F.G * 8) {
            const int gp = item >> 6, g = gp >> 1, part = gp & 1, mt = (item >> 3) & 7, nt = item & 7;
            const float* tb = part ? ts : tc; const float* wp = wf + (size_t)g * 128 * 128 + nt * 16 + l15 + (size_t)(8 * lq) * 128;
            const int cc = mt * 16 + l15;
            f32x4 dacc = {0.f, 0.f, 0.f, 0.f};
            float wv[4][8];
#pragma unroll
            for (int ks = 0; ks < 4; ++ks)
#pragma unroll
                for (int q = 0; q < 8; ++q) wv[ks][q] = wp[(size_t)(ks * 32 + q) * 128];
#pragma unroll
            for (int ks = 0; ks < 4; ++ks) {
                u32x4 th, tl, wh, wl;
#pragma unroll
                for (int q = 0; q < 4; ++q) {
                    const int c2 = ks * 32 + 8 * lq + 2 * q;
                    const float t0 = tb[(cc * c2) & 127], t1 = tb[(cc * (c2 + 1)) & 127];
                    th[q] = cvt_pk_bf16(t0, t1); tl[q] = cvt_pk_bf16(t0 - bflo(th[q]), t1 - bfhi(th[q]));
                    wh[q] = cvt_pk_bf16(wv[ks][2 * q], wv[ks][2 * q + 1]); wl[q] = cvt_pk_bf16(wv[ks][2 * q] - bflo(wh[q]), wv[ks][2 * q + 1] - bfhi(wh[q]));
                }
                const bf16x8 ah = __builtin_bit_cast(bf16x8, th), al = __builtin_bit_cast(bf16x8, tl), bh = __builtin_bit_cast(bf16x8, wh), bl = __builtin_bit_cast(bf16x8, wl);
                dacc = __builtin_amdgcn_mfma_f32_16x16x32_bf16(ah, bh, dacc, 0, 0, 0);
                dacc = __builtin_amdgcn_mfma_f32_16x16x32_bf16(ah, bl, dacc, 0, 0, 0);
                dacc = __builtin_amdgcn_mfma_f32_16x16x32_bf16(al, bh, dacc, 0, 0, 0);
            }
#pragma unroll
            for (int r = 0; r < 4; ++r) g12[((size_t)g * 128 + mt * 16 + 4 * lq + r) * 256 + part * 128 + nt * 16 + l15] = dacc[r] * (1.f / 512.f);
        }
        __syncthreads();
    }
    {
        const GemmThread g = gemm_thread_init();
        if (F.G != 256) { build_cs(F, F.bx * NTHREADS + tid, 2 * 2048 * 256, F.G * NTHREADS); build_wimg(F, g, F.bx, (10 + 8) * 32, F.G); }
        else build_wimg(F, g, F.bx, 10 * 32, F.G);
    }
    {
        f32x2* rp = WSP(f32x2, WS_ROPE);
        for (int idx = F.bx * NTHREADS + tid; idx < 2048 * 64; idx += F.G * NTHREADS) {
            const int s = idx >> 6, p = idx & 63, i = p & 31; const float pos = (float)(p < 32 ? (s >> 6) : (s & 63));
            const float inv = 1.0f / powf(10000.f, (float)(2 * i) / 64.f);
            float sn, cs; sincosf(pos * inv, &sn, &cs);
            rp[idx] = (f32x2){cs, sn};
        }
    }
}

__device__ __forceinline__ void p1_norm(const Frame& F) {
    const int tid = F.tid, lane = F.lane, wave = F.wave;
    const float* x = INP(0); const float* gpm = INP(4); const float* w_in = INP(5);
    bf16_t* h = WSP(bf16_t, WS_H);
    float* av = (float*)F.lds; float* sv = av + DM;
    for (int grp = F.bx; grp < NTOK / 32; grp += F.G) {
        const int row0 = grp * 32, b = row0 / SEQ;
        f32x4 xv[4][8];
#pragma unroll
        for (int rr = 0; rr < 4; ++rr) { const float* xr = x + (size_t)(row0 + wave * 4 + rr) * DM;
#pragma unroll
            for (int i = 0; i < 8; ++i) xv[rr][i] = *(const f32x4*)(xr + i * 256 + lane * 4); }
        __syncthreads();
        for (int k = tid; k < DM; k += NTHREADS) { av[k] = gpm[k] * (1.f + mod_at(F, b * 12288 + DM + k)); sv[k] = mod_at(F, b * 12288 + k); }
        __syncthreads();
#pragma unroll
        for (int rr = 0; rr < 4; ++rr) {
            const int row = row0 + wave * 4 + rr; float ss = 0.f;
#pragma unroll
            for (int i = 0; i < 8; ++i) ss += xv[rr][i][0] * xv[rr][i][0] + xv[rr][i][1] * xv[rr][i][1] + xv[rr][i][2] * xv[rr][i][2] + xv[rr][i][3] * xv[rr][i][3];
            ss = wave_sum(ss); const float rstd = rsqrtf(ss * (1.f / DM) + EPS);
#pragma unroll
            for (int i = 0; i < 8; ++i) { const int k = i * 256 + lane * 4; const f32x4 a4 = *(const f32x4*)(av + k), s4 = *(const f32x4*)(sv + k);
                u32x2 w = {cvt_pk_bf16(xv[rr][i][0] * rstd * a4[0] + s4[0], xv[rr][i][1] * rstd * a4[1] + s4[1]), cvt_pk_bf16(xv[rr][i][2] * rstd * a4[2] + s4[2], xv[rr][i][3] * rstd * a4[3] + s4[3])};
                *(u32x2*)(h + (size_t)row * DM + k) = w; }
        }
    }
    const float* g12 = WSP(const float, WS_G12);
    for (int item = F.bx * 8 + wave; item < 2048; item += F.G * 8) {
        const int ntile = item & 63, mgrp = item >> 6, l15 = lane & 15, lq = lane >> 4;
        const int n = ntile * 16 + l15, half = n >> 9, g = (n >> 7) & 3, j = n & 127;
        const float* gp = g12 + (size_t)g * 128 * 256 + half * 128 + j + (size_t)(8 * lq) * 256;
        bf16x8 yh[4], yl[4];
#pragma unroll
        for (int ks = 0; ks < 4; ++ks) {
            float v[8];
#pragma unroll
            for (int q = 0; q < 8; ++q) v[q] = gp[(size_t)(ks * 32 + q) * 256];
            u32x4 h, l;
#pragma unroll
            for (int q = 0; q < 4; ++q) { h[q] = cvt_pk_bf16(v[2 * q], v[2 * q + 1]); l[q] = cvt_pk_bf16(v[2 * q] - bflo(h[q]), v[2 * q + 1] - bfhi(h[q])); }
            yh[ks] = __builtin_bit_cast(bf16x8, h); yl[ks] = __builtin_bit_cast(bf16x8, l);
        }
        f32x4 xva[4][4][2];
#pragma unroll
        for (int mi = 0; mi < 4; ++mi) { const float* wp = w_in + (size_t)((mgrp * 4 + mi) * 16 + l15) * INW + g * 128 + 8 * lq;
#pragma unroll
            for (int ks = 0; ks < 4; ++ks) { xva[mi][ks][0] = *(const f32x4*)(wp + ks * 32); xva[mi][ks][1] = *(const f32x4*)(wp + ks * 32 + 4); } }
#pragma unroll
        for (int mi = 0; mi < 4; ++mi) {
            const int m0 = (mgrp * 4 + mi) * 16;
            f32x4 (&xv)[4][2] = xva[mi];
            f32x4 d = {0.f, 0.f, 0.f, 0.f};
#pragma unroll
            for (int ks = 0; ks < 4; ++ks) {
                u32x4 h, l;
#pragma unroll
                for (int q = 0; q < 2; ++q) {
                    h[2 * q] = cvt_pk_bf16(xv[ks][q][0], xv[ks][q][1]); h[2 * q + 1] = cvt_pk_bf16(xv[ks][q][2], xv[ks][q][3]);
                    l[2 * q] = cvt_pk_bf16(xv[ks][q][0] - bflo(h[2 * q]), xv[ks][q][1] - bfhi(h[2 * q])); l[2 * q + 1] = cvt_pk_bf16(xv[ks][q][2] - bflo(h[2 * q + 1]), xv[ks][q][3] - bfhi(h[2 * q + 1]));
                }
                const bf16x8 xh = __builtin_bit_cast(bf16x8, h), xl = __builtin_bit_cast(bf16x8, l);
                d = __builtin_amdgcn_mfma_f32_16x16x32_bf16(xh, yh[ks], d, 0, 0, 0);
                d = __builtin_amdgcn_mfma_f32_16x16x32_bf16(xh, yl[ks], d, 0, 0, 0);
                d = __builtin_amdgcn_mfma_f32_16x16x32_bf16(xl, yh[ks], d, 0, 0, 0);
            }
            const int k = m0 + 4 * lq, nt = n >> 8, brow = n & 255, kt = k >> 6, chunk = (k & 63) >> 3;
            u32x2 w = {cvt_pk_bf16(d[0], d[1]), cvt_pk_bf16(d[2], d[3])};
            *(u32x2*)((char*)(WSB() + WS_IMGIN) + (size_t)(nt * 32 + kt) * 32768 + (chunk >> 2) * 16384 + brow * 64 + ((((brow >> 2) & 3) ^ sw4(chunk & 3)) << 4) + (k & 4) * 2) = w;
        }
    }
}

__device__ __forceinline__ void p2_inproj(const Frame& F) {
    const GemmThread g = gemm_thread_init();
    const bf16_t* h = WSP(const bf16_t, WS_H);
    const float* qg = INP(7); const float* kgn = INP(8);
    const f32x2* rope = WSP(const f32x2, WS_ROPE);
    const int vcu = (F.G & 7) ? F.bx : F.xl * (F.G >> 3) + F.rk;
    for (int u = vcu; u < 512; u += F.G) {
        int mt, nt;
        if (!patch_unit(u, 32, 14, mt, nt)) {
            if (F.G == 256) { const int idle = ((u >> 5) - 12) * 16 + ((u & 31) - 16);
                int to = F.tid; asm volatile("" : "+v"(to));
                build_cs(F, idle * 16384 + to, (idle + 1) * 16384, NTHREADS);
                const GemmThread g2 = gemm_thread_init<true>();
                build_wimg(F, g2, 10 * 32 + idle * 4, 10 * 32 + idle * 4 + 4, 1); }
            continue; }
        f32x4 acc[4][8]; acc_zero(acc);
        unsigned aoff[2];
#pragma unroll
        for (int i = 0; i < 2; ++i) aoff[i] = (unsigned)(g.rrow0 + 16 * i) * (DM * 2u) + g.rchunk;
        const char* ab = (const char*)(h + (size_t)mt * 256 * DM);
        gemm_accum_ring(acc, F.lds, g, F.wave, F.lane, ab, aoff, (const char*)(WSB() + WS_IMGIN) + (size_t)(nt * 32) * 32768, DM / 64);
        const EpiLane el = epi_lane(g);
        if (nt < 4) {
            char* img = (char*)(WSB() + WS_IMGZ) + (size_t)((((mt >> 3) * 2 + (nt & 1)) * 64) + (nt >> 1) * 32 + (mt & 7) * 4 + el.wm) * 32768;
            char* tw = F.lds + F.wave * 16384;
#pragma unroll
            for (int i = 0; i < 4; ++i)
#pragma unroll
                for (int j = 0; j < 8; ++j)
#pragma unroll
                    for (int r = 0; r < 4; ++r) *(bf16_t*)(tw + (16 * j + 4 * el.lq + r) * 128 + (16 * i + el.l15) * 2) = f2bf(acc[i][j][r]);
            int ln = F.lane; asm volatile("" : "+v"(ln));
#pragma unroll
            for (int q = 0; q < 16; ++q) { const int idx = q * 64 + ln, nl = idx >> 3, chunk = idx & 7, n = 128 * el.wn + nl;
                const u32x4 v = *(const u32x4*)(tw + nl * 128 + chunk * 16);
                *(u32x4*)(img + (chunk >> 2) * 16384 + n * 64 + ((((n >> 2) & 3) ^ sw4(chunk & 3)) << 4)) = v; }
            __syncthreads();
        } else if (nt < 12) {
            const bool isq = nt < 10;
            const int head = isq ? (nt - 4) * 2 + el.wn : (nt - 10) * 2 + el.wn;
            const float* gn = isq ? qg : kgn;
            bf16_t* dstb = isq ? WSP(bf16_t, WS_Q) : WSP(bf16_t, WS_K); const int ldo = isq ? AW : KVW;
            char* twq = stg_base(F);
            float rstd[4];
#pragma unroll
            for (int i = 0; i < 4; ++i) {
                float ss = 0.f;
#pragma unroll
                for (int j = 0; j < 8; ++j) ss += acc[i][j][0] * acc[i][j][0] + acc[i][j][1] * acc[i][j][1] + acc[i][j][2] * acc[i][j][2] + acc[i][j][3] * acc[i][j][3];
                ss += __shfl_xor(ss, 16, 64); ss += __shfl_xor(ss, 32, 64);
                rstd[i] = rsqrtf(ss * (1.f / 128.f) + EPS);
            }
#pragma unroll
            for (int jb = 0; jb < 8; jb += 2) {
                f32x4 gvv[2], csv[2][4];
#pragma unroll
                for (int jj = 0; jj < 2; ++jj) { const int d = 16 * (jb + jj) + 4 * el.lq;
                    gvv[jj] = *(const f32x4*)(gn + d);
#pragma unroll
                    for (int i = 0; i < 4; ++i) { const int t = mt * 256 + 64 * el.wm + 16 * i + el.l15, sq = t & (SEQ - 1);
                        csv[jj][i] = *(const f32x4*)(rope + (size_t)sq * 64 + (d >> 1)); } }
#pragma unroll
                for (int jj = 0; jj < 2; ++jj) { const int j = jb + jj, d = 16 * j + 4 * el.lq;
                    const f32x4 gv = gvv[jj];
#pragma unroll
                    for (int i = 0; i < 4; ++i) {
                        const int t = mt * 256 + 64 * el.wm + 16 * i + el.l15; const f32x4 cs = csv[jj][i];
                        const float x0 = acc[i][j][0] * rstd[i] * gv[0], x1 = acc[i][j][1] * rstd[i] * gv[1];
                        const float x2 = acc[i][j][2] * rstd[i] * gv[2], x3 = acc[i][j][3] * rstd[i] * gv[3];
                        u32x2 w = {cvt_pk_bf16(x0 * cs[0] - x1 * cs[1], x0 * cs[1] + x1 * cs[0]), cvt_pk_bf16(x2 * cs[2] - x3 * cs[3], x2 * cs[3] + x3 * cs[2])};
                        stg_put(twq, el, i, j, w);
                    }
                }
            }
            stg_flush(F, twq, dstb + (size_t)(mt * 256 + 64 * el.wm) * ldo + head * 128, ldo);
        } else {
            bf16_t* vb = WSP(bf16_t, WS_V);
            char* tw = stg_base(F);
#pragma unroll
            for (int i = 0; i < 4; ++i)
#pragma unroll
                for (int j = 0; j < 8; ++j) stg_put(tw, el, i, j, (u32x2){cvt_pk_bf16(acc[i][j][0], acc[i][j][1]), cvt_pk_bf16(acc[i][j][2], acc[i][j][3])});
            stg_flush(F, tw, vb + (size_t)(mt * 256 + 64 * el.wm) * KVW + (nt - 12) * 256 + 128 * el.wn, KVW);
        }
    }
}

__device__ __forceinline__ void p3_dft_unit(const Frame& F, const GemmThread& g, int du) {
    const int mt = du & 7, nt = du >> 3, b = nt >> 1, g0 = (nt & 1) * 2;
    const bf16_t* cs = WSP(const bf16_t, WS_CMAT);
    f32x4 acc[4][8]; acc_zero(acc);
    unsigned aoff[2];
#pragma unroll
    for (int i = 0; i < 2; ++i) aoff[i] = (unsigned)(g.rrow0 + 16 * i) * 8192u + g.rchunk;
    gemm_accum_ring(acc, F.lds, g, F.wave, F.lane, (const char*)(cs + (size_t)mt * 256 * 4096), aoff, (const char*)(WSB() + WS_IMGZ) + (size_t)(nt * 64) * 32768, 64);
    bf16_t* mrg = WSP(bf16_t, WS_MRG);
    const EpiLane el = epi_lane(g);
    char* tw = stg_base(F);
#pragma unroll
    for (int i = 0; i < 4; ++i)
#pragma unroll
        for (int j = 0; j < 8; ++j) stg_put(tw, el, i, j, (u32x2){cvt_pk_bf16(acc[i][j][0], acc[i][j][1]), cvt_pk_bf16(acc[i][j][2], acc[i][j][3])});
    stg_flush(F, tw, mrg + (size_t)(b * SEQ + mt * 256 + 64 * el.wm) * DM + g0 * 128 + 128 * el.wn, DM);
}
__device__ __forceinline__ void p3_attn_unit(const Frame& F, int kvh  , int sub  ) {
    const int b = kvh >> 2, kv = kvh & 3, hq = kv * 3 + sub / 8, qb = sub % 8;
    const bf16_t* q = WSP(const bf16_t, WS_Q) + (size_t)(b * SEQ + qb * 256) * AW + hq * 128;
    const bf16_t* k = WSP(const bf16_t, WS_K) + (size_t)(b * SEQ) * KVW + kv * 128;
    const bf16_t* v = WSP(const bf16_t, WS_V) + (size_t)(b * SEQ) * KVW + kv * 128;
    bf16_t* o = WSP(bf16_t, WS_MRG) + (size_t)(b * SEQ + qb * 256) * DM + FW + hq * 128;
    attn::attn_dense_body(q, k, v, o, SEQ, F.lds);
}
__device__ __forceinline__ void p3_mixers(const Frame& F) {
    const GemmThread g = gemm_thread_init();
    const bool std = (F.G == 256); const int xl = F.xl, r = F.rk;
    int na, a0, astep, nd, d0, dstep;
    if (std) { na = (r < 24) ? 2 : 0; a0 = xl * 24 + r; astep = 8 * 24; nd = (r < 24) ? 0 : 1; d0 = xl * 8 + (r - 24); dstep = 1; }
    else { na = (384 - F.bx + F.G - 1) / F.G; if (F.bx >= 384) na = 0; a0 = F.bx; astep = F.G; nd = (64 - F.bx + F.G - 1) / F.G; if (F.bx >= 64) nd = 0; d0 = F.bx; dstep = F.G; }
#if (P3_MASK & 1)
    for (int it = 0; it < na; ++it) { const int u = a0 + it * astep; __syncthreads(); p3_attn_unit(F, u / 24, u % 24); }
#endif
#if (P3_MASK & 2)
    for (int it = 0; it < nd; ++it) { __syncthreads(); p3_dft_unit(F, g, d0 + it * dstep); }
#endif
}

__device__ __forceinline__ void p4_merge_norm(const Frame& F) {
    const float* gf = INP(9); const float* ga = INP(10);
    bf16_t* mrg = WSP(bf16_t, WS_MRG);
    for (int base = F.bx * 8 + F.wave; base < NTOK; base += 4 * F.G * 8) {
        u32x4 v[4][4];
#pragma unroll
        for (int q = 0; q < 4; ++q) { const int row = base + q * F.G * 8;
            if (row < NTOK) {
#pragma unroll
                for (int i = 0; i < 4; ++i) v[q][i] = *(const u32x4*)(mrg + (size_t)row * DM + (i * 64 + F.lane) * 8); } }
#pragma unroll
        for (int q = 0; q < 4; ++q) { const int row = base + q * F.G * 8;
            if (row < NTOK) {
                bf16_t* rp = mrg + (size_t)row * DM;
                float ssf = 0.f, ssa = 0.f;
#pragma unroll
                for (int i = 0; i < 4; ++i) { float s2 = 0.f;
#pragma unroll
                    for (int e = 0; e < 4; ++e) { const float a = bflo(v[q][i][e]), b2 = bfhi(v[q][i][e]); s2 += a * a + b2 * b2; }
                    if (i == 0) ssf = s2; else ssa += s2; }
                ssf = wave_sum(ssf); ssa = wave_sum(ssa);
                const float rf = rsqrtf(ssf * (1.f / FW) + EPS), ra = rsqrtf(ssa * (1.f / AW) + EPS);
#pragma unroll
                for (int i = 0; i < 4; ++i) { const int k = (i * 64 + F.lane) * 8; const float rs = (i == 0) ? rf : ra; const float* gp = (i == 0) ? (gf + k) : (ga + (k - FW));
                    const f32x4 g0 = *(const f32x4*)gp, g1 = *(const f32x4*)(gp + 4);
                    u32x4 w;
                    w[0] = cvt_pk_bf16(bflo(v[q][i][0]) * rs * g0[0], bfhi(v[q][i][0]) * rs * g0[1]); w[1] = cvt_pk_bf16(bflo(v[q][i][1]) * rs * g0[2], bfhi(v[q][i][1]) * rs * g0[3]);
                    w[2] = cvt_pk_bf16(bflo(v[q][i][2]) * rs * g1[0], bfhi(v[q][i][2]) * rs * g1[1]); w[3] = cvt_pk_bf16(bflo(v[q][i][3]) * rs * g1[2], bfhi(v[q][i][3]) * rs * g1[3]);
                    *(u32x4*)(rp + k) = w; }
            } }
    }
}

__device__ __forceinline__ void p5_outproj(const Frame& F) {
    const GemmThread g = gemm_thread_init();
    const bf16_t* mrg = WSP(const bf16_t, WS_MRG); bf16_t* mix = WSP(bf16_t, WS_MIX);
    const int vcu = (F.G & 7) ? F.bx : F.xl * (F.G >> 3) + F.rk;
    for (int u = vcu; u < 256; u += F.G) {
        int mt, nt; if (!patch_unit(u, 32, 8, mt, nt)) continue;
        f32x4 acc[4][8]; acc_zero(acc);
        unsigned aoff[2];
#pragma unroll
        for (int i = 0; i < 2; ++i) aoff[i] = (unsigned)(g.rrow0 + 16 * i) * (DM * 2u) + g.rchunk;
        gemm_accum_ring(acc, F.lds, g, F.wave, F.lane, (const char*)(mrg + (size_t)mt * 256 * DM), aoff, (const char*)(WSB() + WS_IMGOUT) + (size_t)(nt * 32) * 32768, DM / 64);
        const EpiLane el = epi_lane(g);
        char* tw = stg_base(F);
#pragma unroll
        for (int i = 0; i < 4; ++i)
#pragma unroll
            for (int j = 0; j < 8; ++j) stg_put(tw, el, i, j, (u32x2){cvt_pk_bf16(acc[i][j][0], acc[i][j][1]), cvt_pk_bf16(acc[i][j][2], acc[i][j][3])});
        stg_flush(F, tw, mix + (size_t)(mt * 256 + 64 * el.wm) * DM + nt * 256 + 128 * el.wn, DM);
    }
}

__device__ __forceinline__ void p6_postmix(const Frame& F) {
    const int tid = F.tid, lane = F.lane, wave = F.wave;
    const float* x = INP(0); const float* gpost = INP(12); const float* gpre = INP(13);
    const float* w_router = INP(14); const float* b_router = INP(15);
    const bf16_t* mix = WSP(const bf16_t, WS_MIX); float* x1b = WSP(float, WS_X1); unsigned char* h2b = WSP(unsigned char, WS_H2);
    int* list = WSP(int, WS_LIST); float* gatev = WSP(float, WS_GATEV); unsigned* cnt = (unsigned*)(WSB() + WS_CTL + CTL_CNT_OFF);
    float* gm = (float*)F.lds; float* af = gm + DM; float* sf = af + DM;
    constexpr int RP = 528;
    char* HAh = F.lds + 24576; char* HAl = HAh + 32 * RP; char* WBh = HAl + 32 * RP; char* WBl = WBh + 32 * RP;
    float* RED = (float*)(WBl + 32 * RP);
    float* LOG = RED + 8 * 32 * 32;
    int* s_cnt = (int*)(LOG + 32 * 32); int* s_base = s_cnt + 32; int* s_e = s_base + 32; int* s_lr = s_e + 128;
    for (int grp = F.bx; grp < NTOK / 32; grp += F.G) {
        const int row0 = grp * 32, b = row0 / SEQ;
        __syncthreads();
        for (int k = tid; k < DM; k += NTHREADS) {
            gm[k] = mod_at(F, b * 12288 + 2 * DM + k) * gpost[k];
            af[k] = gpre[k] * (1.f + mod_at(F, b * 12288 + 4 * DM + k));
            sf[k] = mod_at(F, b * 12288 + 3 * DM + k); }
        if (tid < 32) s_cnt[tid] = 0;
        __syncthreads();
        const unsigned lo16 = (unsigned)lane * 16u, lo8 = (unsigned)lane * 8u;
        float r2v[4];
#pragma unroll
        for (int rr = 0; rr < 4; ++rr) r2v[rr] = 0.f;
#pragma unroll 1
        for (int rr = 0; rr < 4; ++rr) {
            const int row = row0 + wave * 4 + rr;
            float ss = 0.f; f32x4 mv[8];
#pragma unroll
            for (int i = 0; i < 8; ++i) { const u32x2 m2 = *(const u32x2*)((const char*)(mix + (size_t)row * DM + i * 256) + lo8);
                mv[i] = (f32x4){bflo(m2[0]), bfhi(m2[0]), bflo(m2[1]), bfhi(m2[1])};
                ss += mv[i][0] * mv[i][0] + mv[i][1] * mv[i][1] + mv[i][2] * mv[i][2] + mv[i][3] * mv[i][3]; }
            ss = wave_sum(ss); const float r1 = rsqrtf(ss * (1.f / DM) + EPS);
            float s2 = 0.f;
            f32x4 xrow[8];
#pragma unroll
            for (int i = 0; i < 8; ++i) xrow[i] = *(const f32x4*)((const char*)(x + (size_t)row * DM + i * 256) + lo16);
#pragma unroll
            for (int i = 0; i < 8; ++i) { const int k = i * 256 + lane * 4; const f32x4 xv = xrow[i]; const f32x4 g4 = *(const f32x4*)(gm + k);
                f32x4 v1; for (int e = 0; e < 4; ++e) v1[e] = xv[e] + g4[e] * (mv[i][e] * r1);
                *(f32x4*)((char*)(x1b + (size_t)row * DM + i * 256) + lo16) = v1; mv[i] = v1;
#if DEBUG_X1
                *(f32x4*)((char*)(uni(F.a->out) + (size_t)row * DM + i * 256) + lo16) = v1;
#endif
                s2 += v1[0] * v1[0] + v1[1] * v1[1] + v1[2] * v1[2] + v1[3] * v1[3]; }
            s2 = wave_sum(s2); const float r2 = rsqrtf(s2 * (1.f / DM) + EPS);
            r2v[0] = rr == 0 ? r2 : r2v[0]; r2v[1] = rr == 1 ? r2 : r2v[1]; r2v[2] = rr == 2 ? r2 : r2v[2]; r2v[3] = rr == 3 ? r2 : r2v[3];
#pragma unroll
            for (int i = 0; i < 8; ++i) { const int k = i * 256 + lane * 4; const f32x4 a4 = *(const f32x4*)(af + k), s4 = *(const f32x4*)(sf + k);
                float h0 = (mv[i][0] * r2 * a4[0] + s4[0]) * FP8_SA, h1 = (mv[i][1] * r2 * a4[1] + s4[1]) * FP8_SA, h2_ = (mv[i][2] * r2 * a4[2] + s4[2]) * FP8_SA, h3 = (mv[i][3] * r2 * a4[3] + s4[3]) * FP8_SA;
                h0 = fminf(fmaxf(h0, -448.f), 448.f); h1 = fminf(fmaxf(h1, -448.f), 448.f); h2_ = fminf(fmaxf(h2_, -448.f), 448.f); h3 = fminf(fmaxf(h3, -448.f), 448.f);
                *(unsigned*)(h2b + (size_t)row * DM + i * 256 + lane * 4) = cvt4_fp8(h0, h1, h2_, h3); }
        }
        f32x4 racc[2][2];
#pragma unroll
        for (int m = 0; m < 2; ++m)
#pragma unroll
            for (int n = 0; n < 2; ++n) racc[m][n] = (f32x4){0.f, 0.f, 0.f, 0.f};
        const int l15 = lane & 15, lq = lane >> 4;
#pragma unroll 1
        for (int i = 0; i < 8; ++i) {
            __syncthreads();
            {
                const int k = i * 256 + lane * 4; const f32x4 a4 = *(const f32x4*)(af + k), s4 = *(const f32x4*)(sf + k);
#pragma unroll
                for (int rr = 0; rr < 4; ++rr) {
                    const f32x4 xv = *(const f32x4*)((const char*)(x1b + (size_t)(row0 + wave * 4 + rr) * DM + i * 256) + lo16);
                    const float r2 = rr == 0 ? r2v[0] : rr == 1 ? r2v[1] : rr == 2 ? r2v[2] : r2v[3];
                    float h0 = xv[0] * r2 * a4[0] + s4[0], h1 = xv[1] * r2 * a4[1] + s4[1], h2_ = xv[2] * r2 * a4[2] + s4[2], h3 = xv[3] * r2 * a4[3] + s4[3];
                    const unsigned p0 = cvt_pk_bf16(h0, h1), p1 = cvt_pk_bf16(h2_, h3);
                    const unsigned q0 = cvt_pk_bf16(h0 - bflo(p0), h1 - bfhi(p0)), q1 = cvt_pk_bf16(h2_ - bflo(p1), h3 - bfhi(p1));
                    const int off = (wave * 4 + rr) * RP + lane * 8;
                    *(u32x2*)(HAh + off) = (u32x2){p0, p1}; *(u32x2*)(HAl + off) = (u32x2){q0, q1};
                }
            }
            {
                const int k4 = tid & 63, e4 = tid >> 6;
                f32x4 wv[4];
#pragma unroll
                for (int kk = 0; kk < 4; ++kk) wv[kk] = *(const f32x4*)(w_router + (size_t)(i * 256 + 4 * k4 + kk) * NEXP + 4 * e4);
#pragma unroll
                for (int j = 0; j < 4; ++j) {
                    const unsigned p0 = cvt_pk_bf16(wv[0][j], wv[1][j]), p1 = cvt_pk_bf16(wv[2][j], wv[3][j]);
                    const unsigned q0 = cvt_pk_bf16(wv[0][j] - bflo(p0), wv[1][j] - bfhi(p0)), q1 = cvt_pk_bf16(wv[2][j] - bflo(p1), wv[3][j] - bfhi(p1));
                    const int off = (4 * e4 + j) * RP + k4 * 8;
                    *(u32x2*)(WBh + off) = (u32x2){p0, p1}; *(u32x2*)(WBl + off) = (u32x2){q0, q1};
                }
            }
            __syncthreads();
            bf16x8 ah[2], al[2], bh[2], bl[2];
            const int fo = l15 * RP + wave * 64 + lq * 16;
#pragma unroll
            for (int m = 0; m < 2; ++m) { ah[m] = *(const bf16x8*)(HAh + fo + m * 16 * RP); al[m] = *(const bf16x8*)(HAl + fo + m * 16 * RP);
                                          bh[m] = *(const bf16x8*)(WBh + fo + m * 16 * RP); bl[m] = *(const bf16x8*)(WBl + fo + m * 16 * RP); }
#pragma unroll
            for (int m = 0; m < 2; ++m)
#pragma unroll
                for (int n = 0; n < 2; ++n) {
                    racc[m][n] = __builtin_amdgcn_mfma_f32_16x16x32_bf16(ah[m], bh[n], racc[m][n], 0, 0, 0);
                    racc[m][n] = __builtin_amdgcn_mfma_f32_16x16x32_bf16(ah[m], bl[n], racc[m][n], 0, 0, 0);
                    racc[m][n] = __builtin_amdgcn_mfma_f32_16x16x32_bf16(al[m], bh[n], racc[m][n], 0, 0, 0);
                }
        }
#pragma unroll
        for (int m = 0; m < 2; ++m)
#pragma unroll
            for (int n = 0; n < 2; ++n)
#pragma unroll
                for (int r = 0; r < 4; ++r) RED[(wave * 32 + 16 * m + 4 * lq + r) * 32 + 16 * n + l15] = racc[m][n][r];
        __syncthreads();
        { const int tk = tid >> 4, e2 = (tid & 15) * 2; float s0 = b_router[e2], s1 = b_router[e2 + 1];
#pragma unroll
            for (int w = 0; w < 8; ++w) { s0 += RED[(w * 32 + tk) * 32 + e2]; s1 += RED[(w * 32 + tk) * 32 + e2 + 1]; }
            LOG[tk * 32 + e2] = s0; LOG[tk * 32 + e2 + 1] = s1; }
        __syncthreads();
#pragma unroll 1
        for (int rr = 0; rr < 4; ++rr) {
            float val = LOG[(wave * 4 + rr) * 32 + (lane & 31)];
            float tv[4]; int te[4];
#pragma unroll
            for (int kk = 0; kk < 4; ++kk) {
                float m = val;
#pragma unroll
                for (int o = 16; o >= 1; o >>= 1) m = fmaxf(m, __shfl_xor(m, o, 64));
                const unsigned long long bal = __ballot(val == m);
                const int e = __ffsll((long long)bal) - 1;
                tv[kk] = m; te[kk] = e & 31; if ((lane & 31) == (e & 31)) val = -INFINITY;
            }
            const float p1 = __expf(tv[1] - tv[0]), p2 = __expf(tv[2] - tv[0]), p3 = __expf(tv[3] - tv[0]); const float inv = 1.f / (1.f + p1 + p2 + p3);
            if (lane < 4) {
                const int e = lane == 0 ? te[0] : lane == 1 ? te[1] : lane == 2 ? te[2] : te[3];
                const float gt = (lane == 0 ? 1.f : lane == 1 ? p1 : lane == 2 ? p2 : p3) * inv;
                const int al = (wave * 4 + rr) * 4 + lane;
                s_e[al] = e; s_lr[al] = atomicAdd(&s_cnt[e], 1);
                gatev[row0 * 4 + al] = gt;
            }
        }
        __syncthreads();
        if (tid < 32) { int t2 = tid; asm volatile("" : "+v"(t2));
            s_base[tid] = (int)__hip_atomic_fetch_add(&cnt[t2], (unsigned)s_cnt[tid], __ATOMIC_RELAXED, __HIP_MEMORY_SCOPE_AGENT); }
        __syncthreads();
        if (tid < 128) { const int e = s_e[tid]; list[e * 8192 + s_base[e] + s_lr[tid]] = row0 * 4 + tid; }
    }
}

struct MoeTab { int* tiles; int* rowbase; int* cnt; int* pt; };
__device__ __forceinline__ MoeTab moe_tab(const Frame& F) {
    MoeTab t; t.tiles = (int*)(F.lds + LDS_MISC + 64); t.rowbase = t.tiles + 32; t.cnt = t.rowbase + 32; t.pt = t.cnt + 32;
    unsigned* cnt = (unsigned*)(WSB() + WS_CTL + CTL_CNT_OFF);
    __syncthreads();
    if (F.tid < 32) { const int n = (int)__hip_atomic_load(&cnt[F.tid], __ATOMIC_RELAXED, __HIP_MEMORY_SCOPE_AGENT); t.cnt[F.tid] = n; t.tiles[F.tid] = (n + 255) >> 8; }
    __syncthreads();
    if (F.tid == 0) { int s = 0, p = 0; for (int e = 0; e < 32; ++e) { t.rowbase[e] = s; s += t.tiles[e] * 256; t.pt[e] = p; p += t.tiles[e] > 2 ? t.tiles[e] - 2 : 0; } t.pt[32] = p; }
    __syncthreads();
    return t;
}
__device__ __forceinline__ void moe_tile_of(const MoeTab& t, int tix, int& e, int& mt) {
    int ee = 0;
#pragma unroll 1
    for (int k = 1; k < 32; ++k) ee = (tix >= t.pt[k]) ? k : ee;
    e = ee; mt = 2 + tix - t.pt[ee];
}

__device__ __forceinline__ void moe_up_epilogue(const Frame& F, const GemmThread& g, const f32x4 (&acc)[4][8], int e, int mt, int nt, int ne, int rowb) {
    const float* b_gate = INP(17); const float* b_up = INP(19); unsigned char* act = WSP(unsigned char, WS_ACT);
    const EpiLane el = epi_lane(g);
    char* tw = F.lds + F.wave * 4096;
    f32x4 bg[4], bu[4];
#pragma unroll
    for (int j = 0; j < 4; ++j) { const int col = nt * 128 + 64 * el.wn + 16 * j + 4 * el.lq;
        bg[j] = *(const f32x4*)(b_gate + (size_t)e * DM + col); bu[j] = *(const f32x4*)(b_up + (size_t)e * DM + col); }
#pragma unroll
    for (int j = 0; j < 4; ++j) {
        const int col = nt * 128 + 64 * el.wn + 16 * j + 4 * el.lq;
#pragma unroll
        for (int i = 0; i < 4; ++i) {
            const int ml = 64 * el.wm + 16 * i + el.l15;
            float o[4];
#pragma unroll
            for (int q = 0; q < 4; ++q) { float gg = acc[i][j][q] * (1.f / (FP8_SA * FP8_SW)) + bg[j][q], uu = acc[i][j + 4][q] * (1.f / (FP8_SA * FP8_SW)) + bu[j][q];
                gg = fminf(gg, 7.f); uu = fminf(fmaxf(uu, -7.f), 7.f);
                o[q] = (uu + 1.f) * gg * __builtin_amdgcn_rcpf(1.f + __expf(-1.702f * gg)); }
            *(unsigned*)(tw + (16 * i + el.l15) * 64 + 16 * j + 4 * el.lq) = cvt4_fp8(o[0] * FP8_SACT, o[1] * FP8_SACT, o[2] * FP8_SACT, o[3] * FP8_SACT);
        }
    }
    { int ln = F.lane; asm volatile("" : "+v"(ln));
      char* dst = (char*)act + ((size_t)(rowb >> 8) * 32 + nt * 2 + el.wn) * 16384 + (64 * el.wm) * 64;
#pragma unroll
      for (int q = 0; q < 4; ++q) *(u32x4*)(dst + q * 1024 + ln * 16) = *(const u32x4*)(tw + q * 1024 + ln * 16); }
    __syncthreads();
}
__device__ __forceinline__ void moe_dn_epilogue(const Frame& F, const GemmThread& g, const f32x4 (&acc)[4][8], int e, int mt, int nt, int ne) {
    const float* b_down = INP(21); const int* list = WSP(const int, WS_LIST); const float* gatev = WSP(const float, WS_GATEV); bf16_t* outb = WSP(bf16_t, WS_OUTB);
    const EpiLane el = epi_lane(g);
    constexpr float RS = 1.f / (FP8_SACT * FP8_SW);
    int av[4]; float gtv[4]; f32x4 bd[8];
#pragma unroll
    for (int i = 0; i < 4; ++i) { int rk = mt * 256 + 64 * el.wm + 16 * i + el.l15; rk = rk < ne ? rk : ne - 1; av[i] = list[e * 8192 + rk]; }
#pragma unroll
    for (int j = 0; j < 8; ++j) bd[j] = *(const f32x4*)(b_down + (size_t)e * DM + nt * 256 + 128 * el.wn + 16 * j + 4 * el.lq);
#pragma unroll
    for (int i = 0; i < 4; ++i) gtv[i] = gatev[av[i]];
    char* tw = F.lds + F.wave * 8704;
    int ln = F.lane; asm volatile("" : "+v"(ln));
#pragma unroll
    for (int hf = 0; hf < 2; ++hf) {
#pragma unroll
        for (int ii = 0; ii < 2; ++ii) { const int i = 2 * hf + ii; const float gt = gtv[i];
#pragma unroll
            for (int j = 0; j < 8; ++j) {
                u32x2 w = {cvt_pk_bf16((acc[i][j][0] * RS + bd[j][0]) * gt, (acc[i][j][1] * RS + bd[j][1]) * gt), cvt_pk_bf16((acc[i][j][2] * RS + bd[j][2]) * gt, (acc[i][j][3] * RS + bd[j][3]) * gt)};
                *(u32x2*)(tw + (16 * ii + el.l15) * 272 + (16 * j + 4 * el.lq) * 2) = w; } }
#pragma unroll
        for (int q = 0; q < 8; ++q) {
            const int rl = q * 4 + (ln >> 4), chunk = ln & 15;
            const int a = __shfl(av[2 * hf + (q >> 2)], rl & 15, 64);
            const u32x4 v = *(const u32x4*)(tw + rl * 272 + chunk * 16);
            if (mt * 256 + 64 * el.wm + 32 * hf + rl < ne) *(u32x4*)(outb + (size_t)a * DM + nt * 256 + 128 * el.wn + chunk * 8) = v;
        }
    }
    __syncthreads();
}
__device__ __forceinline__ void moe_up_epilogue32(const Frame& F, const GemmThread& g, const f32x16 (&acc)[2][4], int e, int mt, int nt, int ne, int rowb) {
    const float* b_gate = INP(17); const float* b_up = INP(19); unsigned char* act = WSP(unsigned char, WS_ACT);
    int l31 = F.lane & 31, lh = F.lane >> 5; asm volatile("" : "+v"(l31), "+v"(lh));
    char* tw = F.lds + F.wave * 4096;
    f32x4 bg[2][4], bu[2][4];
#pragma unroll
    for (int j = 0; j < 2; ++j)
#pragma unroll
        for (int q4 = 0; q4 < 4; ++q4) { const int col = nt * 128 + 64 * g.wn + 32 * j + 8 * q4 + 4 * lh;
            bg[j][q4] = *(const f32x4*)(b_gate + (size_t)e * DM + col); bu[j][q4] = *(const f32x4*)(b_up + (size_t)e * DM + col); }
#pragma unroll
    for (int j = 0; j < 2; ++j)
#pragma unroll
        for (int q4 = 0; q4 < 4; ++q4) {
            const int col = nt * 128 + 64 * g.wn + 32 * j + 8 * q4 + 4 * lh;
#pragma unroll
            for (int i = 0; i < 2; ++i) {
                const int ml = 64 * g.wm + 32 * i + l31;
                float o[4];
#pragma unroll
                for (int q = 0; q < 4; ++q) { float gg = acc[i][j][4 * q4 + q] * (1.f / (FP8_SA * FP8_SW)) + bg[j][q4][q], uu = acc[i][j + 2][4 * q4 + q] * (1.f / (FP8_SA * FP8_SW)) + bu[j][q4][q];
                    gg = fminf(gg, 7.f); uu = fminf(fmaxf(uu, -7.f), 7.f);
                    o[q] = (uu + 1.f) * gg * __builtin_amdgcn_rcpf(1.f + __expf(-1.702f * gg)); }
                *(unsigned*)(tw + (32 * i + l31) * 64 + 32 * j + 8 * q4 + 4 * lh) = cvt4_fp8(o[0] * FP8_SACT, o[1] * FP8_SACT, o[2] * FP8_SACT, o[3] * FP8_SACT);
            }
        }
    { int ln = F.lane; asm volatile("" : "+v"(ln));
      char* dst = (char*)act + ((size_t)(rowb >> 8) * 32 + nt * 2 + g.wn) * 16384 + (64 * g.wm) * 64;
#pragma unroll
      for (int q = 0; q < 4; ++q) *(u32x4*)(dst + q * 1024 + ln * 16) = *(const u32x4*)(tw + q * 1024 + ln * 16); }
    __syncthreads();
}
__device__ __forceinline__ void moe_dn_epilogue32(const Frame& F, const GemmThread& g, const f32x16 (&acc)[2][4], int e, int mt, int nt, int ne) {
    const float* b_down = INP(21); const int* list = WSP(const int, WS_LIST); const float* gatev = WSP(const float, WS_GATEV); bf16_t* outb = WSP(bf16_t, WS_OUTB);
    int l31 = F.lane & 31, lh = F.lane >> 5; asm volatile("" : "+v"(l31), "+v"(lh));
    constexpr float RS = 1.f / (FP8_SACT * FP8_SW);
    int av[2]; float gtv[2]; f32x4 bd[4][4];
#pragma unroll
    for (int i = 0; i < 2; ++i) { int rk = mt * 256 + 64 * g.wm + 32 * i + l31; rk = rk < ne ? rk : ne - 1; av[i] = list[e * 8192 + rk]; }
#pragma unroll
    for (int j = 0; j < 4; ++j)
#pragma unroll
        for (int q4 = 0; q4 < 4; ++q4) bd[j][q4] = *(const f32x4*)(b_down + (size_t)e * DM + nt * 256 + 128 * g.wn + 32 * j + 8 * q4 + 4 * lh);
#pragma unroll
    for (int i = 0; i < 2; ++i) gtv[i] = gatev[av[i]];
    char* tw = F.lds + F.wave * 8704;
    int ln = F.lane; asm volatile("" : "+v"(ln));
#pragma unroll
    for (int i = 0; i < 2; ++i) {
        const float gt = gtv[i];
#pragma unroll
        for (int j = 0; j < 4; ++j)
#pragma unroll
            for (int q4 = 0; q4 < 4; ++q4) {
                u32x2 w = {cvt_pk_bf16((acc[i][j][4 * q4 + 0] * RS + bd[j][q4][0]) * gt, (acc[i][j][4 * q4 + 1] * RS + bd[j][q4][1]) * gt), cvt_pk_bf16((acc[i][j][4 * q4 + 2] * RS + bd[j][q4][2]) * gt, (acc[i][j][4 * q4 + 3] * RS + bd[j][q4][3]) * gt)};
                *(u32x2*)(tw + l31 * 272 + (32 * j + 8 * q4 + 4 * lh) * 2) = w; }
#pragma unroll
        for (int q = 0; q < 8; ++q) {
            const int rl = q * 4 + (ln >> 4), chunk = ln & 15;
            const int a = __shfl(av[i], rl, 64);
            const u32x4 v = *(const u32x4*)(tw + rl * 272 + chunk * 16);
            if (mt * 256 + 64 * g.wm + 32 * i + rl < ne) *(u32x4*)(outb + (size_t)a * DM + nt * 256 + 128 * g.wn + chunk * 8) = v;
        }
    }
    __syncthreads();
}
__device__ __forceinline__ void moe_up_unit_first(const Frame& F, const GemmThread& g, const MoeTab& tb, int e, int nt) {
    const int ne = __builtin_amdgcn_readfirstlane(tb.cnt[e]); if (ne == 0) return;
    const int* list = WSP(const int, WS_LIST); const unsigned char* h2 = WSP(const unsigned char, WS_H2);
    const float* w_gate = INP(16); const float* w_up = INP(18);
    f32x4 acc[4][8]; acc_zero(acc);
    int achunk = g.rchunk, arow = g.rrow0, kg = g.kg, ng = g.ng; asm volatile("" : "+v"(achunk), "+v"(arow), "+v"(kg), "+v"(ng));
    unsigned aoff[2];
#pragma unroll
    for (int i = 0; i < 2; ++i) { int rk = arow + 16 * i; rk = rk < ne ? rk : ne - 1; const int a = list[e * 8192 + rk]; aoff[i] = (unsigned)(a >> 2) * (unsigned)DM + achunk; }
    const int isup = (F.wave >> 1) & 1;
    const char* bb = (const char*)((isup ? w_up : w_gate) + (size_t)e * DM * DM + nt * 128);
    const unsigned boff = (unsigned)(8 * kg) * (DM * 4u) + (unsigned)((ng >> 5) * 64 + (ng & 15) * 4) * 4u;
    f8_accum_w32(acc, F.lds, g, F.wave, (const char*)h2, aoff, bb, boff, DM * 4, DM / 64, (char*)(WSB() + WS_IMGGU) + (size_t)((e * 16 + nt) * 32) * 16384);
    moe_up_epilogue(F, g, acc, e, 0, nt, ne, __builtin_amdgcn_readfirstlane(tb.rowbase[e]));
}
__device__ __forceinline__ void moe_dn_unit_first(const Frame& F, const GemmThread& g, const MoeTab& tb, int e, int nt) {
    const int ne = __builtin_amdgcn_readfirstlane(tb.cnt[e]); if (ne == 0) return;
    const unsigned char* act = WSP(const unsigned char, WS_ACT); const float* w_down = INP(20);
    const int rowb = __builtin_amdgcn_readfirstlane(tb.rowbase[e]);
    f32x4 acc[4][8]; acc_zero(acc);
    int achunk = g.rchunk, arow = g.rrow0, kg = g.kg, ng = g.ng; asm volatile("" : "+v"(achunk), "+v"(arow), "+v"(kg), "+v"(ng));
    unsigned aoff[2];
#pragma unroll
    for (int i = 0; i < 2; ++i) aoff[i] = (unsigned)(arow + 16 * i) * 64u + achunk;
    f8_accum_w32(acc, F.lds, g, F.wave, (const char*)(act + (size_t)(rowb >> 8) * 32 * 16384), aoff, (const char*)(w_down + (size_t)e * DM * DM + nt * 256), (unsigned)(8 * kg) * (DM * 4u) + 16u * ng, DM * 4, DM / 64,
                 (char*)(WSB() + WS_IMGDN) + (size_t)((e * 8 + nt) * 32) * 16384, 16384u);
    moe_dn_epilogue(F, g, acc, e, 0, nt, ne);
}
__device__ __forceinline__ void moe_up_unit_dma(const Frame& F, const GemmThread& g, const MoeTab& tb, int e, int mt, int nt) {
    const int ne = __builtin_amdgcn_readfirstlane(tb.cnt[e]);
    const int* list = WSP(const int, WS_LIST); const unsigned char* h2 = WSP(const unsigned char, WS_H2);
    int achunk = g.rchunk, arow = g.rrow0; asm volatile("" : "+v"(achunk), "+v"(arow));
    f32x16 acc[2][4];
#pragma unroll
    for (int i = 0; i < 2; ++i)
#pragma unroll
        for (int j = 0; j < 4; ++j) acc[i][j] = f32x16{};
    unsigned aoff[2];
#pragma unroll
    for (int i = 0; i < 2; ++i) { int rk = mt * 256 + arow + 16 * i; rk = rk < ne ? rk : ne - 1; const int a = list[e * 8192 + rk]; aoff[i] = (unsigned)(a >> 2) * (unsigned)DM + achunk; }
    s8_accum_ring(acc, F.lds, g, F.wave, F.lane, (const char*)h2, aoff, (const char*)(WSB() + WS_IMGGU) + (size_t)((e * 16 + nt) * 32) * 16384, DM / 64);
    moe_up_epilogue32(F, g, acc, e, mt, nt, ne, __builtin_amdgcn_readfirstlane(tb.rowbase[e]) + mt * 256);
}
__device__ __forceinline__ void moe_dn_unit_dma(const Frame& F, const GemmThread& g, const MoeTab& tb, int e, int mt, int nt) {
    const int ne = __builtin_amdgcn_readfirstlane(tb.cnt[e]), rowb = __builtin_amdgcn_readfirstlane(tb.rowbase[e]) + mt * 256;
    const unsigned char* act = WSP(const unsigned char, WS_ACT);
    int achunk = g.rchunk, arow = g.rrow0; asm volatile("" : "+v"(achunk), "+v"(arow));
    f32x16 acc[2][4];
#pragma unroll
    for (int i = 0; i < 2; ++i)
#pragma unroll
        for (int j = 0; j < 4; ++j) acc[i][j] = f32x16{};
    unsigned aoff[2];
#pragma unroll
    for (int i = 0; i < 2; ++i) aoff[i] = (unsigned)(arow + 16 * i) * 64u + achunk;
    s8_accum_ring(acc, F.lds, g, F.wave, F.lane, (const char*)(act + (size_t)(rowb >> 8) * 32 * 16384), aoff, (const char*)(WSB() + WS_IMGDN) + (size_t)((e * 8 + nt) * 32) * 16384, DM / 64, 16384u);
    moe_dn_epilogue32(F, g, acc, e, mt, nt, ne);
}

__device__ __forceinline__ void moe_dn_unit_dma_h(const Frame& F, const GemmThread& g, const MoeTab& tb, int e, int mt, int nt, int nh) {
    const int ne = __builtin_amdgcn_readfirstlane(tb.cnt[e]), rowb = __builtin_amdgcn_readfirstlane(tb.rowbase[e]) + mt * 256;
    const unsigned char* act = WSP(const unsigned char, WS_ACT);
    int achunk = g.rchunk, arow = g.rrow0; asm volatile("" : "+v"(achunk), "+v"(arow));
    f32x16 acc[2][2];
#pragma unroll
    for (int i = 0; i < 2; ++i)
#pragma unroll
        for (int j = 0; j < 2; ++j) acc[i][j] = f32x16{};
    unsigned aoff[2];
#pragma unroll
    for (int i = 0; i < 2; ++i) aoff[i] = (unsigned)(arow + 16 * i) * 64u + achunk;
    s8_accum_ring_h(acc, F.lds, g, F.wave, F.lane, (const char*)(act + (size_t)(rowb >> 8) * 32 * 16384), aoff, (const char*)(WSB() + WS_IMGDN) + (size_t)((e * 8 + nt) * 32) * 16384 + nh * 8192, DM / 64, 16384u);
    const float* b_down = INP(21); const int* list = WSP(const int, WS_LIST); const float* gatev = WSP(const float, WS_GATEV); bf16_t* outb = WSP(bf16_t, WS_OUTB);
    int l31 = F.lane & 31, lh = F.lane >> 5; asm volatile("" : "+v"(l31), "+v"(lh));
    constexpr float RS = 1.f / (FP8_SACT * FP8_SW);
    int av[2]; float gtv[2]; f32x4 bd[2][4];
#pragma unroll
    for (int i = 0; i < 2; ++i) { int rk = mt * 256 + 64 * g.wm + 32 * i + l31; rk = rk < ne ? rk : ne - 1; av[i] = list[e * 8192 + rk]; }
#pragma unroll
    for (int j = 0; j < 2; ++j)
#pragma unroll
        for (int q4 = 0; q4 < 4; ++q4) bd[j][q4] = *(const f32x4*)(b_down + (size_t)e * DM + nt * 256 + nh * 128 + 64 * g.wn + 32 * j + 8 * q4 + 4 * lh);
#pragma unroll
    for (int i = 0; i < 2; ++i) gtv[i] = gatev[av[i]];
#pragma unroll
    for (int i = 0; i < 2; ++i) {
        const int ml = 64 * g.wm + 32 * i + l31, rk = mt * 256 + ml;
        if (rk < ne) {
            const int a = av[i]; const float gt = gtv[i];
#pragma unroll
            for (int j = 0; j < 2; ++j)
#pragma unroll
                for (int q4 = 0; q4 < 4; ++q4) { const int col = nt * 256 + nh * 128 + 64 * g.wn + 32 * j + 8 * q4 + 4 * lh;
                    u32x2 w = {cvt_pk_bf16((acc[i][j][4 * q4 + 0] * RS + bd[j][q4][0]) * gt, (acc[i][j][4 * q4 + 1] * RS + bd[j][q4][1]) * gt), cvt_pk_bf16((acc[i][j][4 * q4 + 2] * RS + bd[j][q4][2]) * gt, (acc[i][j][4 * q4 + 3] * RS + bd[j][q4][3]) * gt)};
                    *(u32x2*)(outb + (size_t)a * DM + col) = w; }
        }
    }
}

__device__ __forceinline__ void p7_moe_a(const Frame& F) {
    const GemmThread g = gemm_thread_init();
    const MoeTab tb = moe_tab(F);
    const int vcu = (F.G & 7) ? F.bx : F.xl * (F.G >> 3) + F.rk;
#pragma unroll 1
    for (int u = vcu; u < 32 * 16; u += F.G) { const int e = u >> 4, nt = u & 15;
        moe_up_unit_first(F, g, tb, e, nt);
        if (__builtin_amdgcn_readfirstlane(tb.tiles[e]) >= 2) { const GemmThread g2 = gemm_thread_init<true>(); moe_up_unit_dma(F, g2, tb, e, 1, nt); } }
}
__device__ __forceinline__ void p8_moe_b(const Frame& F) {
    const GemmThread g = gemm_thread_init();
    const MoeTab tb = moe_tab(F);
    const int nb = __builtin_amdgcn_readfirstlane(tb.pt[32]) * 16;
    const int vcu = (F.G & 7) ? F.bx : F.xl * (F.G >> 3) + F.rk;
    int u = vcu;
#pragma unroll 1
    for (; u < 256; u += F.G) { const int e = u >> 3, nt = u & 7;
        moe_dn_unit_first(F, g, tb, e, nt);
        if (__builtin_amdgcn_readfirstlane(tb.tiles[e]) >= 2) { const GemmThread g2 = gemm_thread_init<true>(); moe_dn_unit_dma(F, g2, tb, e, 1, nt); } }
    if (F.G == 256) {
        const int T = nb >> 4, ngrp = 2 * ((T + 3) >> 2);
        for (int gi = F.xl; gi < ngrp; gi += 8) { const int tix = (gi >> 1) * 4 + (F.rk >> 3), nt = (gi & 1) * 8 + (F.rk & 7);
            if (tix < T) { int e, mt; moe_tile_of(tb, tix, e, mt); e = __builtin_amdgcn_readfirstlane(e); mt = __builtin_amdgcn_readfirstlane(mt); moe_up_unit_dma(F, g, tb, e, mt, nt); } }
    } else
    for (u = F.bx; u < nb; u += F.G) { int e, mt; moe_tile_of(tb, u >> 4, e, mt); e = __builtin_amdgcn_readfirstlane(e); mt = __builtin_amdgcn_readfirstlane(mt); moe_up_unit_dma(F, g, tb, e, mt, u & 15); }
}
__device__ __forceinline__ void p9_moe_c(const Frame& F) {
    const GemmThread g = gemm_thread_init();
    const MoeTab tb = moe_tab(F);
    const int nb = __builtin_amdgcn_readfirstlane(tb.pt[32]) * 8;
    if (F.G == 256) {
        const int T = nb >> 3, ngrp = (T + 3) >> 2;
        const int rem = ngrp & 7, nfull = (rem >= 1 && rem <= 4) ? ngrp - rem : ngrp;
        for (int gi = F.xl; gi < nfull; gi += 8) { const int tix = gi * 4 + (F.rk >> 3), nt = F.rk & 7;
            if (tix < T) { int e, mt; moe_tile_of(tb, tix, e, mt); e = __builtin_amdgcn_readfirstlane(e); mt = __builtin_amdgcn_readfirstlane(mt); moe_dn_unit_dma(F, g, tb, e, mt, nt); } }
        if (nfull < ngrp && F.xl < 2 * rem) { const int gi = nfull + (F.xl >> 1), nh = F.xl & 1, tix = gi * 4 + (F.rk >> 3), nt = F.rk & 7;
            if (tix < T) { int e, mt; moe_tile_of(tb, tix, e, mt); e = __builtin_amdgcn_readfirstlane(e); mt = __builtin_amdgcn_readfirstlane(mt); moe_dn_unit_dma_h(F, g, tb, e, mt, nt, nh); } }
    } else
    for (int u = F.bx; u < nb; u += F.G) { int e, mt; moe_tile_of(tb, u >> 3, e, mt); e = __builtin_amdgcn_readfirstlane(e); mt = __builtin_amdgcn_readfirstlane(mt); moe_dn_unit_dma(F, g, tb, e, mt, u & 7); }
}

__device__ __forceinline__ void p10_final(const Frame& F) {
    const int tid = F.tid, lane = F.lane, wave = F.wave;
    const float* gpf = INP(22); const float* x1b = WSP(const float, WS_X1); const bf16_t* outb = WSP(const bf16_t, WS_OUTB);
    float* gfv = (float*)F.lds;
    for (int grp = F.bx; grp < NTOK / 32; grp += F.G) {
        const int row0 = grp * 32, b = row0 / SEQ;
        __syncthreads();
        for (int k = tid; k < DM; k += NTHREADS) gfv[k] = mod_at(F, b * 12288 + 5 * DM + k) * gpf[k];
        __syncthreads();
#pragma unroll 1
        for (int rp = 0; rp < 4; rp += 2) {
            u32x2 m2v[2][8][4]; f32x4 xvv[2][8];
#pragma unroll
            for (int q = 0; q < 2; ++q) { const int row = row0 + wave * 4 + rp + q;
#pragma unroll
                for (int i = 0; i < 8; ++i) {
#pragma unroll
                    for (int kk = 0; kk < 4; ++kk) m2v[q][i][kk] = *(const u32x2*)(outb + (size_t)(row * 4 + kk) * DM + i * 256 + lane * 4);
                    xvv[q][i] = *(const f32x4*)(x1b + (size_t)row * DM + i * 256 + lane * 4); } }
#pragma unroll
            for (int q = 0; q < 2; ++q) { const int row = row0 + wave * 4 + rp + q;
                f32x4 y[8]; float ss = 0.f;
#pragma unroll
                for (int i = 0; i < 8; ++i) { y[i] = (f32x4){0.f, 0.f, 0.f, 0.f};
#pragma unroll
                    for (int kk = 0; kk < 4; ++kk) { const u32x2 m2 = m2v[q][i][kk];
                        y[i][0] += bflo(m2[0]); y[i][1] += bfhi(m2[0]); y[i][2] += bflo(m2[1]); y[i][3] += bfhi(m2[1]); }
                    ss += y[i][0] * y[i][0] + y[i][1] * y[i][1] + y[i][2] * y[i][2] + y[i][3] * y[i][3]; }
                ss = wave_sum(ss); const float rs = rsqrtf(ss * (1.f / DM) + EPS);
#pragma unroll
                for (int i = 0; i < 8; ++i) { const int k = i * 256 + lane * 4; const f32x4 g4 = *(const f32x4*)(gfv + k);
                    f32x4 o; for (int e = 0; e < 4; ++e) o[e] = xvv[q][i][e] + g4[e] * (y[i][e] * rs);
                    *(f32x4*)(uni(F.a->out) + (size_t)row * DM + k) = o; }
            }
        }
    }
}


__global__ void __launch_bounds__(NTHREADS, 2) fwd_kernel(Args args) {
    extern __shared__ __attribute__((aligned(16))) char lds[];
    Frame F;
    F.lds = lds; F.a = &args;
    F.tid = threadIdx.x; F.lane = F.tid & 63; F.wave = __builtin_amdgcn_readfirstlane(F.tid >> 6); F.G = gridDim.x; F.bx = blockIdx.x;
    const int lo = args.ph_lo, hi = args.ph_hi;
    F.xl = F.bx & 7; F.rk = F.bx >> 3;
    XcdBarrier bar; bar.bar = (unsigned*)(args.ws + WS_CTL); bar.x = 0; bar.st = (volatile LAS unsigned*)(lds + LDS_MISC);
    if (hi - lo > 1) {
        if (F.tid == 0) { *(volatile LAS unsigned*)(lds + LDS_MISC) = 0u; *(volatile LAS unsigned*)(lds + LDS_MISC + 4) = 0u; }
        __syncthreads();
        bar = xcd_barrier_post((unsigned*)(args.ws + WS_CTL), (volatile LAS unsigned*)(lds + LDS_MISC));
        if (F.tid == 0) *(volatile LAS unsigned*)(lds + LDS_MISC + 16) = xb_add((unsigned*)(args.ws + WS_CTL + CTL_RANK_OFF) + bar.x, 1u);
    }
#ifndef PH_MASK
#define PH_MASK 0x7ff
#endif
#define IN(k) (((PH_MASK >> (k)) & 1) && lo <= (k) && (k) < hi)
#define SEAM(k) do { if (IN(k) && IN((k) + 1)) xcd_barrier(bar); } while (0)
    if (IN(0)) { p0_prologue(F); } SEAM(0);
    if (hi - lo > 1 && (F.G & 7) == 0) {
        if (F.tid == 0) { unsigned ok = 1u; for (int j = 0; j < 8; ++j) ok &= (xb_ld(&bar.bar[XB_XCNT(j)]) == (unsigned)(F.G >> 3)) ? 1u : 0u; *(volatile LAS unsigned*)(lds + LDS_MISC + 20) = ok; }
        __syncthreads();
        if (*(volatile LAS unsigned*)(lds + LDS_MISC + 20) && bar.x < 8u) { F.xl = (int)bar.x; F.rk = (int)*(volatile LAS unsigned*)(lds + LDS_MISC + 16); }
        F.xl = __builtin_amdgcn_readfirstlane(F.xl); F.rk = __builtin_amdgcn_readfirstlane(F.rk);
    }
    if (IN(1)) { p1_norm(F); } SEAM(1);
    if (IN(2)) { p2_inproj(F); } SEAM(2);
    if (IN(3)) { p3_mixers(F); } SEAM(3);
    if (IN(4)) { p4_merge_norm(F); } SEAM(4);
    if (IN(5)) { p5_outproj(F); } SEAM(5);
    if (IN(6)) { p6_postmix(F); } SEAM(6);
    if (IN(7)) { p7_moe_a(F); } SEAM(7);
    if (IN(8)) { p8_moe_b(F); } SEAM(8);
    if (IN(9)) { p9_moe_c(F); } SEAM(9);
    if (IN(10)) { p10_final(F); }
#undef IN
#undef SEAM
}

}

extern "C" void kernel_launch(void* const* d_in, const int* in_sizes, int n_in, void* d_out, int out_size, void* d_ws, size_t ws_size, hipStream_t stream) {
    static int grid = 0;
    if (grid == 0) {
        if (n_in != 23 || out_size != NTOK * DM || ws_size < WS_END) { fprintf(stderr, "kernel_launch: unexpected shapes (n_in %d out %d ws %zu need %zu)\n", n_in, out_size, ws_size, (size_t)WS_END); grid = -1; return; }
        int dev = 0, cus = 0, per_cu = 0;
        if (hipGetDevice(&dev) != hipSuccess || hipDeviceGetAttribute(&cus, hipDeviceAttributeMultiprocessorCount, dev) != hipSuccess) { grid = -1; return; }
        if (hipFuncSetAttribute((const void*)fwd_kernel, hipFuncAttributeMaxDynamicSharedMemorySize, LDS_BYTES) != hipSuccess) { fprintf(stderr, "kernel_launch: hipFuncSetAttribute failed\n"); grid = -1; return; }
        if (hipOccupancyMaxActiveBlocksPerMultiprocessor(&per_cu, (const void*)fwd_kernel, NTHREADS, LDS_BYTES) != hipSuccess || per_cu < 1)
            fprintf(stderr, "kernel_launch: occupancy query reports %d blocks per CU\n", per_cu);
        (void)hipGetLastError();
        grid = cus;
    }
    if (grid < 0) return;
    (void)hipMemsetAsync((char*)d_ws + WS_CTL, 0, CTL_BYTES, stream);
    Args a{};
    for (int i = 0; i < 23; ++i) a.in[i] = (const float*)d_in[i];
    a.out = (float*)d_out; a.ws = (unsigned char*)d_ws;
#if MK_N_LAUNCHES == 1
    a.ph_lo = 0; a.ph_hi = NPHASE;
    hipLaunchKernelGGL(fwd_kernel, dim3(grid), dim3(NTHREADS), LDS_BYTES, stream, a);
#else
    for (int p = 0; p < NPHASE; ++p) { a.ph_lo = p; a.ph_hi = p + 1; hipLaunchKernelGGL(fwd_kernel, dim3(grid), dim3(NTHREADS), LDS_BYTES, stream, a);
        if ((REP_MASK >> p) & 1) hipLaunchKernelGGL(fwd_kernel, dim3(grid), dim3(NTHREADS), LDS_BYTES, stream, a); }
#endif
    const hipError_t le = hipPeekAtLastError();
    if (le != hipSuccess) fprintf(stderr, "kernel_launch: launch failed: %s\n", hipGetErrorName(le));
}
```

```cpp
#include <hip/hip_runtime.h>
#include <stdint.h>
#include <stdio.h>

#ifndef DEBUG_X1
#define DEBUG_X1 0
#endif
#ifndef STAMP_A
#define STAMP_A 0
#endif
#ifndef STAMP_B
#define STAMP_B 0
#endif
#ifndef S8_KMAP
#define S8_KMAP 0
#endif
#ifndef REP_MASK
#define REP_MASK 0
#endif
#ifndef DEBUG_PROBE
#define DEBUG_PROBE 0
#endif
#ifndef P3_MASK
#define P3_MASK 3
#endif
#ifndef MK_N_LAUNCHES
#define MK_N_LAUNCHES 1
#endif

namespace {

constexpr int DM = 2048, NBATCH = 4, SEQ = 2048, NTOK = NBATCH * SEQ;
constexpr int FW = 512, AW = 1536, KVW = 512, INW = 3072;
constexpr int NEXP = 32, TOPK = 4, NMOD = 6;
constexpr int NPHASE = 11;
constexpr float EPS = 1e-6f;
constexpr int NTHREADS = 512;
constexpr float FP8_SA = 16.f, FP8_SW = 256.f, FP8_SACT = 4.f;

typedef unsigned short bf16_t;
typedef short bf16x8 __attribute__((ext_vector_type(8)));
typedef short s16x4 __attribute__((ext_vector_type(4)));
typedef float f32x4 __attribute__((ext_vector_type(4)));
typedef float f32x2 __attribute__((ext_vector_type(2)));
typedef float f32x16 __attribute__((ext_vector_type(16)));
typedef unsigned u32x4 __attribute__((ext_vector_type(4)));
typedef unsigned u32x2 __attribute__((ext_vector_type(2)));

constexpr size_t al256(size_t x) { return (x + 255) / 256 * 256; }
constexpr size_t WS_CTL   = 0;
constexpr size_t CTL_BAR_BYTES = 16384;
constexpr size_t CTL_CNT_OFF = CTL_BAR_BYTES;
constexpr size_t CTL_RANK_OFF = CTL_BAR_BYTES + 256;
constexpr size_t CTL_BYTES = CTL_BAR_BYTES + 512;
constexpr size_t WS_MODP  = al256(WS_CTL + CTL_BYTES);
constexpr size_t WS_G12   = al256(WS_MODP + 2ull * 4 * 12288 * 4);
constexpr size_t WS_ROPE  = al256(WS_G12 + 4ull * 128 * 256 * 4);
constexpr size_t WS_WZ    = al256(WS_ROPE + 2048ull * 64 * 2 * 4);
constexpr size_t WS_CMAT  = al256(WS_WZ + 2048ull * 1024 * 4);
constexpr size_t WS_SMAT  = al256(WS_CMAT + 2048ull * 2048 * 2);
constexpr size_t WS_H     = al256(WS_SMAT + 2048ull * 2048 * 2);
constexpr size_t WS_ZC    = al256(WS_H + (size_t)NTOK * DM * 2);
constexpr size_t WS_ZS    = al256(WS_ZC + (size_t)NTOK * 512 * 4);
constexpr size_t WS_Q     = al256(WS_ZS + (size_t)NTOK * 512 * 4);
constexpr size_t WS_K     = al256(WS_Q + (size_t)NTOK * AW * 2);
constexpr size_t WS_V     = al256(WS_K + (size_t)NTOK * KVW * 2);
constexpr size_t WS_MRG   = al256(WS_V + (size_t)NTOK * KVW * 2);
constexpr size_t WS_MIX   = al256(WS_MRG + (size_t)NTOK * DM * 2);
constexpr size_t WS_X1    = al256(WS_MIX + (size_t)NTOK * DM * 2);
constexpr size_t WS_H2    = al256(WS_X1 + (size_t)NTOK * DM * 4);
constexpr size_t WS_LIST  = al256(WS_H2 + (size_t)NTOK * DM * 2);
constexpr size_t WS_GATEV = al256(WS_LIST + 32ull * 8192 * 4);
constexpr int ACT_ROWS = NTOK * TOPK + NEXP * 256;
constexpr size_t WS_ACT   = al256(WS_GATEV + 32768ull * 4);
constexpr size_t WS_OUTB  = al256(WS_ACT + (size_t)ACT_ROWS * DM * 2);
constexpr size_t WS_IMGGU = al256(WS_OUTB + (size_t)NTOK * TOPK * DM * 2);
constexpr size_t WS_IMGDN = al256(WS_IMGGU + 32ull * 16 * 32 * 16384);
constexpr size_t WS_IMGIN = al256(WS_IMGDN + 32ull * 8 * 32 * 16384);
constexpr size_t WS_IMGOUT= al256(WS_IMGIN + 14ull * 32 * 32768);
constexpr size_t WS_IMGZ  = al256(WS_IMGOUT + 8ull * 32 * 32768);
constexpr size_t WS_END   = al256(WS_IMGZ + 8ull * 64 * 32768);

constexpr int LDS_GEMM = 147456;
constexpr int LDS_MISC = LDS_GEMM;
constexpr int LDS_BYTES = LDS_GEMM + 1024;

typedef __bf16 bf16x2_t __attribute__((ext_vector_type(2)));
__device__ __forceinline__ unsigned cvt_pk_bf16(float lo, float hi) { f32x2 v = {lo, hi}; bf16x2_t b = __builtin_convertvector(v, bf16x2_t); return __builtin_bit_cast(unsigned, b); }
__device__ __forceinline__ bf16_t f2bf(float f) { return (bf16_t)(cvt_pk_bf16(f, 0.f) & 0xffffu); }
__device__ __forceinline__ float bf2f(unsigned h) { return __uint_as_float(h << 16); }
__device__ __forceinline__ float bflo(unsigned w) { return __uint_as_float(w << 16); }
__device__ __forceinline__ float bfhi(unsigned w) { return __uint_as_float(w & 0xffff0000u); }
__device__ __forceinline__ float wave_sum(float v) {
#pragma unroll
    for (int o = 32; o >= 1; o >>= 1) v += __shfl_xor(v, o, 64);
    return v;
}

#define XB_TMO      128
#define XB_XCNT(j)  (256  + 64 * (j))
#define XB_XSUB(j)  (1280 + 64 * (j))
#define XB_XGEN(j)  (2304 + 64 * (j))
#define XB_TOP      3328
#define XB_TOPGEN   3392
#define XCD_BAR_WORDS 3456
#define XB_SPIN_CAP (1u << 22)
#define LAS __attribute__((address_space(3)))

__device__ __forceinline__ unsigned xb_ld(unsigned* p)              { return __hip_atomic_load(p, __ATOMIC_RELAXED, __HIP_MEMORY_SCOPE_AGENT); }
__device__ __forceinline__ unsigned xb_add(unsigned* p, unsigned v) { return __hip_atomic_fetch_add(p, v, __ATOMIC_RELAXED, __HIP_MEMORY_SCOPE_AGENT); }
__device__ __forceinline__ unsigned xb_xcc_id() { return (unsigned)__builtin_amdgcn_s_getreg((3 << 11) | 20) & 0xFu; }
#define XB_SPIN(cond, bar) do { unsigned _sp = 0; while (cond) { __builtin_amdgcn_s_sleep(1); \
    if ((++_sp & 255u) == 0u) { if (xb_ld(&(bar)[XB_TMO])) break; if (_sp > XB_SPIN_CAP) { atomicAdd(&(bar)[XB_TMO], 1u); break; } } } } while (0)

struct XcdBarrier { unsigned* bar; unsigned x; volatile LAS unsigned* st; };

__device__ __forceinline__ XcdBarrier xcd_barrier_post(unsigned* bar, volatile LAS unsigned* st) {
    XcdBarrier b; b.bar = bar; b.x = xb_xcc_id(); b.st = st;
    if (threadIdx.x == 0) (void)xb_add(&bar[XB_XCNT(b.x)], 1u);
    return b;
}
__device__ __forceinline__ void xcd_barrier_complete(unsigned* bar, unsigned x, unsigned& nloc, unsigned& nx) {
    const unsigned G = gridDim.x * gridDim.y * gridDim.z;
    unsigned sum, cnt, mine, sp = 0u;
    for (;;) {
        sum = 0u; cnt = 0u; mine = 0u;
#pragma unroll
        for (unsigned j = 0; j < 16; ++j) { const unsigned c = xb_ld(&bar[XB_XCNT(j)]); sum += c; cnt += (c > 0u) ? 1u : 0u; mine = (j == x) ? c : mine; }
        if (sum == G) break;
        __builtin_amdgcn_s_sleep(1);
        if ((++sp & 255u) == 0u) { if (xb_ld(&bar[XB_TMO])) break; if (sp > XB_SPIN_CAP) { atomicAdd(&bar[XB_TMO], 1u); break; } }
    }
    nloc = mine > 0u ? mine : 1u; nx = cnt > 0u ? cnt : 1u;
}
__device__ __forceinline__ void xcd_barrier(const XcdBarrier& b) {
    asm volatile("s_waitcnt vmcnt(0)" ::: "memory");
    __syncthreads();
    if (threadIdx.x == 0) {
        unsigned* bar = b.bar;
        __builtin_amdgcn_s_waitcnt(0);
        unsigned nloc = b.st[0], nx = b.st[1];
        if (nloc == 0u) { xcd_barrier_complete(bar, b.x, nloc, nx); b.st[0] = nloc; b.st[1] = nx; }
        const unsigned old = xb_add(&bar[XB_XSUB(b.x)], 1u);
        const unsigned gen = old / nloc;
        if (old + 1u == (gen + 1u) * nloc) {
            __builtin_amdgcn_fence(__ATOMIC_RELEASE, "agent");
            asm volatile("s_waitcnt vmcnt(0)" ::: "memory");
            const unsigned og = xb_add(&bar[XB_TOP], 1u);
            const unsigned tg = og / nx;
            if (og + 1u == (tg + 1u) * nx) xb_add(&bar[XB_TOPGEN], 1u);
            else XB_SPIN(xb_ld(&bar[XB_TOPGEN]) == tg, bar);
            __builtin_amdgcn_fence(__ATOMIC_ACQUIRE, "agent");
            xb_add(&bar[XB_XGEN(b.x)], 1u);
            asm volatile("s_waitcnt vmcnt(0)" ::: "memory");
        } else {
            XB_SPIN(xb_ld(&bar[XB_XGEN(b.x)]) == gen, bar);
            __builtin_amdgcn_fence(__ATOMIC_ACQUIRE, "agent");
            asm volatile("s_waitcnt vmcnt(0)" ::: "memory");
        }
    }
    __syncthreads();
}

struct Args {
    const float* in[23];
    float* out;
    unsigned char* ws;
    int ph_lo, ph_hi;
};

struct GemmThread {
    int a_w0;
    int b_w0;
    int a_r, b_r;
    int c8;
    int r0;
    int kg, ng;
    int wm, wn, l15, lq;
    int arow0, achunk;
    int rrow0, rchunk;
    int rfr;
    int imgw0;
    int f8r0, f8r1;
    int f8w0;
    int s8r0, s8r1;
};
__host__ __device__ constexpr int sw4(int c) { return (0x9C >> (2 * c)) & 3; }
__host__ __device__ constexpr int sw4inv(int p) { return (0x78 >> (2 * p)) & 3; }
template <bool OPQ = false>
__device__ __forceinline__ GemmThread gemm_thread_init() {
    GemmThread g;
    int tid = threadIdx.x; if (OPQ) asm volatile("" : "+v"(tid));
    const int lane = tid & 63, wave = __builtin_amdgcn_readfirstlane(tid >> 6);
    const int c = tid & 7; g.r0 = tid >> 3; g.c8 = c * 8;
    g.a_w0 = g.r0 * 128 + ((c ^ (g.r0 & 7)) << 4);
    g.kg = lane & 7; g.ng = (lane >> 3) + 8 * wave;
    g.b_w0 = 32768 + (4 * g.ng) * 128 + ((g.kg ^ ((4 * g.ng) & 7)) << 4);
    g.wm = wave >> 1; g.wn = wave & 1; g.l15 = lane & 15; g.lq = lane >> 4;
    const int sw = ((g.lq ^ (g.l15 & 7)) << 4);
    g.a_r = (64 * g.wm + g.l15) * 128 + sw;
    g.b_r = 32768 + (128 * g.wn + g.l15) * 128 + sw;
    g.arow0 = 32 * wave + (lane >> 3); g.achunk = ((lane & 7) ^ (lane >> 3)) * 16;
    g.rrow0 = 32 * wave + (lane >> 2); g.rchunk = sw4inv((lane & 3) ^ ((lane >> 4) & 3)) * 16;
    g.rfr = g.l15 * 64 + ((((g.l15 >> 2) & 3) ^ sw4(g.lq)) << 4);
    g.imgw0 = (g.kg >> 2) * 16384 + (4 * g.ng) * 64 + (((g.ng & 3) ^ sw4(g.kg & 3)) << 4);
    g.f8r0 = g.l15 * 64 + ((((g.l15 >> 2) & 3) ^ sw4(g.lq >> 1)) << 4) + 8 * (g.lq & 1);
    g.f8r1 = g.l15 * 64 + ((((g.l15 >> 2) & 3) ^ sw4(2 + (g.lq >> 1))) << 4) + 8 * (g.lq & 1);
    g.f8w0 = (4 * g.ng) * 64 + (((g.ng & 3) ^ sw4(g.kg >> 1)) << 4) + 8 * (g.kg & 1);
    { const int r32 = lane & 31, hh = lane >> 5, qq = (r32 >> 2) & 3;
      const int c0 = S8_KMAP ? hh : 2 * hh, c1 = S8_KMAP ? 2 + hh : 2 * hh + 1;
      g.s8r0 = r32 * 64 + ((qq ^ sw4(c0)) << 4); g.s8r1 = r32 * 64 + ((qq ^ sw4(c1)) << 4); }
    return g;
}

template <class T> __device__ __forceinline__ T* sgpr_ptr(T* p) {
    const unsigned long long v = (unsigned long long)p;
    const unsigned lo = __builtin_amdgcn_readfirstlane((unsigned)v), hi = __builtin_amdgcn_readfirstlane((unsigned)(v >> 32));
    typedef __attribute__((address_space(1))) T* gptr_t;
    return (T*)(gptr_t)(((unsigned long long)hi << 32) | lo);
}
__device__ __forceinline__ f32x4 ld_nt_async(const char* sbase, unsigned voff) {
    f32x4 r; asm volatile("global_load_dwordx4 %0, %1, %2 nt" : "=v"(r) : "v"(voff), "s"(sbase) : "memory"); return r;
}
#define RB_PIN(WAITSTR, RB) asm volatile(WAITSTR : "+v"(RB[0]), "+v"(RB[1]), "+v"(RB[2]), "+v"(RB[3]), "+v"(RB[4]), "+v"(RB[5]), "+v"(RB[6]), "+v"(RB[7]) :: "memory")
__device__ __forceinline__ void glds16(const void* src, char* lds_wave_base) {
    __builtin_amdgcn_global_load_lds((const unsigned*)src, (LAS unsigned*)lds_wave_base, 16, 0, 0);
}
#define G_AF(ks)  _Pragma("unroll") for (int i_ = 0; i_ < 4; ++i_) af[i_] = *(const bf16x8*)(sb + ((g.a_r ^ ((ks) << 6)) + i_ * 2048));
#define G_BF(ks, jh) _Pragma("unroll") for (int j_ = 0; j_ < 4; ++j_) bfr[j_] = *(const bf16x8*)(sb + ((g.b_r ^ ((ks) << 6)) + ((jh) * 4 + j_) * 2048));
#define G_MM(jh) _Pragma("unroll") for (int j_ = 0; j_ < 4; ++j_) _Pragma("unroll") for (int i_ = 0; i_ < 4; ++i_) \
        acc[i_][(jh) * 4 + j_] = __builtin_amdgcn_mfma_f32_16x16x32_bf16(bfr[j_], af[i_], acc[i_][(jh) * 4 + j_], 0, 0, 0);
#define G_WRB(sn, j_) do { u32x4 w_; \
        w_[0] = cvt_pk_bf16(rb[0][j_], rb[1][j_]); w_[1] = cvt_pk_bf16(rb[2][j_], rb[3][j_]); \
        w_[2] = cvt_pk_bf16(rb[4][j_], rb[5][j_]); w_[3] = cvt_pk_bf16(rb[6][j_], rb[7][j_]); \
        *(u32x4*)((sn) + (bw0_ ^ ((j_) * 0x90))) = w_; \
        if (IMG) *(u32x4*)(imgk + g.imgw0 + (j_) * 64) = w_; } while (0)
template <bool TWO_SEG, bool WR, bool LD, bool IMG>
__device__ __forceinline__ void gemm_step(f32x4 (&acc)[4][8], char* lds, const GemmThread& g, const int wave, f32x4 (&rb)[8], const int kt,
                                          const char* Abase, const unsigned (&aoffb)[4], const char* Bbase, const unsigned boffb, const int ldbB,
                                          const char* Abase2, const char* Bbase2, const int nk1, char* img) {
    asm volatile("s_waitcnt vmcnt(0)" ::: "memory");
    __syncthreads();
    const char* sb = lds + (kt & 1) * 65536; char* sn = lds + ((kt + 1) & 1) * 65536;
    char* imgk = img + (size_t)(kt + 1) * 32768;
    if (WR) {
        const int k1 = kt + 1; const bool s1 = TWO_SEG && k1 >= nk1; const char* ak = (s1 ? Abase2 : Abase) + (size_t)(s1 ? k1 - nk1 : k1) * 128;
#pragma unroll
        for (int i = 0; i < 4; ++i) glds16(ak + aoffb[i], sn + (4 * wave + i) * 1024);
    }
    int bw0_ = g.b_w0; asm volatile("" : "+v"(bw0_));
    bf16x8 af[4], bfr[4];
    G_AF(0) G_BF(0, 0) G_MM(0)
    if (WR) { G_WRB(sn, 0); G_WRB(sn, 1); }
    __builtin_amdgcn_sched_barrier(0);
    G_BF(0, 1) G_MM(1)
    if (WR) { G_WRB(sn, 2); G_WRB(sn, 3); }
    if (LD) {
        const int k2 = kt + 2; const bool s2 = TWO_SEG && k2 >= nk1; const int kk = s2 ? k2 - nk1 : k2;
        const char* bk = (s2 ? Bbase2 : Bbase) + (size_t)kk * 64 * ldbB;
#pragma unroll
        for (int k = 0; k < 8; ++k) rb[k] = *(const f32x4*)(bk + (size_t)k * ldbB + boffb);
    }
    __builtin_amdgcn_sched_barrier(0);
    G_AF(1) G_BF(1, 0) G_MM(0)
    __builtin_amdgcn_sched_barrier(0);
    G_BF(1, 1) G_MM(1)
}

template <bool TWO_SEG = false, bool IMG = false>
__device__ __forceinline__ void gemm_accum(f32x4 (&acc)[4][8], char* lds, const GemmThread& g, const int wave,
                                           const char* Abase, const unsigned (&aoffb)[4],
                                           const char* Bbase, const unsigned boffb, const int ldbB, const int nk,
                                           const char* Abase2 = nullptr, const char* Bbase2 = nullptr, const int nk1 = 0, char* img = nullptr) {
    f32x4 rb[8];
#define G_LOADB(kt) do { const char* bk_ = Bbase + (size_t)(kt) * 64 * ldbB; \
        _Pragma("unroll") for (int k_ = 0; k_ < 8; ++k_) rb[k_] = *(const f32x4*)(bk_ + (size_t)k_ * ldbB + boffb); } while (0)
#pragma unroll
    for (int i = 0; i < 4; ++i) glds16(Abase + aoffb[i], lds + (4 * wave + i) * 1024);
    G_LOADB(0);
    { char* sn = lds; char* imgk = img; const int bw0_ = g.b_w0; G_WRB(sn, 0); G_WRB(sn, 1); G_WRB(sn, 2); G_WRB(sn, 3); }
    G_LOADB(1);
    for (int kt = 0; kt < nk - 2; ++kt) gemm_step<TWO_SEG, true, true, IMG>(acc, lds, g, wave, rb, kt, Abase, aoffb, Bbase, boffb, ldbB, Abase2, Bbase2, nk1, img);
    gemm_step<TWO_SEG, true, false, IMG>(acc, lds, g, wave, rb, nk - 2, Abase, aoffb, Bbase, boffb, ldbB, Abase2, Bbase2, nk1, img);
    gemm_step<TWO_SEG, false, false, IMG>(acc, lds, g, wave, rb, nk - 1, Abase, aoffb, Bbase, boffb, ldbB, Abase2, Bbase2, nk1, img);
    __syncthreads();
#undef G_LOADB
}

#define R_MMJ(AF, BF, jh, j) do { _Pragma("unroll") for (int i_ = 0; i_ < 4; ++i_) \
        acc[i_][(jh) * 4 + (j)] = __builtin_amdgcn_mfma_f32_16x16x32_bf16(BF[j], AF[i_], acc[i_][(jh) * 4 + (j)], 0, 0, 0); } while (0)
#define R_SB() __builtin_amdgcn_sched_barrier(0)
#define STG_BARRIER() do { asm volatile("s_waitcnt lgkmcnt(0)" ::: "memory"); __builtin_amdgcn_s_barrier(); asm volatile("" ::: "memory"); } while (0)
#define R_MMI(AF, BF, i) do { _Pragma("unroll") for (int j_ = 0; j_ < 4; ++j_) \
        acc[i][4 + j_] = __builtin_amdgcn_mfma_f32_16x16x32_bf16(BF[j_], AF[i], acc[i][4 + j_], 0, 0, 0); } while (0)
__device__ __forceinline__ void gemm_accum_ring(f32x4 (&acc)[4][8], char* lds, const GemmThread& g, const int wave, const int lane,
                                                const char* Abase, const unsigned (&aoffb)[2], const char* Bimg, const int nk) {
    const unsigned boffl = (unsigned)wave * 2048u + (unsigned)lane * 16u;
    const int NS = 2 * nk;
    const int saoff = g.rfr + (64 * g.wm) * 64, sboff = 16384 + g.rfr + (128 * g.wn) * 64;
#pragma unroll
    for (int s = 0; s < 4; ++s) { char* sd = lds + s * 32768 + wave * 2048; const char* ak = sgpr_ptr(Abase + (size_t)s * 64); const char* bk = sgpr_ptr(Bimg + (size_t)s * 16384);
        glds16(ak + aoffb[0], sd); glds16(bk + boffl, sd + 16384); glds16(ak + aoffb[1], sd + 1024); glds16(bk + (boffl + 1024u), sd + 16384 + 1024); }
    asm volatile("s_waitcnt vmcnt(12)" ::: "memory");
    __builtin_amdgcn_s_barrier();
    asm volatile("" ::: "memory");
    bf16x8 a0[4], b0[4], b1[4];
#pragma unroll
    for (int i = 0; i < 4; ++i) a0[i] = *(const bf16x8*)(lds + saoff + i * 1024);
#pragma unroll
    for (int j = 0; j < 4; ++j) b0[j] = *(const bf16x8*)(lds + sboff + j * 1024);
#pragma unroll
    for (int j = 0; j < 4; ++j) b1[j] = *(const bf16x8*)(lds + sboff + (4 + j) * 1024);
#pragma unroll 1
    for (int s = 0; s < NS; ++s) {
        R_MMJ(a0, b0, 0, 0); R_MMJ(a0, b0, 0, 1); R_MMJ(a0, b0, 0, 2); R_MMJ(a0, b0, 0, 3);
        R_SB();
        asm volatile("s_waitcnt vmcnt(8)" ::: "memory");
        asm volatile("s_waitcnt lgkmcnt(0)" ::: "memory");
        __builtin_amdgcn_s_barrier();
        asm volatile("" ::: "memory");
        const bool ld = s + 4 < NS;
        const char* sn = lds + ((s + 1) & 3) * 32768;
        char* sd = lds + (s & 3) * 32768 + wave * 2048;
        const char* ak = sgpr_ptr(ld ? Abase + (size_t)(s + 4) * 64 : Bimg); const char* bk = sgpr_ptr(ld ? Bimg + (size_t)(s + 4) * 16384 : Bimg);
        const char* p0 = ak + (ld ? aoffb[0] : 0u); const char* p1 = bk + (ld ? boffl : 0u); const char* p2 = ak + (ld ? aoffb[1] : 0u); const char* p3 = bk + (ld ? boffl + 1024u : 0u);
#pragma unroll
        for (int j = 0; j < 4; ++j) b0[j] = *(const bf16x8*)(sn + sboff + j * 1024);
        glds16(p0, sd); R_SB();
        R_MMI(a0, b1, 0); R_SB();
        a0[0] = *(const bf16x8*)(sn + saoff); glds16(p1, sd + 16384); R_SB();
        R_MMI(a0, b1, 1); R_SB();
        a0[1] = *(const bf16x8*)(sn + saoff + 1024); glds16(p2, sd + 1024); R_SB();
        R_MMI(a0, b1, 2); R_SB();
        a0[2] = *(const bf16x8*)(sn + saoff + 2048); glds16(p3, sd + 16384 + 1024); R_SB();
        R_MMI(a0, b1, 3); R_SB();
        a0[3] = *(const bf16x8*)(sn + saoff + 3072);
#pragma unroll
        for (int j = 0; j < 4; ++j) b1[j] = *(const bf16x8*)(sn + sboff + (4 + j) * 1024);
        R_SB();
    }
    __syncthreads();
}

typedef long f8x8;
__device__ __forceinline__ unsigned cvt4_fp8(float a, float b, float c, float d) {
    unsigned w = 0; w = __builtin_amdgcn_cvt_pk_fp8_f32(a, b, w, false); w = __builtin_amdgcn_cvt_pk_fp8_f32(c, d, w, true); return w;
}
#define F8_RA(AF, off) _Pragma("unroll") for (int i_ = 0; i_ < 4; ++i_) AF[i_] = *(const f8x8*)(sa + (off) + i_ * 1024);
#define F8_RB(BF, off) _Pragma("unroll") for (int j_ = 0; j_ < 8; ++j_) BF[j_] = *(const f8x8*)(sbb + (off) + j_ * 1024);
#define F8_MMJ(AF, BF, j) do { _Pragma("unroll") for (int i_ = 0; i_ < 4; ++i_) \
        acc[i_][j] = __builtin_amdgcn_mfma_f32_16x16x32_fp8_fp8(BF[j], AF[i_], acc[i_][j], 0, 0, 0); } while (0)
template <int WAITN, bool LD>
__device__ __forceinline__ void f8_ring_step(f32x4 (&acc)[4][8], char* lds, const GemmThread& g, const int wave, const int s,
                                             const char* Abase, const unsigned (&aoffb)[2], const char* Bimg, const unsigned boffl) {
    if (WAITN == 8) asm volatile("s_waitcnt vmcnt(8)" ::: "memory"); else if (WAITN == 4) asm volatile("s_waitcnt vmcnt(4)" ::: "memory"); else asm volatile("s_waitcnt vmcnt(0)" ::: "memory");
    asm volatile("s_waitcnt lgkmcnt(0)" ::: "memory");
    __builtin_amdgcn_s_barrier();
    asm volatile("" ::: "memory");
    const char* sa = lds + (s & 3) * 32768 + (64 * g.wm) * 64; const char* sbb = lds + (s & 3) * 32768 + 16384 + (128 * g.wn) * 64;
    char* sd = lds + ((s + 3) & 3) * 32768 + wave * 2048;
    const char* ak = Abase + (size_t)(s + 3) * 64; const char* bk = Bimg + (size_t)(s + 3) * 16384 + boffl;
    f8x8 a0[4], b0[8], a1[4], b1[8];
    F8_RA(a0, g.f8r0) F8_RB(b0, g.f8r0)
    R_SB();
    F8_MMJ(a0, b0, 0); R_SB(); if (LD) glds16(ak + aoffb[0], sd); R_SB();
    F8_MMJ(a0, b0, 1); R_SB(); if (LD) glds16(bk, sd + 16384); R_SB();
    F8_MMJ(a0, b0, 2); R_SB(); if (LD) glds16(ak + aoffb[1], sd + 1024); R_SB();
    F8_MMJ(a0, b0, 3); R_SB(); if (LD) glds16(bk + 1024, sd + 16384 + 1024); R_SB();
    F8_RA(a1, g.f8r1) F8_RB(b1, g.f8r1)
    R_SB();
    F8_MMJ(a0, b0, 4); F8_MMJ(a0, b0, 5); F8_MMJ(a0, b0, 6); F8_MMJ(a0, b0, 7);
    R_SB();
    F8_MMJ(a1, b1, 0); F8_MMJ(a1, b1, 1); F8_MMJ(a1, b1, 2); F8_MMJ(a1, b1, 3); F8_MMJ(a1, b1, 4); F8_MMJ(a1, b1, 5); F8_MMJ(a1, b1, 6); F8_MMJ(a1, b1, 7);
}
__device__ __forceinline__ void f8_accum_ring(f32x4 (&acc)[4][8], char* lds, const GemmThread& g, const int wave, const int lane,
                                              const char* Abase, const unsigned (&aoffb)[2], const char* Bimg, const int nk) {
    const unsigned boffl = (unsigned)wave * 2048u + (unsigned)lane * 16u;
#pragma unroll
    for (int s = 0; s < 3; ++s) { char* sd = lds + s * 32768 + wave * 2048; const char* ak = Abase + (size_t)s * 64; const char* bk = Bimg + (size_t)s * 16384 + boffl;
        glds16(ak + aoffb[0], sd); glds16(bk, sd + 16384); glds16(ak + aoffb[1], sd + 1024); glds16(bk + 1024, sd + 16384 + 1024); }
    for (int s = 0; s < nk - 3; ++s) f8_ring_step<8, true>(acc, lds, g, wave, s, Abase, aoffb, Bimg, boffl);
    f8_ring_step<8, false>(acc, lds, g, wave, nk - 3, Abase, aoffb, Bimg, boffl);
    f8_ring_step<4, false>(acc, lds, g, wave, nk - 2, Abase, aoffb, Bimg, boffl);
    f8_ring_step<0, false>(acc, lds, g, wave, nk - 1, Abase, aoffb, Bimg, boffl);
    __syncthreads();
}
typedef int i32x8 __attribute__((ext_vector_type(8)));
typedef int i32x4 __attribute__((ext_vector_type(4)));
__device__ __forceinline__ i32x8 s8_frag(const char* p0, const char* p1) {
    const i32x4 lo = *(const i32x4*)p0, hi = *(const i32x4*)p1;
    return __builtin_shufflevector(lo, hi, 0, 1, 2, 3, 4, 5, 6, 7);
}
#define S8_MM(i, j) acc[i][j] = __builtin_amdgcn_mfma_scale_f32_32x32x64_f8f6f4(bf[j], af[i], acc[i][j], 0, 0, 0, 0x7F7F7F7F, 0, 0x7F7F7F7F)
#define S8_FR(base) s8_frag((base) + g.s8r0, (base) + g.s8r1)
__device__ __forceinline__ void s8_accum_ring(f32x16 (&acc)[2][4], char* lds, const GemmThread& g, const int wave, const int lane,
                                              const char* Abase, const unsigned (&aoffb)[2], const char* Bimg, const int nk, const unsigned astr = 64) {
    const unsigned boffl = (unsigned)wave * 2048u + (unsigned)lane * 16u;
    const int saoff = (64 * g.wm) * 64, sboff = 16384 + (128 * g.wn) * 64;
#pragma unroll
    for (int s = 0; s < 4; ++s) { char* sd = lds + s * 32768 + wave * 2048; const char* ak = sgpr_ptr(Abase + (size_t)s * astr); const char* bk = sgpr_ptr(Bimg + (size_t)s * 16384);
        glds16(ak + aoffb[0], sd); glds16(bk + boffl, sd + 16384); glds16(ak + aoffb[1], sd + 1024); glds16(bk + (boffl + 1024u), sd + 16384 + 1024); }
    asm volatile("s_waitcnt vmcnt(12)" ::: "memory");
    __builtin_amdgcn_s_barrier();
    asm volatile("" ::: "memory");
    i32x8 af[2], bf[4];
    af[0] = S8_FR(lds + saoff);
#pragma unroll
    for (int j = 0; j < 4; ++j) bf[j] = S8_FR(lds + sboff + j * 2048);
    af[1] = S8_FR(lds + saoff + 2048);
#pragma unroll 1
    for (int s = 0; s < nk; ++s) {
        S8_MM(0, 0); S8_MM(0, 1); S8_MM(0, 2); S8_MM(0, 3);
        R_SB();
        asm volatile("s_waitcnt vmcnt(8)" ::: "memory");
        asm volatile("s_waitcnt lgkmcnt(0)" ::: "memory");
        __builtin_amdgcn_s_barrier();
        asm volatile("" ::: "memory");
        const bool ld = s + 4 < nk;
        const char* sn = lds + ((s + 1) & 3) * 32768;
        char* sd = lds + (s & 3) * 32768 + wave * 2048;
        const char* ak = sgpr_ptr(ld ? Abase + (size_t)(s + 4) * astr : Bimg); const char* bk = sgpr_ptr(ld ? Bimg + (size_t)(s + 4) * 16384 : Bimg);
        const char* p0 = ak + (ld ? aoffb[0] : 0u); const char* p1 = bk + (ld ? boffl : 0u); const char* p2 = ak + (ld ? aoffb[1] : 0u); const char* p3 = bk + (ld ? boffl + 1024u : 0u);
        af[0] = S8_FR(sn + saoff); glds16(p0, sd); R_SB();
        S8_MM(1, 0); R_SB();
        bf[0] = S8_FR(sn + sboff); glds16(p1, sd + 16384); R_SB();
        S8_MM(1, 1); R_SB();
        bf[1] = S8_FR(sn + sboff + 2048); glds16(p2, sd + 1024); R_SB();
        S8_MM(1, 2); R_SB();
        bf[2] = S8_FR(sn + sboff + 4096); glds16(p3, sd + 16384 + 1024); R_SB();
        S8_MM(1, 3); R_SB();
        bf[3] = S8_FR(sn + sboff + 6144); af[1] = S8_FR(sn + saoff + 2048); R_SB();
    }
    __syncthreads();
}
__device__ __forceinline__ void s8_accum_ring_h(f32x16 (&acc)[2][2], char* lds, const GemmThread& g, const int wave, const int lane,
                                                const char* Abase, const unsigned (&aoffb)[2], const char* Bimg, const int nk, const unsigned astr) {
    const unsigned boffl = (unsigned)wave * 1024u + (unsigned)lane * 16u;
    const int saoff = (64 * g.wm) * 64, sboff = 16384 + (64 * g.wn) * 64;
#pragma unroll
    for (int s = 0; s < 4; ++s) { char* sd = lds + s * 32768; const char* ak = Abase + (size_t)s * astr; const char* bk = Bimg + (size_t)s * 16384 + boffl;
        glds16(ak + aoffb[0], sd + wave * 2048); glds16(bk, sd + 16384 + wave * 1024); glds16(ak + aoffb[1], sd + wave * 2048 + 1024); }
    asm volatile("s_waitcnt vmcnt(9)" ::: "memory");
    __builtin_amdgcn_s_barrier();
    asm volatile("" ::: "memory");
    i32x8 af[2], bf[2];
    af[0] = S8_FR(lds + saoff); bf[0] = S8_FR(lds + sboff); bf[1] = S8_FR(lds + sboff + 2048); af[1] = S8_FR(lds + saoff + 2048);
#pragma unroll 1
    for (int s = 0; s < nk; ++s) {
        S8_MM(0, 0); S8_MM(0, 1);
        R_SB();
        asm volatile("s_waitcnt vmcnt(6)" ::: "memory");
        asm volatile("s_waitcnt lgkmcnt(0)" ::: "memory");
        __builtin_amdgcn_s_barrier();
        asm volatile("" ::: "memory");
        const bool ld = s + 4 < nk;
        const char* sn = lds + ((s + 1) & 3) * 32768;
        char* sd = lds + (s & 3) * 32768;
        const char* ak = Abase + (size_t)(s + 4) * astr; const char* bk = Bimg + (size_t)(s + 4) * 16384 + boffl;
        const char* p0 = ld ? ak + aoffb[0] : Bimg; const char* p1 = ld ? bk : Bimg; const char* p2 = ld ? ak + aoffb[1] : Bimg;
        af[0] = S8_FR(sn + saoff); glds16(p0, sd + wave * 2048); R_SB();
        S8_MM(1, 0); R_SB();
        bf[0] = S8_FR(sn + sboff); glds16(p1, sd + 16384 + wave * 1024); R_SB();
        S8_MM(1, 1); R_SB();
        bf[1] = S8_FR(sn + sboff + 2048); af[1] = S8_FR(sn + saoff + 2048); glds16(p2, sd + wave * 2048 + 1024); R_SB();
    }
    __syncthreads();
}
#define F8_WRB(sn, j_) do { u32x2 w_; \
        w_[0] = cvt4_fp8(rb[0][j_] * FP8_SW, rb[1][j_] * FP8_SW, rb[2][j_] * FP8_SW, rb[3][j_] * FP8_SW); \
        w_[1] = cvt4_fp8(rb[4][j_] * FP8_SW, rb[5][j_] * FP8_SW, rb[6][j_] * FP8_SW, rb[7][j_] * FP8_SW); \
        *(u32x2*)((sn) + 16384 + bw8_ + (j_) * 64) = w_; } while (0)
template <bool WR, bool LD, bool W8>
__device__ __forceinline__ void f8_w32_step(f32x4 (&acc)[4][8], char* lds, const GemmThread& g, const int wave, f32x4 (&rb)[8], const int kt,
                                            const char* Abase, const unsigned (&aoffb)[2], const char* Bbase, const unsigned boffb, const int ldbB, char* img, const unsigned astr) {
    if (WR) { if (W8) RB_PIN("s_waitcnt vmcnt(10)", rb); else RB_PIN("s_waitcnt vmcnt(0)", rb); }
    else { if (W8) asm volatile("s_waitcnt vmcnt(10)" ::: "memory"); else asm volatile("s_waitcnt vmcnt(0)" ::: "memory"); }
    asm volatile("s_waitcnt lgkmcnt(0)" ::: "memory");
    __builtin_amdgcn_s_barrier();
    asm volatile("" ::: "memory");
    const char* sa = lds + (kt & 1) * 32768 + (64 * g.wm) * 64; const char* sbb = lds + (kt & 1) * 32768 + 16384 + (128 * g.wn) * 64;
    char* sn = lds + ((kt + 1) & 1) * 32768;
    if (WR) { const char* ak = Abase + (size_t)(kt + 1) * astr; glds16(ak + aoffb[0], sn + (2 * wave) * 1024); glds16(ak + aoffb[1], sn + (2 * wave + 1) * 1024); }
    int bw8_ = g.f8w0; asm volatile("" : "+v"(bw8_));
    f8x8 a0[4], b0[8];
    F8_RA(a0, g.f8r0) F8_RB(b0, g.f8r0)
    F8_MMJ(a0, b0, 0); F8_MMJ(a0, b0, 1); F8_MMJ(a0, b0, 2); F8_MMJ(a0, b0, 3);
    if (WR) { F8_WRB(sn, 0); F8_WRB(sn, 1); }
    __builtin_amdgcn_sched_barrier(0);
    F8_MMJ(a0, b0, 4); F8_MMJ(a0, b0, 5); F8_MMJ(a0, b0, 6); F8_MMJ(a0, b0, 7);
    if (WR) { F8_WRB(sn, 2); F8_WRB(sn, 3); }
    if (LD) { const char* bk = Bbase + (size_t)(kt + 3) * 64 * ldbB;
#pragma unroll
        for (int k = 0; k < 8; ++k) rb[k] = ld_nt_async(sgpr_ptr(bk + (size_t)k * ldbB), boffb); }
    {
        int to = (int)threadIdx.x * 16; asm volatile("" : "+v"(to));
        const char* sbi = lds + (kt & 1) * 32768 + 16384; char* imgk = img + (size_t)kt * 16384;
        const u32x4 i0 = *(const u32x4*)(sbi + to), i1 = *(const u32x4*)(sbi + 8192 + to);
        *(u32x4*)(imgk + to) = i0; *(u32x4*)(imgk + 8192 + to) = i1; }
    __builtin_amdgcn_sched_barrier(0);
    F8_RA(a0, g.f8r1) F8_RB(b0, g.f8r1)
    F8_MMJ(a0, b0, 0); F8_MMJ(a0, b0, 1); F8_MMJ(a0, b0, 2); F8_MMJ(a0, b0, 3);
    __builtin_amdgcn_sched_barrier(0);
    F8_MMJ(a0, b0, 4); F8_MMJ(a0, b0, 5); F8_MMJ(a0, b0, 6); F8_MMJ(a0, b0, 7);
}
__device__ __forceinline__ void f8_accum_w32(f32x4 (&acc)[4][8], char* lds, const GemmThread& g, const int wave,
                                             const char* Abase, const unsigned (&aoffb)[2], const char* Bbase, const unsigned boffb, const int ldbB, const int nk, char* img, const unsigned astr = 64) {
    f32x4 rbA[8], rbB[8];
#define F8_LOADB(RB, kt) do { const char* bk_ = Bbase + (size_t)(kt) * 64 * ldbB; \
        _Pragma("unroll") for (int k_ = 0; k_ < 8; ++k_) RB[k_] = ld_nt_async(sgpr_ptr(bk_ + (size_t)k_ * ldbB), boffb); } while (0)
    glds16(Abase + aoffb[0], lds + (2 * wave) * 1024); glds16(Abase + aoffb[1], lds + (2 * wave + 1) * 1024);
    F8_LOADB(rbA, 0);
    RB_PIN("s_waitcnt vmcnt(0)", rbA);
    { f32x4 (&rb)[8] = rbA; char* sn = lds; const int bw8_ = g.f8w0; F8_WRB(sn, 0); F8_WRB(sn, 1); F8_WRB(sn, 2); F8_WRB(sn, 3); }
    F8_LOADB(rbA, 1);
    F8_LOADB(rbB, 2);
    RB_PIN("s_waitcnt vmcnt(8)", rbA);
#pragma unroll 1
    for (int kt = 0; kt < nk - 4; kt += 2) {
        f8_w32_step<true, true, true>(acc, lds, g, wave, rbA, kt, Abase, aoffb, Bbase, boffb, ldbB, img, astr);
        f8_w32_step<true, true, true>(acc, lds, g, wave, rbB, kt + 1, Abase, aoffb, Bbase, boffb, ldbB, img, astr);
    }
    f8_w32_step<true, true, true>(acc, lds, g, wave, rbA, nk - 4, Abase, aoffb, Bbase, boffb, ldbB, img, astr);
    f8_w32_step<true, false, true>(acc, lds, g, wave, rbB, nk - 3, Abase, aoffb, Bbase, boffb, ldbB, img, astr);
    f8_w32_step<true, false, false>(acc, lds, g, wave, rbA, nk - 2, Abase, aoffb, Bbase, boffb, ldbB, img, astr);
    f8_w32_step<false, false, false>(acc, lds, g, wave, rbB, nk - 1, Abase, aoffb, Bbase, boffb, ldbB, img, astr);
    __syncthreads();
#undef F8_LOADB
}

struct EpiLane { int l15, lq, wm, wn; };
__device__ __forceinline__ EpiLane epi_lane(const GemmThread& g) { EpiLane e; e.l15 = g.l15; e.lq = g.lq; e.wm = g.wm; e.wn = g.wn; asm volatile("" : "+v"(e.l15), "+v"(e.lq)); return e; }
constexpr int STG_PITCH = 272, STG_WAVE = 64 * STG_PITCH;
#define stg_base(F) ((F).lds + (F).wave * STG_WAVE)
__device__ __forceinline__ void stg_put(char* tw, const EpiLane& el, int i, int j, u32x2 w) { *(u32x2*)(tw + (16 * i + el.l15) * STG_PITCH + (16 * j + 4 * el.lq) * 2) = w; }
__device__ __forceinline__ void stg_flush_(int lane, char* tw, bf16_t* dst, size_t ld) {
    int ln = lane; asm volatile("" : "+v"(ln));
#pragma unroll 4
    for (int q = 0; q < 16; ++q) { const int rl = q * 4 + (ln >> 4), chunk = ln & 15;
        *(u32x4*)(dst + (size_t)rl * ld + chunk * 8) = *(const u32x4*)(tw + rl * STG_PITCH + chunk * 16); }
    STG_BARRIER();
}
#define stg_flush(F, tw, dst, ld) stg_flush_((F).lane, tw, dst, ld)
__device__ __forceinline__ void acc_zero(f32x4 (&acc)[4][8]) {
#pragma unroll
    for (int i = 0; i < 4; ++i)
#pragma unroll
        for (int j = 0; j < 8; ++j) acc[i][j] = (f32x4){0.f, 0.f, 0.f, 0.f};
}
__device__ __forceinline__ bool patch_unit(int u, int nMt, int nNt, int& mt, int& nt) {
    const int pM = nMt / 8, p = u >> 5, q = u & 31;
    mt = (p % pM) * 8 + (q & 7); nt = (p / pM) * 4 + (q >> 3);
    return nt < nNt;
}
__device__ __forceinline__ int vcu_of_block(int bx, int G) { return (G % 8 == 0) ? (bx % 8) * (G / 8) + bx / 8 : bx; }

namespace attn {
constexpr int D = 128, NW = 8, QBLK = 32, KVBLK = 64;
constexpr float SCALE = 0.088388347648318440f;
constexpr float THR = 8.f;
constexpr int LDQ = AW, LDK = KVW, LDO = DM;
constexpr size_t SHM_V = KVBLK * D * 2, SHM_K = KVBLK * D * 2, SHM_ATTN = 2 * SHM_V + 2 * SHM_K + NW * 64 * 4;
#define KSWZ(row, colB) ((row) * 256 + ((colB) ^ (((row) & 7) << 4)))
#define SBAR() __builtin_amdgcn_sched_barrier(0)
__device__ __forceinline__ int crow(int r, int hi) { return (r & 3) + 8 * (r >> 2) + 4 * hi; }
__device__ __forceinline__ unsigned cvtpk(float lo, float hi) { return cvt_pk_bf16(lo, hi); }

__device__ __forceinline__ void partialSM(f32x16& p0, f32x16& p1, float& m_reg, float& mn, float& alpha) {
  constexpr float C = SCALE * 1.4426950408889634f;
  float pmax = p0[0]; for (int r = 1; r < 16; ++r) pmax = fmaxf(pmax, p0[r]); for (int r = 0; r < 16; ++r) pmax = fmaxf(pmax, p1[r]);
  { auto rr = __builtin_amdgcn_permlane32_swap(__float_as_uint(pmax), __float_as_uint(pmax), false, false);
    pmax = fmaxf(__uint_as_float(rr[0]), __uint_as_float(rr[1])); }
  if (__builtin_expect(__all(pmax - m_reg <= THR / SCALE), 1)) { mn = m_reg; alpha = 1.f; }
  else { mn = fmaxf(m_reg, pmax); alpha = __builtin_amdgcn_exp2f((m_reg - mn) * C); m_reg = mn; }
  float mnC = -mn * C;
  for (int r = 0; r < 16; ++r) p0[r] = fmaf(p0[r], C, mnC); for (int r = 0; r < 16; ++r) p1[r] = fmaf(p1[r], C, mnC);
  for (int r = 0; r < 16; ++r) p0[r] = __builtin_amdgcn_exp2f(p0[r]);
}
__device__ __forceinline__ void finishSM(f32x16& p0, f32x16& p1, float alpha, float& l_reg, bf16x8& pa0, bf16x8& pa1, bf16x8& pa2, bf16x8& pa3) {
  for (int r = 0; r < 16; ++r) p1[r] = __builtin_amdgcn_exp2f(p1[r]);
  float ps = 0; for (int r = 0; r < 16; ++r) ps += p0[r]; for (int r = 0; r < 16; ++r) ps += p1[r];
  { auto rr = __builtin_amdgcn_permlane32_swap(__float_as_uint(ps), __float_as_uint(ps), false, false);
    ps = __uint_as_float(rr[0]) + __uint_as_float(rr[1]); }
  l_reg = l_reg * alpha + ps;
#define PK4(P, BASE, OUT) do { unsigned a0 = cvtpk(P[BASE + 0], P[BASE + 1]), a1 = cvtpk(P[BASE + 2], P[BASE + 3]);   \
    unsigned b0 = cvtpk(P[BASE + 4], P[BASE + 5]), b1 = cvtpk(P[BASE + 6], P[BASE + 7]);                              \
    auto r0 = __builtin_amdgcn_permlane32_swap(a0, b0, false, false); auto r1 = __builtin_amdgcn_permlane32_swap(a1, b1, false, false); \
    u32x4 w = {r0[0], r1[0], r0[1], r1[1]}; OUT = *reinterpret_cast<bf16x8*>(&w); } while (0)
  PK4(p0, 0, pa0); PK4(p0, 8, pa1); PK4(p1, 0, pa2); PK4(p1, 8, pa3);
#undef PK4
}
__device__ __forceinline__ void qkt(f32x16& p0, f32x16& p1, const bf16_t* Ks, const bf16x8* qr, int r32, int hi) {
  p0 = f32x16{}; p1 = f32x16{};
  for (int d0 = 0; d0 < 8; ++d0) { int cb = (d0 * 16 + hi * 8) * 2;
    bf16x8 b0 = *reinterpret_cast<const bf16x8*>((const char*)Ks + KSWZ(r32, cb));
    bf16x8 b1 = *reinterpret_cast<const bf16x8*>((const char*)Ks + KSWZ(32 + r32, cb));
    p0 = __builtin_amdgcn_mfma_f32_32x32x16_bf16(b0, qr[d0], p0, 0, 0, 0);
    p1 = __builtin_amdgcn_mfma_f32_32x32x16_bf16(b1, qr[d0], p1, 0, 0, 0); }
}
__device__ __forceinline__ int v_st(int k, int c) { const int kk = (k & ~0xC) | ((k & 4) << 1) | ((k & 8) >> 1); return ((kk >> 3) * 4 + (c >> 5)) * 512 + ((kk & 7) * 32 + (c & 31)) * 2; }
__device__ __forceinline__ int v_rd_base(int lane) { return ((lane & 3) << 3) | (((lane >> 2) & 3) << 6) | (((lane >> 4) & 1) << 5) | (((lane >> 5) & 1) << 8); }
constexpr int v_rd_off(int d0, int ks, int half) { return d0 * 512 + ks * 4096 + half * 2048; }
template <int OFF> __device__ __forceinline__ s16x4 tr_read(int vb) {
  s16x4 r; asm volatile("ds_read_b64_tr_b16 %0, %1 offset:%2" : "=&v"(r) : "v"(vb), "i"(OFF) : "memory"); return r;
}
template <int D0> __device__ __forceinline__ void pv_one(f32x16& od, int vb, bf16x8 pa0, bf16x8 pa1, bf16x8 pa2, bf16x8 pa3) {
  const s16x4 l0 = tr_read<v_rd_off(D0, 0, 0)>(vb), h0 = tr_read<v_rd_off(D0, 0, 1)>(vb), l1 = tr_read<v_rd_off(D0, 1, 0)>(vb), h1 = tr_read<v_rd_off(D0, 1, 1)>(vb);
  const s16x4 l2 = tr_read<v_rd_off(D0, 2, 0)>(vb), h2 = tr_read<v_rd_off(D0, 2, 1)>(vb), l3 = tr_read<v_rd_off(D0, 3, 0)>(vb), h3 = tr_read<v_rd_off(D0, 3, 1)>(vb);
  asm volatile("s_waitcnt lgkmcnt(0)" ::: "memory"); SBAR();
#define PK(L, H) (bf16x8){L[0], L[1], L[2], L[3], H[0], H[1], H[2], H[3]}
  od = __builtin_amdgcn_mfma_f32_32x32x16_bf16(pa0, PK(l0, h0), od, 0, 0, 0);
  od = __builtin_amdgcn_mfma_f32_32x32x16_bf16(pa1, PK(l1, h1), od, 0, 0, 0);
  od = __builtin_amdgcn_mfma_f32_32x32x16_bf16(pa2, PK(l2, h2), od, 0, 0, 0);
  od = __builtin_amdgcn_mfma_f32_32x32x16_bf16(pa3, PK(l3, h3), od, 0, 0, 0);
#undef PK
}
__device__ __forceinline__ void pv_d0(f32x16* o, int vb, bf16x8 pa0, bf16x8 pa1, bf16x8 pa2, bf16x8 pa3) {
  pv_one<0>(o[0], vb, pa0, pa1, pa2, pa3); pv_one<1>(o[1], vb, pa0, pa1, pa2, pa3); pv_one<2>(o[2], vb, pa0, pa1, pa2, pa3); pv_one<3>(o[3], vb, pa0, pa1, pa2, pa3);
}
__device__ __forceinline__ void attn_dense_body(const bf16_t* __restrict__ Qb, const bf16_t* __restrict__ Kh, const bf16_t* __restrict__ Vh, bf16_t* __restrict__ Ob, int seq, char* lds) {
  const int tid = threadIdx.x, wid = tid >> 6, lane = tid & 63, r32 = lane & 31, hi = lane >> 5;
  bf16_t* V_lds = (bf16_t*)lds; bf16_t* K_lds = (bf16_t*)(lds + 2 * SHM_V);
  float* ws = (float*)(lds + 2 * SHM_V + 2 * SHM_K) + wid * 64; float* li_l = ws; float* al_l = ws + 32;
  float m_reg = -1e30f, l_reg = 0; f32x16 o[4] = {}; bf16x8 qr[8];
  const bf16_t* Qw = Qb + (long)(wid * QBLK + r32) * LDQ + hi * 8;
#pragma unroll
  for (int d0 = 0; d0 < 8; ++d0) qr[d0] = *reinterpret_cast<const bf16x8*>(Qw + d0 * 16);
  const int sr = tid >> 4, sc = (tid & 15) * 8, vst0 = v_st(sr, sc), vst1 = v_st(32 + sr, sc);
  const int vb0 = (int)(uintptr_t)V_lds + v_rd_base(lane);
  struct { bf16x8 vs0, vs1, ks0, ks1; } sr_[2];
#define LD8(p) (*reinterpret_cast<const bf16x8*>(p))
#define SLOAD(i, k0) do { sr_[i].vs0 = LD8(&Vh[(long)((k0) + sr) * LDK + sc]); sr_[i].vs1 = LD8(&Vh[(long)((k0) + 32 + sr) * LDK + sc]); \
    sr_[i].ks0 = LD8(&Kh[(long)((k0) + sr) * LDK + sc]); sr_[i].ks1 = LD8(&Kh[(long)((k0) + 32 + sr) * LDK + sc]); } while (0)
#define SWRITE(b, i) do { *(bf16x8*)((char*)V_lds + (b) * SHM_V + vst0) = sr_[i].vs0;          \
    *(bf16x8*)((char*)V_lds + (b) * SHM_V + vst1) = sr_[i].vs1; int kc = sc * 2;               \
    *(bf16x8*)((char*)K_lds + (b) * SHM_K + KSWZ(sr, kc)) = sr_[i].ks0;                       \
    *(bf16x8*)((char*)K_lds + (b) * SHM_K + KSWZ(32 + sr, kc)) = sr_[i].ks1; } while (0)
#define SWAIT() do { asm volatile("s_waitcnt vmcnt(4)" ::: "memory"); } while (0)
#define RESC(a) do { if (__any((a) < 1.f)) { if (hi == 0) al_l[r32] = (a); asm volatile("s_waitcnt lgkmcnt(0)" ::: "memory"); \
    for (int d = 0; d < 4; ++d) for (int r = 0; r < 16; ++r) o[d][r] *= al_l[crow(r, hi)]; } } while (0)
  f32x16 pA0, pA1, pB0, pB1; float mnA, mnB, alA, alB; bf16x8 pa0, pa1, pa2, pa3; const int NT = seq / KVBLK;
  constexpr int SE = 0, SO = 1;
  SLOAD(SE, 0); asm volatile("s_waitcnt vmcnt(0)" ::: "memory"); SWRITE(0, SE); __syncthreads();
  qkt(pA0, pA1, K_lds, qr, r32, hi); partialSM(pA0, pA1, m_reg, mnA, alA);
  SLOAD(SO, KVBLK); if (2 < NT) SLOAD(SE, 2 * KVBLK);
  SWAIT(); SWRITE(1, SO); __syncthreads();
  for (int j = 1; j + 1 < NT; j += 2) {
    SBAR(); qkt(pB0, pB1, (bf16_t*)((char*)K_lds + SHM_K), qr, r32, hi);
    finishSM(pA0, pA1, alA, l_reg, pa0, pa1, pa2, pa3); SBAR();
    SLOAD(SO, (j + 2) * KVBLK); SBAR();
    pv_d0(o, vb0, pa0, pa1, pa2, pa3); partialSM(pB0, pB1, m_reg, mnB, alB);
    __syncthreads(); SWAIT(); SWRITE(0, SE);
    RESC(alB); __syncthreads();
    SBAR(); qkt(pA0, pA1, K_lds, qr, r32, hi);
    finishSM(pB0, pB1, alB, l_reg, pa0, pa1, pa2, pa3); SBAR();
    if (j + 3 < NT) SLOAD(SE, (j + 3) * KVBLK); SBAR();
    pv_d0(o, vb0 + (int)SHM_V, pa0, pa1, pa2, pa3); partialSM(pA0, pA1, m_reg, mnA, alA);
    __syncthreads(); SWAIT(); SWRITE(1, SO);
    RESC(alA); __syncthreads();
  }
  SBAR(); qkt(pB0, pB1, (bf16_t*)((char*)K_lds + SHM_K), qr, r32, hi);
  finishSM(pA0, pA1, alA, l_reg, pa0, pa1, pa2, pa3); SBAR();
  pv_d0(o, vb0, pa0, pa1, pa2, pa3); partialSM(pB0, pB1, m_reg, mnB, alB);
  __syncthreads(); RESC(alB);
  finishSM(pB0, pB1, alB, l_reg, pa0, pa1, pa2, pa3); SBAR();
  pv_d0(o, vb0 + (int)SHM_V, pa0, pa1, pa2, pa3);
  if (hi == 0) li_l[r32] = l_reg; asm volatile("s_waitcnt lgkmcnt(0)" ::: "memory");
  float rli[16];
#pragma unroll
  for (int r = 0; r < 16; ++r) rli[r] = __builtin_amdgcn_rcpf(li_l[crow(r, hi)]);
  bf16_t* Ow = Ob + (long)(wid * QBLK) * LDO;
#pragma unroll
  for (int r = 0; r < 16; ++r) { int orow = crow(r, hi);
    for (int d0 = 0; d0 < 4; ++d0) Ow[(long)orow * LDO + d0 * 32 + r32] = f2bf(o[d0][r] * rli[r]); }
#undef LD8
#undef SLOAD
#undef SWRITE
#undef SWAIT
#undef RESC
}
}

struct Frame {
    char* lds;
    const Args* a;
    int tid, lane, wave, G, bx;
    int xl, rk;
};
template <class T> __device__ __forceinline__ T* uni(T* p) {
    const unsigned long long v = (unsigned long long)p;
    const unsigned lo = __builtin_amdgcn_readfirstlane((unsigned)v), hi = __builtin_amdgcn_readfirstlane((unsigned)(v >> 32));
    typedef __attribute__((address_space(1))) T* gptr_t;
    return (T*)(gptr_t)(((unsigned long long)hi << 32) | lo);
}
#define WSB() (uni(F.a->ws))
#define WSP(T, off) ((T*)(WSB() + (off)))
#define INP(i) (uni(F.a->in[i]))

__device__ __forceinline__ float mod_at(const Frame& F, int idx) { const float* mp = WSP(const float, WS_MODP); return mp[idx] + mp[4 * 12288 + idx]; }

__device__ __forceinline__ void build_cs(const Frame& F, int idx0, int idx1, int step) {
    bf16_t* cm = WSP(bf16_t, WS_CMAT);
    for (int idx = idx0; idx < idx1; idx += step) {
        const int mat = idx >> 19, s = (idx >> 8) & 2047, t0 = (idx & 255) * 8;
        float v[8];
#pragma unroll
        for (int e = 0; e < 8; ++e) { const float fr = (float)((s * (t0 + e)) & 2047) * (1.f / 2048.f);
            v[e] = mat ? -__builtin_amdgcn_sinf(fr) : __builtin_amdgcn_cosf(fr); }
        u32x4 w = {cvt_pk_bf16(v[0], v[1]), cvt_pk_bf16(v[2], v[3]), cvt_pk_bf16(v[4], v[5]), cvt_pk_bf16(v[6], v[7])};
        *(u32x4*)(cm + (size_t)s * 4096 + mat * 2048 + t0) = w;
    }
}
__device__ __forceinline__ void build_wimg(const Frame& F, const GemmThread& g, int t0, int t1, int step) {
    const float* w_in = INP(5); const float* w_out = INP(11);
    for (int t = t0; t < t1; t += step) {
        const float* srcp; char* dst; const int kt = t & 31, nt = t >> 5;
        if (nt < 10) { srcp = w_in + (size_t)(kt * 64 + 8 * g.kg) * INW + 512 + nt * 256 + 4 * g.ng; dst = (char*)(WSB() + WS_IMGIN) + (size_t)((nt + 4) * 32 + kt) * 32768; }
        else { srcp = w_out + (size_t)(kt * 64 + 8 * g.kg) * DM + (nt - 10) * 256 + 4 * g.ng; dst = (char*)(WSB() + WS_IMGOUT) + (size_t)((nt - 10) * 32 + kt) * 32768; }
        const size_t ld = nt < 10 ? INW : DM;
        f32x4 rb[8];
#pragma unroll
        for (int k = 0; k < 8; ++k) rb[k] = *(const f32x4*)(srcp + (size_t)k * ld);
#pragma unroll
        for (int j = 0; j < 4; ++j) { u32x4 w;
            w[0] = cvt_pk_bf16(rb[0][j], rb[1][j]); w[1] = cvt_pk_bf16(rb[2][j], rb[3][j]); w[2] = cvt_pk_bf16(rb[4][j], rb[5][j]); w[3] = cvt_pk_bf16(rb[6][j], rb[7][j]);
            *(u32x4*)(dst + g.imgw0 + j * 64) = w; }
    }
}
__device__ __forceinline__ void p0_prologue(const Frame& F) {
    const int tid = F.tid;
    const float* c = INP(1); const float* w_ada = INP(2); const float* b_ada = INP(3); const float* wf = INP(6);
    float* modp = WSP(float, WS_MODP);
    for (int item = F.bx; item < 256; item += F.G) {
        const int half = item & 1, cg = item >> 1;
        float* sc = (float*)F.lds;
        float* red = (float*)(F.lds + 16384);
        __syncthreads();
        for (int i = tid; i < 4096; i += NTHREADS) { const int b = i >> 10, k = i & 1023; const float cv = c[b * DM + half * 1024 + k]; sc[i] = cv / (1.f + __expf(-cv)); }
        __syncthreads();
        const int cq = tid % 24, kg = tid / 24;
        f32x4 am[4]; for (int b = 0; b < 4; ++b) am[b] = (f32x4){0.f, 0.f, 0.f, 0.f};
        if (kg < 21) {
            const float* wp = w_ada + (size_t)(half * 1024) * (NMOD * DM) + cg * 96 + cq * 4;
#pragma unroll 7
            for (int k = kg; k < 1024; k += 21) {
                const f32x4 w = *(const f32x4*)(wp + (size_t)k * (NMOD * DM));
#pragma unroll
                for (int b = 0; b < 4; ++b) am[b] += sc[b * 1024 + k] * w;
            }
#pragma unroll
            for (int b = 0; b < 4; ++b) *(f32x4*)(red + ((kg * 4 + b) * 96 + cq * 4)) = am[b];
        }
        __syncthreads();
        if (tid < 384) { const int b = tid / 96, col = tid % 96; float s = 0.f;
            for (int k2 = 0; k2 < 21; ++k2) s += red[(k2 * 4 + b) * 96 + col];
            if (half == 0) s += b_ada[cg * 96 + col];
            modp[(half * 4 + b) * 12288 + cg * 96 + col] = s; }
    }
    __syncthreads();
    {
        float* tc = (float*)F.lds; float* ts = tc + 128;
        if (tid < 128) { tc[tid] = cospif((float)tid / 64.f); ts[tid] = sinpif((float)tid / 64.f); }
        __syncthreads();
        float* g12 = WSP(float, WS_G12);
        const int lane = tid & 63, l15 = lane & 15, lq = lane >> 4;
        for (int item = F.bx * 8 + F.wave; item < 512; item += F.G * 8) {
            const int gp = item >> 6, g = gp >> 1, part = gp & 1, mt = (item >> 3) & 7, nt = item & 7;
            const float* tb = part ? ts : tc; const float* wp = wf + (size_t)g * 128 * 128 + nt * 16 + l15 + (size_t)(8 * lq) * 128;
            const int cc = mt * 16 + l15;
            f32x4 dacc = {0.f, 0.f, 0.f, 0.f};
            float wv[4][8];
#pragma unroll
            for (int ks = 0; ks < 4; ++ks)
#pragma unroll
                for (int q = 0; q < 8; ++q) wv[ks][q] = wp[(size_t)(ks * 32 + q) * 128];
#pragma unroll
            for (int ks = 0; ks < 4; ++ks) {
                u32x4 th, tl, wh, wl;
#pragma unroll
                for (int q = 0; q < 4; ++q) {
                    const int c2 = ks * 32 + 8 * lq + 2 * q;
                    const float t0 = tb[(cc * c2) & 127], t1 = tb[(cc * (c2 + 1)) & 127];
                    th[q] = cvt_pk_bf16(t0, t1); tl[q] = cvt_pk_bf16(t0 - bflo(th[q]), t1 - bfhi(th[q]));
                    wh[q] = cvt_pk_bf16(wv[ks][2 * q], wv[ks][2 * q + 1]); wl[q] = cvt_pk_bf16(wv[ks][2 * q] - bflo(wh[q]), wv[ks][2 * q + 1] - bfhi(wh[q]));
                }
                const bf16x8 ah = __builtin_bit_cast(bf16x8, th), al = __builtin_bit_cast(bf16x8, tl), bh = __builtin_bit_cast(bf16x8, wh), bl = __builtin_bit_cast(bf16x8, wl);
                dacc = __builtin_amdgcn_mfma_f32_16x16x32_bf16(ah, bh, dacc, 0, 0, 0);
                dacc = __builtin_amdgcn_mfma_f32_16x16x32_bf16(ah, bl, dacc, 0, 0, 0);
                dacc = __builtin_amdgcn_mfma_f32_16x16x32_bf16(al, bh, dacc, 0, 0, 0);
            }
#pragma unroll
            for (int r = 0; r < 4; ++r) g12[((size_t)g * 128 + mt * 16 + 4 * lq + r) * 256 + part * 128 + nt * 16 + l15] = dacc[r] * (1.f / 512.f);
        }
        __syncthreads();
    }
    {
        const GemmThread g = gemm_thread_init();
        if (F.G != 256) { build_cs(F, F.bx * NTHREADS + tid, 2 * 2048 * 256, F.G * NTHREADS); build_wimg(F, g, F.bx, (10 + 8) * 32, F.G); }
        else build_wimg(F, g, F.bx, 10 * 32, F.G);
    }
    {
        f32x2* rp = WSP(f32x2, WS_ROPE);
        for (int idx = F.bx * NTHREADS + tid; idx < 2048 * 64; idx += F.G * NTHREADS) {
            const int s = idx >> 6, p = idx & 63, i = p & 31; const float pos = (float)(p < 32 ? (s >> 6) : (s & 63));
            const float inv = 1.0f / powf(10000.f, (float)(2 * i) / 64.f);
            float sn, cs; sincosf(pos * inv, &sn, &cs);
            rp[idx] = (f32x2){cs, sn};
        }
    }
}

__device__ __forceinline__ void p1_norm(const Frame& F) {
    const int tid = F.tid, lane = F.lane, wave = F.wave;
    const float* x = INP(0); const float* gpm = INP(4); const float* w_in = INP(5);
    bf16_t* h = WSP(bf16_t, WS_H);
    float* av = (float*)F.lds; float* sv = av + DM;
    for (int grp = F.bx; grp < NTOK / 32; grp += F.G) {
        const int row0 = grp * 32, b = row0 / SEQ;
        f32x4 xv[4][8];
#pragma unroll
        for (int rr = 0; rr < 4; ++rr) { const float* xr = x + (size_t)(row0 + wave * 4 + rr) * DM;
#pragma unroll
            for (int i = 0; i < 8; ++i) xv[rr][i] = *(const f32x4*)(xr + i * 256 + lane * 4); }
        __syncthreads();
        for (int k = tid; k < DM; k += NTHREADS) { av[k] = gpm[k] * (1.f + mod_at(F, b * 12288 + DM + k)); sv[k] = mod_at(F, b * 12288 + k); }
        __syncthreads();
#pragma unroll
        for (int rr = 0; rr < 4; ++rr) {
            const int row = row0 + wave * 4 + rr; float ss = 0.f;
#pragma unroll
            for (int i = 0; i < 8; ++i) ss += xv[rr][i][0] * xv[rr][i][0] + xv[rr][i][1] * xv[rr][i][1] + xv[rr][i][2] * xv[rr][i][2] + xv[rr][i][3] * xv[rr][i][3];
            ss = wave_sum(ss); const float rstd = rsqrtf(ss * (1.f / DM) + EPS);
#pragma unroll
            for (int i = 0; i < 8; ++i) { const int k = i * 256 + lane * 4; const f32x4 a4 = *(const f32x4*)(av + k), s4 = *(const f32x4*)(sv + k);
                u32x2 w = {cvt_pk_bf16(xv[rr][i][0] * rstd * a4[0] + s4[0], xv[rr][i][1] * rstd * a4[1] + s4[1]), cvt_pk_bf16(xv[rr][i][2] * rstd * a4[2] + s4[2], xv[rr][i][3] * rstd * a4[3] + s4[3])};
                *(u32x2*)(h + (size_t)row * DM + k) = w; }
        }
    }
    const float* g12 = WSP(const float, WS_G12);
    for (int item = F.bx * 8 + wave; item < 2048; item += F.G * 8) {
        const int ntile = item & 63, mgrp = item >> 6, l15 = lane & 15, lq = lane >> 4;
        const int n = ntile * 16 + l15, half = n >> 9, g = (n >> 7) & 3, j = n & 127;
        const float* gp = g12 + (size_t)g * 128 * 256 + half * 128 + j + (size_t)(8 * lq) * 256;
        bf16x8 yh[4], yl[4];
#pragma unroll
        for (int ks = 0; ks < 4; ++ks) {
            float v[8];
#pragma unroll
            for (int q = 0; q < 8; ++q) v[q] = gp[(size_t)(ks * 32 + q) * 256];
            u32x4 h, l;
#pragma unroll
            for (int q = 0; q < 4; ++q) { h[q] = cvt_pk_bf16(v[2 * q], v[2 * q + 1]); l[q] = cvt_pk_bf16(v[2 * q] - bflo(h[q]), v[2 * q + 1] - bfhi(h[q])); }
            yh[ks] = __builtin_bit_cast(bf16x8, h); yl[ks] = __builtin_bit_cast(bf16x8, l);
        }
        f32x4 xva[4][4][2];
#pragma unroll
        for (int mi = 0; mi < 4; ++mi) { const float* wp = w_in + (size_t)((mgrp * 4 + mi) * 16 + l15) * INW + g * 128 + 8 * lq;
#pragma unroll
            for (int ks = 0; ks < 4; ++ks) { xva[mi][ks][0] = *(const f32x4*)(wp + ks * 32); xva[mi][ks][1] = *(const f32x4*)(wp + ks * 32 + 4); } }
#pragma unroll
        for (int mi = 0; mi < 4; ++mi) {
            const int m0 = (mgrp * 4 + mi) * 16;
            f32x4 (&xv)[4][2] = xva[mi];
            f32x4 d = {0.f, 0.f, 0.f, 0.f};
#pragma unroll
            for (int ks = 0; ks < 4; ++ks) {
                u32x4 h, l;
#pragma unroll
                for (int q = 0; q < 2; ++q) {
                    h[2 * q] = cvt_pk_bf16(xv[ks][q][0], xv[ks][q][1]); h[2 * q + 1] = cvt_pk_bf16(xv[ks][q][2], xv[ks][q][3]);
                    l[2 * q] = cvt_pk_bf16(xv[ks][q][0] - bflo(h[2 * q]), xv[ks][q][1] - bfhi(h[2 * q])); l[2 * q + 1] = cvt_pk_bf16(xv[ks][q][2] - bflo(h[2 * q + 1]), xv[ks][q][3] - bfhi(h[2 * q + 1]));
                }
                const bf16x8 xh = __builtin_bit_cast(bf16x8, h), xl = __builtin_bit_cast(bf16x8, l);
                d = __builtin_amdgcn_mfma_f32_16x16x32_bf16(xh, yh[ks], d, 0, 0, 0);
                d = __builtin_amdgcn_mfma_f32_16x16x32_bf16(xh, yl[ks], d, 0, 0, 0);
                d = __builtin_amdgcn_mfma_f32_16x16x32_bf16(xl, yh[ks], d, 0, 0, 0);
            }
            const int k = m0 + 4 * lq, nt = n >> 8, brow = n & 255, kt = k >> 6, chunk = (k & 63) >> 3;
            u32x2 w = {cvt_pk_bf16(d[0], d[1]), cvt_pk_bf16(d[2], d[3])};
            *(u32x2*)((char*)(WSB() + WS_IMGIN) + (size_t)(nt * 32 + kt) * 32768 + (chunk >> 2) * 16384 + brow * 64 + ((((brow >> 2) & 3) ^ sw4(chunk & 3)) << 4) + (k & 4) * 2) = w;
        }
    }
}

__device__ __forceinline__ void p2_inproj(const Frame& F) {
    const GemmThread g = gemm_thread_init();
    const bf16_t* h = WSP(const bf16_t, WS_H);
    const float* qg = INP(7); const float* kgn = INP(8);
    const f32x2* rope = WSP(const f32x2, WS_ROPE);
    const int vcu = (F.G & 7) ? F.bx : F.xl * (F.G >> 3) + F.rk;
    for (int u = vcu; u < 512; u += F.G) {
        int mt, nt;
        if (!patch_unit(u, 32, 14, mt, nt)) {
            if (F.G == 256) { const int idle = ((u >> 5) - 12) * 16 + ((u & 31) - 16);
                int to = F.tid; asm volatile("" : "+v"(to));
                build_cs(F, idle * 16384 + to, (idle + 1) * 16384, NTHREADS);
                const GemmThread g2 = gemm_thread_init<true>();
                build_wimg(F, g2, 10 * 32 + idle * 4, 10 * 32 + idle * 4 + 4, 1); }
            continue; }
        f32x4 acc[4][8]; acc_zero(acc);
        unsigned aoff[2];
#pragma unroll
        for (int i = 0; i < 2; ++i) aoff[i] = (unsigned)(g.rrow0 + 16 * i) * (DM * 2u) + g.rchunk;
        const char* ab = (const char*)(h + (size_t)mt * 256 * DM);
        gemm_accum_ring(acc, F.lds, g, F.wave, F.lane, ab, aoff, (const char*)(WSB() + WS_IMGIN) + (size_t)(nt * 32) * 32768, DM / 64);
        const EpiLane el = epi_lane(g);
        if (nt < 4) {
            char* img = (char*)(WSB() + WS_IMGZ) + (size_t)((((mt >> 3) * 2 + (nt & 1)) * 64) + (nt >> 1) * 32 + (mt & 7) * 4 + el.wm) * 32768;
            char* tw = F.lds + F.wave * 16384;
#pragma unroll
            for (int i = 0; i < 4; ++i)
#pragma unroll
                for (int j = 0; j < 8; ++j)
#pragma unroll
                    for (int r = 0; r < 4; ++r) *(bf16_t*)(tw + (16 * j + 4 * el.lq + r) * 128 + (16 * i + el.l15) * 2) = f2bf(acc[i][j][r]);
            int ln = F.lane; asm volatile("" : "+v"(ln));
#pragma unroll
            for (int q = 0; q < 16; ++q) { const int idx = q * 64 + ln, nl = idx >> 3, chunk = idx & 7, n = 128 * el.wn + nl;
                const u32x4 v = *(const u32x4*)(tw + nl * 128 + chunk * 16);
                *(u32x4*)(img + (chunk >> 2) * 16384 + n * 64 + ((((n >> 2) & 3) ^ sw4(chunk & 3)) << 4)) = v; }
            STG_BARRIER();
        } else if (nt < 12) {
            const bool isq = nt < 10;
            const int head = isq ? (nt - 4) * 2 + el.wn : (nt - 10) * 2 + el.wn;
            const float* gn = isq ? qg : kgn;
            bf16_t* dstb = isq ? WSP(bf16_t, WS_Q) : WSP(bf16_t, WS_K); const int ldo = isq ? AW : KVW;
            char* twq = stg_base(F);
            float rstd[4];
#pragma unroll
            for (int i = 0; i < 4; ++i) {
                float ss = 0.f;
#pragma unroll
                for (int j = 0; j < 8; ++j) ss += acc[i][j][0] * acc[i][j][0] + acc[i][j][1] * acc[i][j][1] + acc[i][j][2] * acc[i][j][2] + acc[i][j][3] * acc[i][j][3];
                ss += __shfl_xor(ss, 16, 64); ss += __shfl_xor(ss, 32, 64);
                rstd[i] = rsqrtf(ss * (1.f / 128.f) + EPS);
            }
#pragma unroll
            for (int jb = 0; jb < 8; jb += 2) {
                f32x4 gvv[2], csv[2][4];
#pragma unroll
                for (int jj = 0; jj < 2; ++jj) { const int d = 16 * (jb + jj) + 4 * el.lq;
                    gvv[jj] = *(const f32x4*)(gn + d);
#pragma unroll
                    for (int i = 0; i < 4; ++i) { const int t = mt * 256 + 64 * el.wm + 16 * i + el.l15, sq = t & (SEQ - 1);
                        csv[jj][i] = *(const f32x4*)(rope + (size_t)sq * 64 + (d >> 1)); } }
#pragma unroll
                for (int jj = 0; jj < 2; ++jj) { const int j = jb + jj, d = 16 * j + 4 * el.lq;
                    const f32x4 gv = gvv[jj];
#pragma unroll
                    for (int i = 0; i < 4; ++i) {
                        const int t = mt * 256 + 64 * el.wm + 16 * i + el.l15; const f32x4 cs = csv[jj][i];
                        const float x0 = acc[i][j][0] * rstd[i] * gv[0], x1 = acc[i][j][1] * rstd[i] * gv[1];
                        const float x2 = acc[i][j][2] * rstd[i] * gv[2], x3 = acc[i][j][3] * rstd[i] * gv[3];
                        u32x2 w = {cvt_pk_bf16(x0 * cs[0] - x1 * cs[1], x0 * cs[1] + x1 * cs[0]), cvt_pk_bf16(x2 * cs[2] - x3 * cs[3], x2 * cs[3] + x3 * cs[2])};
                        stg_put(twq, el, i, j, w);
                    }
                }
            }
            stg_flush(F, twq, dstb + (size_t)(mt * 256 + 64 * el.wm) * ldo + head * 128, ldo);
        } else {
            bf16_t* vb = WSP(bf16_t, WS_V);
            char* tw = stg_base(F);
#pragma unroll
            for (int i = 0; i < 4; ++i)
#pragma unroll
                for (int j = 0; j < 8; ++j) stg_put(tw, el, i, j, (u32x2){cvt_pk_bf16(acc[i][j][0], acc[i][j][1]), cvt_pk_bf16(acc[i][j][2], acc[i][j][3])});
            stg_flush(F, tw, vb + (size_t)(mt * 256 + 64 * el.wm) * KVW + (nt - 12) * 256 + 128 * el.wn, KVW);
        }
    }
}

__device__ __forceinline__ void p3_dft_unit(const Frame& F, const GemmThread& g, int du) {
    const int mt = du & 7, nt = du >> 3, b = nt >> 1, g0 = (nt & 1) * 2;
    const bf16_t* cs = WSP(const bf16_t, WS_CMAT);
    f32x4 acc[4][8]; acc_zero(acc);
    unsigned aoff[2];
#pragma unroll
    for (int i = 0; i < 2; ++i) aoff[i] = (unsigned)(g.rrow0 + 16 * i) * 8192u + g.rchunk;
    gemm_accum_ring(acc, F.lds, g, F.wave, F.lane, (const char*)(cs + (size_t)mt * 256 * 4096), aoff, (const char*)(WSB() + WS_IMGZ) + (size_t)(nt * 64) * 32768, 64);
    bf16_t* mrg = WSP(bf16_t, WS_MRG);
    const EpiLane el = epi_lane(g);
    char* tw = stg_base(F);
#pragma unroll
    for (int i = 0; i < 4; ++i)
#pragma unroll
        for (int j = 0; j < 8; ++j) stg_put(tw, el, i, j, (u32x2){cvt_pk_bf16(acc[i][j][0], acc[i][j][1]), cvt_pk_bf16(acc[i][j][2], acc[i][j][3])});
    stg_flush(F, tw, mrg + (size_t)(b * SEQ + mt * 256 + 64 * el.wm) * DM + g0 * 128 + 128 * el.wn, DM);
}
__device__ __forceinline__ void p3_attn_unit(const Frame& F, int kvh  , int sub  ) {
    const int b = kvh >> 2, kv = kvh & 3, hq = kv * 3 + sub / 8, qb = sub % 8;
    const bf16_t* q = WSP(const bf16_t, WS_Q) + (size_t)(b * SEQ + qb * 256) * AW + hq * 128;
    const bf16_t* k = WSP(const bf16_t, WS_K) + (size_t)(b * SEQ) * KVW + kv * 128;
    const bf16_t* v = WSP(const bf16_t, WS_V) + (size_t)(b * SEQ) * KVW + kv * 128;
    bf16_t* o = WSP(bf16_t, WS_MRG) + (size_t)(b * SEQ + qb * 256) * DM + FW + hq * 128;
    attn::attn_dense_body(q, k, v, o, SEQ, F.lds);
}
__device__ __forceinline__ void p3_mixers(const Frame& F) {
    const GemmThread g = gemm_thread_init();
    const bool std = (F.G == 256); const int xl = F.xl, r = F.rk;
    int na, a0, astep, nd, d0, dstep;
    if (std) { na = (r < 24) ? 2 : 0; a0 = xl * 24 + r; astep = 8 * 24; nd = (r < 24) ? 0 : 1; d0 = xl * 8 + (r - 24); dstep = 1; }
    else { na = (384 - F.bx + F.G - 1) / F.G; if (F.bx >= 384) na = 0; a0 = F.bx; astep = F.G; nd = (64 - F.bx + F.G - 1) / F.G; if (F.bx >= 64) nd = 0; d0 = F.bx; dstep = F.G; }
#if (P3_MASK & 1)
    for (int it = 0; it < na; ++it) { const int u = a0 + it * astep; __syncthreads(); p3_attn_unit(F, u / 24, u % 24); }
#endif
#if (P3_MASK & 2)
    for (int it = 0; it < nd; ++it) { __syncthreads(); p3_dft_unit(F, g, d0 + it * dstep); }
#endif
}

__device__ __forceinline__ void p4_merge_norm(const Frame& F) {
    const float* gf = INP(9); const float* ga = INP(10);
    bf16_t* mrg = WSP(bf16_t, WS_MRG);
    for (int base = F.bx * 8 + F.wave; base < NTOK; base += 4 * F.G * 8) {
        u32x4 v[4][4];
#pragma unroll
        for (int q = 0; q < 4; ++q) { const int row = base + q * F.G * 8;
            if (row < NTOK) {
#pragma unroll
                for (int i = 0; i < 4; ++i) v[q][i] = *(const u32x4*)(mrg + (size_t)row * DM + (i * 64 + F.lane) * 8); } }
#pragma unroll
        for (int q = 0; q < 4; ++q) { const int row = base + q * F.G * 8;
            if (row < NTOK) {
                bf16_t* rp = mrg + (size_t)row * DM;
                float ssf = 0.f, ssa = 0.f;
#pragma unroll
                for (int i = 0; i < 4; ++i) { float s2 = 0.f;
#pragma unroll
                    for (int e = 0; e < 4; ++e) { const float a = bflo(v[q][i][e]), b2 = bfhi(v[q][i][e]); s2 += a * a + b2 * b2; }
                    if (i == 0) ssf = s2; else ssa += s2; }
                ssf = wave_sum(ssf); ssa = wave_sum(ssa);
                const float rf = rsqrtf(ssf * (1.f / FW) + EPS), ra = rsqrtf(ssa * (1.f / AW) + EPS);
#pragma unroll
                for (int i = 0; i < 4; ++i) { const int k = (i * 64 + F.lane) * 8; const float rs = (i == 0) ? rf : ra; const float* gp = (i == 0) ? (gf + k) : (ga + (k - FW));
                    const f32x4 g0 = *(const f32x4*)gp, g1 = *(const f32x4*)(gp + 4);
                    u32x4 w;
                    w[0] = cvt_pk_bf16(bflo(v[q][i][0]) * rs * g0[0], bfhi(v[q][i][0]) * rs * g0[1]); w[1] = cvt_pk_bf16(bflo(v[q][i][1]) * rs * g0[2], bfhi(v[q][i][1]) * rs * g0[3]);
                    w[2] = cvt_pk_bf16(bflo(v[q][i][2]) * rs * g1[0], bfhi(v[q][i][2]) * rs * g1[1]); w[3] = cvt_pk_bf16(bflo(v[q][i][3]) * rs * g1[2], bfhi(v[q][i][3]) * rs * g1[3]);
                    *(u32x4*)(rp + k) = w; }
            } }
    }
}

__device__ __forceinline__ void p5_outproj(const Frame& F) {
    const GemmThread g = gemm_thread_init();
    const bf16_t* mrg = WSP(const bf16_t, WS_MRG); bf16_t* mix = WSP(bf16_t, WS_MIX);
    const int vcu = (F.G & 7) ? F.bx : F.xl * (F.G >> 3) + F.rk;
    for (int u = vcu; u < 256; u += F.G) {
        int mt, nt; if (!patch_unit(u, 32, 8, mt, nt)) continue;
        f32x4 acc[4][8]; acc_zero(acc);
        unsigned aoff[2];
#pragma unroll
        for (int i = 0; i < 2; ++i) aoff[i] = (unsigned)(g.rrow0 + 16 * i) * (DM * 2u) + g.rchunk;
        gemm_accum_ring(acc, F.lds, g, F.wave, F.lane, (const char*)(mrg + (size_t)mt * 256 * DM), aoff, (const char*)(WSB() + WS_IMGOUT) + (size_t)(nt * 32) * 32768, DM / 64);
        const EpiLane el = epi_lane(g);
        char* tw = stg_base(F);
#pragma unroll
        for (int i = 0; i < 4; ++i)
#pragma unroll
            for (int j = 0; j < 8; ++j) stg_put(tw, el, i, j, (u32x2){cvt_pk_bf16(acc[i][j][0], acc[i][j][1]), cvt_pk_bf16(acc[i][j][2], acc[i][j][3])});
        stg_flush(F, tw, mix + (size_t)(mt * 256 + 64 * el.wm) * DM + nt * 256 + 128 * el.wn, DM);
    }
}

__device__ __forceinline__ void p6_postmix(const Frame& F) {
    const int tid = F.tid, lane = F.lane, wave = F.wave;
    const float* x = INP(0); const float* gpost = INP(12); const float* gpre = INP(13);
    const float* w_router = INP(14); const float* b_router = INP(15);
    const bf16_t* mix = WSP(const bf16_t, WS_MIX); float* x1b = WSP(float, WS_X1); unsigned char* h2b = WSP(unsigned char, WS_H2);
    int* list = WSP(int, WS_LIST); float* gatev = WSP(float, WS_GATEV); unsigned* cnt = (unsigned*)(WSB() + WS_CTL + CTL_CNT_OFF);
    float* gm = (float*)F.lds; float* af = gm + DM; float* sf = af + DM;
    constexpr int RP = 528;
    char* HAh = F.lds + 24576; char* HAl = HAh + 32 * RP; char* WBh = HAl + 32 * RP; char* WBl = WBh + 32 * RP;
    float* RED = (float*)(WBl + 32 * RP);
    float* LOG = RED + 8 * 32 * 32;
    int* s_cnt = (int*)(LOG + 32 * 32); int* s_base = s_cnt + 32; int* s_e = s_base + 32; int* s_lr = s_e + 128;
    for (int grp = F.bx; grp < NTOK / 32; grp += F.G) {
        const int row0 = grp * 32, b = row0 / SEQ;
        __syncthreads();
        for (int k = tid; k < DM; k += NTHREADS) {
            gm[k] = mod_at(F, b * 12288 + 2 * DM + k) * gpost[k];
            af[k] = gpre[k] * (1.f + mod_at(F, b * 12288 + 4 * DM + k));
            sf[k] = mod_at(F, b * 12288 + 3 * DM + k); }
        if (tid < 32) s_cnt[tid] = 0;
        __syncthreads();
        const unsigned lo16 = (unsigned)lane * 16u, lo8 = (unsigned)lane * 8u;
        float r2v[4];
#pragma unroll
        for (int rr = 0; rr < 4; ++rr) r2v[rr] = 0.f;
#pragma unroll 1
        for (int rr = 0; rr < 4; ++rr) {
            const int row = row0 + wave * 4 + rr;
            float ss = 0.f; f32x4 mv[8];
#pragma unroll
            for (int i = 0; i < 8; ++i) { const u32x2 m2 = *(const u32x2*)((const char*)(mix + (size_t)row * DM + i * 256) + lo8);
                mv[i] = (f32x4){bflo(m2[0]), bfhi(m2[0]), bflo(m2[1]), bfhi(m2[1])};
                ss += mv[i][0] * mv[i][0] + mv[i][1] * mv[i][1] + mv[i][2] * mv[i][2] + mv[i][3] * mv[i][3]; }
            ss = wave_sum(ss); const float r1 = rsqrtf(ss * (1.f / DM) + EPS);
            float s2 = 0.f;
            f32x4 xrow[8];
#pragma unroll
            for (int i = 0; i < 8; ++i) xrow[i] = *(const f32x4*)((const char*)(x + (size_t)row * DM + i * 256) + lo16);
#pragma unroll
            for (int i = 0; i < 8; ++i) { const int k = i * 256 + lane * 4; const f32x4 xv = xrow[i]; const f32x4 g4 = *(const f32x4*)(gm + k);
                f32x4 v1; for (int e = 0; e < 4; ++e) v1[e] = xv[e] + g4[e] * (mv[i][e] * r1);
                *(f32x4*)((char*)(x1b + (size_t)row * DM + i * 256) + lo16) = v1; mv[i] = v1;
#if DEBUG_X1
                *(f32x4*)((char*)(uni(F.a->out) + (size_t)row * DM + i * 256) + lo16) = v1;
#endif
                s2 += v1[0] * v1[0] + v1[1] * v1[1] + v1[2] * v1[2] + v1[3] * v1[3]; }
            s2 = wave_sum(s2); const float r2 = rsqrtf(s2 * (1.f / DM) + EPS);
            r2v[0] = rr == 0 ? r2 : r2v[0]; r2v[1] = rr == 1 ? r2 : r2v[1]; r2v[2] = rr == 2 ? r2 : r2v[2]; r2v[3] = rr == 3 ? r2 : r2v[3];
#pragma unroll
            for (int i = 0; i < 8; ++i) { const int k = i * 256 + lane * 4; const f32x4 a4 = *(const f32x4*)(af + k), s4 = *(const f32x4*)(sf + k);
                float h0 = (mv[i][0] * r2 * a4[0] + s4[0]) * FP8_SA, h1 = (mv[i][1] * r2 * a4[1] + s4[1]) * FP8_SA, h2_ = (mv[i][2] * r2 * a4[2] + s4[2]) * FP8_SA, h3 = (mv[i][3] * r2 * a4[3] + s4[3]) * FP8_SA;
                h0 = fminf(fmaxf(h0, -448.f), 448.f); h1 = fminf(fmaxf(h1, -448.f), 448.f); h2_ = fminf(fmaxf(h2_, -448.f), 448.f); h3 = fminf(fmaxf(h3, -448.f), 448.f);
                *(unsigned*)(h2b + (size_t)row * DM + i * 256 + lane * 4) = cvt4_fp8(h0, h1, h2_, h3); }
        }
        f32x4 racc[2][2];
#pragma unroll
        for (int m = 0; m < 2; ++m)
#pragma unroll
            for (int n = 0; n < 2; ++n) racc[m][n] = (f32x4){0.f, 0.f, 0.f, 0.f};
        const int l15 = lane & 15, lq = lane >> 4;
#pragma unroll 1
        for (int i = 0; i < 8; ++i) {
            __syncthreads();
            {
                const int k = i * 256 + lane * 4; const f32x4 a4 = *(const f32x4*)(af + k), s4 = *(const f32x4*)(sf + k);
#pragma unroll
                for (int rr = 0; rr < 4; ++rr) {
                    const f32x4 xv = *(const f32x4*)((const char*)(x1b + (size_t)(row0 + wave * 4 + rr) * DM + i * 256) + lo16);
                    const float r2 = rr == 0 ? r2v[0] : rr == 1 ? r2v[1] : rr == 2 ? r2v[2] : r2v[3];
                    float h0 = xv[0] * r2 * a4[0] + s4[0], h1 = xv[1] * r2 * a4[1] + s4[1], h2_ = xv[2] * r2 * a4[2] + s4[2], h3 = xv[3] * r2 * a4[3] + s4[3];
                    const unsigned p0 = cvt_pk_bf16(h0, h1), p1 = cvt_pk_bf16(h2_, h3);
                    const unsigned q0 = cvt_pk_bf16(h0 - bflo(p0), h1 - bfhi(p0)), q1 = cvt_pk_bf16(h2_ - bflo(p1), h3 - bfhi(p1));
                    const int off = (wave * 4 + rr) * RP + lane * 8;
                    *(u32x2*)(HAh + off) = (u32x2){p0, p1}; *(u32x2*)(HAl + off) = (u32x2){q0, q1};
                }
            }
            {
                const int k4 = tid & 63, e4 = tid >> 6;
                f32x4 wv[4];
#pragma unroll
                for (int kk = 0; kk < 4; ++kk) wv[kk] = *(const f32x4*)(w_router + (size_t)(i * 256 + 4 * k4 + kk) * NEXP + 4 * e4);
#pragma unroll
                for (int j = 0; j < 4; ++j) {
                    const unsigned p0 = cvt_pk_bf16(wv[0][j], wv[1][j]), p1 = cvt_pk_bf16(wv[2][j], wv[3][j]);
                    const unsigned q0 = cvt_pk_bf16(wv[0][j] - bflo(p0), wv[1][j] - bfhi(p0)), q1 = cvt_pk_bf16(wv[2][j] - bflo(p1), wv[3][j] - bfhi(p1));
                    const int off = (4 * e4 + j) * RP + k4 * 8;
                    *(u32x2*)(WBh + off) = (u32x2){p0, p1}; *(u32x2*)(WBl + off) = (u32x2){q0, q1};
                }
            }
            __syncthreads();
            bf16x8 ah[2], al[2], bh[2], bl[2];
            const int fo = l15 * RP + wave * 64 + lq * 16;
#pragma unroll
            for (int m = 0; m < 2; ++m) { ah[m] = *(const bf16x8*)(HAh + fo + m * 16 * RP); al[m] = *(const bf16x8*)(HAl + fo + m * 16 * RP);
                                          bh[m] = *(const bf16x8*)(WBh + fo + m * 16 * RP); bl[m] = *(const bf16x8*)(WBl + fo + m * 16 * RP); }
#pragma unroll
            for (int m = 0; m < 2; ++m)
#pragma unroll
                for (int n = 0; n < 2; ++n) {
                    racc[m][n] = __builtin_amdgcn_mfma_f32_16x16x32_bf16(ah[m], bh[n], racc[m][n], 0, 0, 0);
                    racc[m][n] = __builtin_amdgcn_mfma_f32_16x16x32_bf16(ah[m], bl[n], racc[m][n], 0, 0, 0);
                    racc[m][n] = __builtin_amdgcn_mfma_f32_16x16x32_bf16(al[m], bh[n], racc[m][n], 0, 0, 0);
                }
        }
#pragma unroll
        for (int m = 0; m < 2; ++m)
#pragma unroll
            for (int n = 0; n < 2; ++n)
#pragma unroll
                for (int r = 0; r < 4; ++r) RED[(wave * 32 + 16 * m + 4 * lq + r) * 32 + 16 * n + l15] = racc[m][n][r];
        __syncthreads();
        { const int tk = tid >> 4, e2 = (tid & 15) * 2; float s0 = b_router[e2], s1 = b_router[e2 + 1];
#pragma unroll
            for (int w = 0; w < 8; ++w) { s0 += RED[(w * 32 + tk) * 32 + e2]; s1 += RED[(w * 32 + tk) * 32 + e2 + 1]; }
            LOG[tk * 32 + e2] = s0; LOG[tk * 32 + e2 + 1] = s1; }
        __syncthreads();
#pragma unroll 1
        for (int rr = 0; rr < 4; ++rr) {
            float val = LOG[(wave * 4 + rr) * 32 + (lane & 31)];
            float tv[4]; int te[4];
#pragma unroll
            for (int kk = 0; kk < 4; ++kk) {
                float m = val;
#pragma unroll
                for (int o = 16; o >= 1; o >>= 1) m = fmaxf(m, __shfl_xor(m, o, 64));
                const unsigned long long bal = __ballot(val == m);
                const int e = __ffsll((long long)bal) - 1;
                tv[kk] = m; te[kk] = e & 31; if ((lane & 31) == (e & 31)) val = -INFINITY;
            }
            const float p1 = __expf(tv[1] - tv[0]), p2 = __expf(tv[2] - tv[0]), p3 = __expf(tv[3] - tv[0]); const float inv = 1.f / (1.f + p1 + p2 + p3);
            if (lane < 4) {
                const int e = lane == 0 ? te[0] : lane == 1 ? te[1] : lane == 2 ? te[2] : te[3];
                const float gt = (lane == 0 ? 1.f : lane == 1 ? p1 : lane == 2 ? p2 : p3) * inv;
                const int al = (wave * 4 + rr) * 4 + lane;
                s_e[al] = e; s_lr[al] = atomicAdd(&s_cnt[e], 1);
                gatev[row0 * 4 + al] = gt;
            }
        }
        __syncthreads();
        if (tid < 32) { int t2 = tid; asm volatile("" : "+v"(t2));
            s_base[tid] = (int)__hip_atomic_fetch_add(&cnt[t2], (unsigned)s_cnt[tid], __ATOMIC_RELAXED, __HIP_MEMORY_SCOPE_AGENT); }
        __syncthreads();
        if (tid < 128) { const int e = s_e[tid]; list[e * 8192 + s_base[e] + s_lr[tid]] = row0 * 4 + tid; }
    }
}

struct MoeTab { int* tiles; int* rowbase; int* cnt; int* pt; };
__device__ __forceinline__ MoeTab moe_tab(const Frame& F) {
    MoeTab t; t.tiles = (int*)(F.lds + LDS_MISC + 64); t.rowbase = t.tiles + 32; t.cnt = t.rowbase + 32; t.pt = t.cnt + 32;
    unsigned* cnt = (unsigned*)(WSB() + WS_CTL + CTL_CNT_OFF);
    __syncthreads();
    if (F.tid < 32) { const int n = (int)__hip_atomic_load(&cnt[F.tid], __ATOMIC_RELAXED, __HIP_MEMORY_SCOPE_AGENT); t.cnt[F.tid] = n; t.tiles[F.tid] = (n + 255) >> 8; }
    __syncthreads();
    if (F.tid == 0) { int s = 0, p = 0; for (int e = 0; e < 32; ++e) { t.rowbase[e] = s; s += t.tiles[e] * 256; t.pt[e] = p; p += t.tiles[e] > 2 ? t.tiles[e] - 2 : 0; } t.pt[32] = p; }
    __syncthreads();
    return t;
}
__device__ __forceinline__ void moe_tile_of(const MoeTab& t, int tix, int& e, int& mt) {
    int ee = 0;
#pragma unroll 1
    for (int k = 1; k < 32; ++k) ee = (tix >= t.pt[k]) ? k : ee;
    e = ee; mt = 2 + tix - t.pt[ee];
}

__device__ __forceinline__ void moe_up_epilogue(const Frame& F, const GemmThread& g, const f32x4 (&acc)[4][8], int e, int mt, int nt, int ne, int rowb) {
    const float* b_gate = INP(17); const float* b_up = INP(19); unsigned char* act = WSP(unsigned char, WS_ACT);
    const EpiLane el = epi_lane(g);
    char* tw = F.lds + F.wave * 4096;
    f32x4 bg[4], bu[4];
#pragma unroll
    for (int j = 0; j < 4; ++j) { const int col = nt * 128 + 64 * el.wn + 16 * j + 4 * el.lq;
        bg[j] = *(const f32x4*)(b_gate + (size_t)e * DM + col); bu[j] = *(const f32x4*)(b_up + (size_t)e * DM + col); }
#pragma unroll
    for (int j = 0; j < 4; ++j) {
        const int col = nt * 128 + 64 * el.wn + 16 * j + 4 * el.lq;
#pragma unroll
        for (int i = 0; i < 4; ++i) {
            const int ml = 64 * el.wm + 16 * i + el.l15;
            float o[4];
#pragma unroll
            for (int q = 0; q < 4; ++q) { float gg = acc[i][j][q] * (1.f / (FP8_SA * FP8_SW)) + bg[j][q], uu = acc[i][j + 4][q] * (1.f / (FP8_SA * FP8_SW)) + bu[j][q];
                gg = fminf(gg, 7.f); uu = fminf(fmaxf(uu, -7.f), 7.f);
                o[q] = (uu + 1.f) * gg * __builtin_amdgcn_rcpf(1.f + __expf(-1.702f * gg)); }
            *(unsigned*)(tw + (16 * i + el.l15) * 64 + 16 * j + 4 * el.lq) = cvt4_fp8(o[0] * FP8_SACT, o[1] * FP8_SACT, o[2] * FP8_SACT, o[3] * FP8_SACT);
        }
    }
    { int ln = F.lane; asm volatile("" : "+v"(ln));
      char* dst = (char*)act + ((size_t)(rowb >> 8) * 32 + nt * 2 + el.wn) * 16384 + (64 * el.wm) * 64;
#pragma unroll
      for (int q = 0; q < 4; ++q) *(u32x4*)(dst + q * 1024 + ln * 16) = *(const u32x4*)(tw + q * 1024 + ln * 16); }
    STG_BARRIER();
}
__device__ __forceinline__ void moe_dn_epilogue(const Frame& F, const GemmThread& g, const f32x4 (&acc)[4][8], int e, int mt, int nt, int ne) {
    const float* b_down = INP(21); const int* list = WSP(const int, WS_LIST); const float* gatev = WSP(const float, WS_GATEV); bf16_t* outb = WSP(bf16_t, WS_OUTB);
    const EpiLane el = epi_lane(g);
    constexpr float RS = 1.f / (FP8_SACT * FP8_SW);
    int av[4]; float gtv[4]; f32x4 bd[8];
#pragma unroll
    for (int i = 0; i < 4; ++i) { int rk = mt * 256 + 64 * el.wm + 16 * i + el.l15; rk = rk < ne ? rk : ne - 1; av[i] = list[e * 8192 + rk]; }
#pragma unroll
    for (int j = 0; j < 8; ++j) bd[j] = *(const f32x4*)(b_down + (size_t)e * DM + nt * 256 + 128 * el.wn + 16 * j + 4 * el.lq);
#pragma unroll
    for (int i = 0; i < 4; ++i) gtv[i] = gatev[av[i]];
    char* tw = F.lds + F.wave * 8704;
    int ln = F.lane; asm volatile("" : "+v"(ln));
#pragma unroll
    for (int hf = 0; hf < 2; ++hf) {
#pragma unroll
        for (int ii = 0; ii < 2; ++ii) { const int i = 2 * hf + ii; const float gt = gtv[i];
#pragma unroll
            for (int j = 0; j < 8; ++j) {
                u32x2 w = {cvt_pk_bf16((acc[i][j][0] * RS + bd[j][0]) * gt, (acc[i][j][1] * RS + bd[j][1]) * gt), cvt_pk_bf16((acc[i][j][2] * RS + bd[j][2]) * gt, (acc[i][j][3] * RS + bd[j][3]) * gt)};
                *(u32x2*)(tw + (16 * ii + el.l15) * 272 + (16 * j + 4 * el.lq) * 2) = w; } }
#pragma unroll
        for (int q = 0; q < 8; ++q) {
            const int rl = q * 4 + (ln >> 4), chunk = ln & 15;
            const int a = __shfl(av[2 * hf + (q >> 2)], rl & 15, 64);
            const u32x4 v = *(const u32x4*)(tw + rl * 272 + chunk * 16);
            if (mt * 256 + 64 * el.wm + 32 * hf + rl < ne) *(u32x4*)(outb + (size_t)a * DM + nt * 256 + 128 * el.wn + chunk * 8) = v;
        }
    }
    STG_BARRIER();
}
__device__ __forceinline__ void moe_up_epilogue32(const Frame& F, const GemmThread& g, const f32x16 (&acc)[2][4], int e, int mt, int nt, int ne, int rowb) {
    const float* b_gate = INP(17); const float* b_up = INP(19); unsigned char* act = WSP(unsigned char, WS_ACT);
    int l31 = F.lane & 31, lh = F.lane >> 5; asm volatile("" : "+v"(l31), "+v"(lh));
    char* tw = F.lds + F.wave * 4096;
    f32x4 bg[2][4], bu[2][4];
#pragma unroll
    for (int j = 0; j < 2; ++j)
#pragma unroll
        for (int q4 = 0; q4 < 4; ++q4) { const int col = nt * 128 + 64 * g.wn + 32 * j + 8 * q4 + 4 * lh;
            bg[j][q4] = *(const f32x4*)(b_gate + (size_t)e * DM + col); bu[j][q4] = *(const f32x4*)(b_up + (size_t)e * DM + col); }
#pragma unroll
    for (int j = 0; j < 2; ++j)
#pragma unroll
        for (int q4 = 0; q4 < 4; ++q4) {
            const int col = nt * 128 + 64 * g.wn + 32 * j + 8 * q4 + 4 * lh;
#pragma unroll
            for (int i = 0; i < 2; ++i) {
                const int ml = 64 * g.wm + 32 * i + l31;
                float o[4];
#pragma unroll
                for (int q = 0; q < 4; ++q) { float gg = acc[i][j][4 * q4 + q] * (1.f / (FP8_SA * FP8_SW)) + bg[j][q4][q], uu = acc[i][j + 2][4 * q4 + q] * (1.f / (FP8_SA * FP8_SW)) + bu[j][q4][q];
                    gg = fminf(gg, 7.f); uu = fminf(fmaxf(uu, -7.f), 7.f);
                    o[q] = (uu + 1.f) * gg * __builtin_amdgcn_rcpf(1.f + __expf(-1.702f * gg)); }
                *(unsigned*)(tw + (32 * i + l31) * 64 + 32 * j + 8 * q4 + 4 * lh) = cvt4_fp8(o[0] * FP8_SACT, o[1] * FP8_SACT, o[2] * FP8_SACT, o[3] * FP8_SACT);
            }
        }
    { int ln = F.lane; asm volatile("" : "+v"(ln));
      char* dst = (char*)act + ((size_t)(rowb >> 8) * 32 + nt * 2 + g.wn) * 16384 + (64 * g.wm) * 64;
#pragma unroll
      for (int q = 0; q < 4; ++q) *(u32x4*)(dst + q * 1024 + ln * 16) = *(const u32x4*)(tw + q * 1024 + ln * 16); }
    STG_BARRIER();
}
__device__ __forceinline__ void moe_dn_epilogue32(const Frame& F, const GemmThread& g, const f32x16 (&acc)[2][4], int e, int mt, int nt, int ne) {
    const float* b_down = INP(21); const int* list = WSP(const int, WS_LIST); const float* gatev = WSP(const float, WS_GATEV); bf16_t* outb = WSP(bf16_t, WS_OUTB);
    int l31 = F.lane & 31, lh = F.lane >> 5; asm volatile("" : "+v"(l31), "+v"(lh));
    constexpr float RS = 1.f / (FP8_SACT * FP8_SW);
    int av[2]; float gtv[2]; f32x4 bd[4][4];
#pragma unroll
    for (int i = 0; i < 2; ++i) { int rk = mt * 256 + 64 * g.wm + 32 * i + l31; rk = rk < ne ? rk : ne - 1; av[i] = list[e * 8192 + rk]; }
#pragma unroll
    for (int j = 0; j < 4; ++j)
#pragma unroll
        for (int q4 = 0; q4 < 4; ++q4) bd[j][q4] = *(const f32x4*)(b_down + (size_t)e * DM + nt * 256 + 128 * g.wn + 32 * j + 8 * q4 + 4 * lh);
#pragma unroll
    for (int i = 0; i < 2; ++i) gtv[i] = gatev[av[i]];
    char* tw = F.lds + F.wave * 8704;
    int ln = F.lane; asm volatile("" : "+v"(ln));
#pragma unroll
    for (int i = 0; i < 2; ++i) {
        const float gt = gtv[i];
#pragma unroll
        for (int j = 0; j < 4; ++j)
#pragma unroll
            for (int q4 = 0; q4 < 4; ++q4) {
                u32x2 w = {cvt_pk_bf16((acc[i][j][4 * q4 + 0] * RS + bd[j][q4][0]) * gt, (acc[i][j][4 * q4 + 1] * RS + bd[j][q4][1]) * gt), cvt_pk_bf16((acc[i][j][4 * q4 + 2] * RS + bd[j][q4][2]) * gt, (acc[i][j][4 * q4 + 3] * RS + bd[j][q4][3]) * gt)};
                *(u32x2*)(tw + l31 * 272 + (32 * j + 8 * q4 + 4 * lh) * 2) = w; }
#pragma unroll
        for (int q = 0; q < 8; ++q) {
            const int rl = q * 4 + (ln >> 4), chunk = ln & 15;
            const int a = __shfl(av[i], rl, 64);
            const u32x4 v = *(const u32x4*)(tw + rl * 272 + chunk * 16);
            if (mt * 256 + 64 * g.wm + 32 * i + rl < ne) *(u32x4*)(outb + (size_t)a * DM + nt * 256 + 128 * g.wn + chunk * 8) = v;
        }
    }
    STG_BARRIER();
}
__device__ __forceinline__ void moe_up_unit_first(const Frame& F, const GemmThread& g, const MoeTab& tb, int e, int nt) {
    const int ne = __builtin_amdgcn_readfirstlane(tb.cnt[e]); if (ne == 0) return;
    const int* list = WSP(const int, WS_LIST); const unsigned char* h2 = WSP(const unsigned char, WS_H2);
    const float* w_gate = INP(16); const float* w_up = INP(18);
    f32x4 acc[4][8]; acc_zero(acc);
    int achunk = g.rchunk, arow = g.rrow0, kg = g.kg, ng = g.ng; asm volatile("" : "+v"(achunk), "+v"(arow), "+v"(kg), "+v"(ng));
    unsigned aoff[2];
#pragma unroll
    for (int i = 0; i < 2; ++i) { int rk = arow + 16 * i; rk = rk < ne ? rk : ne - 1; const int a = list[e * 8192 + rk]; aoff[i] = (unsigned)(a >> 2) * (unsigned)DM + achunk; }
    const int isup = (F.wave >> 1) & 1;
    const char* bb = (const char*)((isup ? w_up : w_gate) + (size_t)e * DM * DM + nt * 128);
    const unsigned boff = (unsigned)(8 * kg) * (DM * 4u) + (unsigned)((ng >> 5) * 64 + (ng & 15) * 4) * 4u;
    f8_accum_w32(acc, F.lds, g, F.wave, (const char*)h2, aoff, bb, boff, DM * 4, DM / 64, (char*)(WSB() + WS_IMGGU) + (size_t)((e * 16 + nt) * 32) * 16384);
    moe_up_epilogue(F, g, acc, e, 0, nt, ne, __builtin_amdgcn_readfirstlane(tb.rowbase[e]));
}
__device__ __forceinline__ void moe_dn_unit_first(const Frame& F, const GemmThread& g, const MoeTab& tb, int e, int nt) {
    const int ne = __builtin_amdgcn_readfirstlane(tb.cnt[e]); if (ne == 0) return;
    const unsigned char* act = WSP(const unsigned char, WS_ACT); const float* w_down = INP(20);
    const int rowb = __builtin_amdgcn_readfirstlane(tb.rowbase[e]);
    f32x4 acc[4][8]; acc_zero(acc);
    int achunk = g.rchunk, arow = g.rrow0, kg = g.kg, ng = g.ng; asm volatile("" : "+v"(achunk), "+v"(arow), "+v"(kg), "+v"(ng));
    unsigned aoff[2];
#pragma unroll
    for (int i = 0; i < 2; ++i) aoff[i] = (unsigned)(arow + 16 * i) * 64u + achunk;
    f8_accum_w32(acc, F.lds, g, F.wave, (const char*)(act + (size_t)(rowb >> 8) * 32 * 16384), aoff, (const char*)(w_down + (size_t)e * DM * DM + nt * 256), (unsigned)(8 * kg) * (DM * 4u) + 16u * ng, DM * 4, DM / 64,
                 (char*)(WSB() + WS_IMGDN) + (size_t)((e * 8 + nt) * 32) * 16384, 16384u);
    moe_dn_epilogue(F, g, acc, e, 0, nt, ne);
}
__device__ __forceinline__ void moe_up_unit_dma(const Frame& F, const GemmThread& g, const MoeTab& tb, int e, int mt, int nt) {
    const int ne = __builtin_amdgcn_readfirstlane(tb.cnt[e]);
    const int* list = WSP(const int, WS_LIST); const unsigned char* h2 = WSP(const unsigned char, WS_H2);
    int achunk = g.rchunk, arow = g.rrow0; asm volatile("" : "+v"(achunk), "+v"(arow));
    f32x16 acc[2][4];
#pragma unroll
    for (int i = 0; i < 2; ++i)
#pragma unroll
        for (int j = 0; j < 4; ++j) acc[i][j] = f32x16{};
    unsigned aoff[2];
#pragma unroll
    for (int i = 0; i < 2; ++i) { int rk = mt * 256 + arow + 16 * i; rk = rk < ne ? rk : ne - 1; const int a = list[e * 8192 + rk]; aoff[i] = (unsigned)(a >> 2) * (unsigned)DM + achunk; }
    s8_accum_ring(acc, F.lds, g, F.wave, F.lane, (const char*)h2, aoff, (const char*)(WSB() + WS_IMGGU) + (size_t)((e * 16 + nt) * 32) * 16384, DM / 64);
    moe_up_epilogue32(F, g, acc, e, mt, nt, ne, __builtin_amdgcn_readfirstlane(tb.rowbase[e]) + mt * 256);
}
__device__ __forceinline__ void moe_dn_unit_dma(const Frame& F, const GemmThread& g, const MoeTab& tb, int e, int mt, int nt) {
    const int ne = __builtin_amdgcn_readfirstlane(tb.cnt[e]), rowb = __builtin_amdgcn_readfirstlane(tb.rowbase[e]) + mt * 256;
    const unsigned char* act = WSP(const unsigned char, WS_ACT);
    int achunk = g.rchunk, arow = g.rrow0; asm volatile("" : "+v"(achunk), "+v"(arow));
    f32x16 acc[2][4];
#pragma unroll
    for (int i = 0; i < 2; ++i)
#pragma unroll
        for (int j = 0; j < 4; ++j) acc[i][j] = f32x16{};
    unsigned aoff[2];
#pragma unroll
    for (int i = 0; i < 2; ++i) aoff[i] = (unsigned)(arow + 16 * i) * 64u + achunk;
    s8_accum_ring(acc, F.lds, g, F.wave, F.lane, (const char*)(act + (size_t)(rowb >> 8) * 32 * 16384), aoff, (const char*)(WSB() + WS_IMGDN) + (size_t)((e * 8 + nt) * 32) * 16384, DM / 64, 16384u);
    moe_dn_epilogue32(F, g, acc, e, mt, nt, ne);
}

__device__ __forceinline__ void moe_dn_unit_dma_h(const Frame& F, const GemmThread& g, const MoeTab& tb, int e, int mt, int nt, int nh) {
    const int ne = __builtin_amdgcn_readfirstlane(tb.cnt[e]), rowb = __builtin_amdgcn_readfirstlane(tb.rowbase[e]) + mt * 256;
    const unsigned char* act = WSP(const unsigned char, WS_ACT);
    int achunk = g.rchunk, arow = g.rrow0; asm volatile("" : "+v"(achunk), "+v"(arow));
    f32x16 acc[2][2];
#pragma unroll
    for (int i = 0; i < 2; ++i)
#pragma unroll
        for (int j = 0; j < 2; ++j) acc[i][j] = f32x16{};
    unsigned aoff[2];
#pragma unroll
    for (int i = 0; i < 2; ++i) aoff[i] = (unsigned)(arow + 16 * i) * 64u + achunk;
    s8_accum_ring_h(acc, F.lds, g, F.wave, F.lane, (const char*)(act + (size_t)(rowb >> 8) * 32 * 16384), aoff, (const char*)(WSB() + WS_IMGDN) + (size_t)((e * 8 + nt) * 32) * 16384 + nh * 8192, DM / 64, 16384u);
    const float* b_down = INP(21); const int* list = WSP(const int, WS_LIST); const float* gatev = WSP(const float, WS_GATEV); bf16_t* outb = WSP(bf16_t, WS_OUTB);
    int l31 = F.lane & 31, lh = F.lane >> 5; asm volatile("" : "+v"(l31), "+v"(lh));
    constexpr float RS = 1.f / (FP8_SACT * FP8_SW);
    int av[2]; float gtv[2]; f32x4 bd[2][4];
#pragma unroll
    for (int i = 0; i < 2; ++i) { int rk = mt * 256 + 64 * g.wm + 32 * i + l31; rk = rk < ne ? rk : ne - 1; av[i] = list[e * 8192 + rk]; }
#pragma unroll
    for (int j = 0; j < 2; ++j)
#pragma unroll
        for (int q4 = 0; q4 < 4; ++q4) bd[j][q4] = *(const f32x4*)(b_down + (size_t)e * DM + nt * 256 + nh * 128 + 64 * g.wn + 32 * j + 8 * q4 + 4 * lh);
#pragma unroll
    for (int i = 0; i < 2; ++i) gtv[i] = gatev[av[i]];
#pragma unroll
    for (int i = 0; i < 2; ++i) {
        const int ml = 64 * g.wm + 32 * i + l31, rk = mt * 256 + ml;
        if (rk < ne) {
            const int a = av[i]; const float gt = gtv[i];
#pragma unroll
            for (int j = 0; j < 2; ++j)
#pragma unroll
                for (int q4 = 0; q4 < 4; ++q4) { const int col = nt * 256 + nh * 128 + 64 * g.wn + 32 * j + 8 * q4 + 4 * lh;
                    u32x2 w = {cvt_pk_bf16((acc[i][j][4 * q4 + 0] * RS + bd[j][q4][0]) * gt, (acc[i][j][4 * q4 + 1] * RS + bd[j][q4][1]) * gt), cvt_pk_bf16((acc[i][j][4 * q4 + 2] * RS + bd[j][q4][2]) * gt, (acc[i][j][4 * q4 + 3] * RS + bd[j][q4][3]) * gt)};
                    *(u32x2*)(outb + (size_t)a * DM + col) = w; }
        }
    }
}

__device__ __forceinline__ void p7_moe_a(const Frame& F) {
    const GemmThread g = gemm_thread_init();
    const MoeTab tb = moe_tab(F);
    const int vcu = (F.G & 7) ? F.bx : F.xl * (F.G >> 3) + F.rk;
#pragma unroll 1
    for (int u = vcu; u < 32 * 16; u += F.G) { const int e = u >> 4, nt = u & 15;
        moe_up_unit_first(F, g, tb, e, nt);
        if (__builtin_amdgcn_readfirstlane(tb.tiles[e]) >= 2) { const GemmThread g2 = gemm_thread_init<true>(); moe_up_unit_dma(F, g2, tb, e, 1, nt); } }
}
__device__ __forceinline__ void p8_moe_b(const Frame& F) {
    const GemmThread g = gemm_thread_init();
    const MoeTab tb = moe_tab(F);
    const int nb = __builtin_amdgcn_readfirstlane(tb.pt[32]) * 16;
    const int vcu = (F.G & 7) ? F.bx : F.xl * (F.G >> 3) + F.rk;
    int u = vcu;
#pragma unroll 1
    for (; u < 256; u += F.G) { const int e = u >> 3, nt = u & 7;
        moe_dn_unit_first(F, g, tb, e, nt);
        if (__builtin_amdgcn_readfirstlane(tb.tiles[e]) >= 2) { const GemmThread g2 = gemm_thread_init<true>(); moe_dn_unit_dma(F, g2, tb, e, 1, nt); } }
    if (F.G == 256) {
        const int T = nb >> 4, ngrp = 2 * ((T + 3) >> 2);
        for (int gi = F.xl; gi < ngrp; gi += 8) { const int tix = (gi >> 1) * 4 + (F.rk >> 3), nt = (gi & 1) * 8 + (F.rk & 7);
            if (tix < T) { int e, mt; moe_tile_of(tb, tix, e, mt); e = __builtin_amdgcn_readfirstlane(e); mt = __builtin_amdgcn_readfirstlane(mt); moe_up_unit_dma(F, g, tb, e, mt, nt); } }
    } else
    for (u = F.bx; u < nb; u += F.G) { int e, mt; moe_tile_of(tb, u >> 4, e, mt); e = __builtin_amdgcn_readfirstlane(e); mt = __builtin_amdgcn_readfirstlane(mt); moe_up_unit_dma(F, g, tb, e, mt, u & 15); }
}
__device__ __forceinline__ void p9_moe_c(const Frame& F) {
    const GemmThread g = gemm_thread_init();
    const MoeTab tb = moe_tab(F);
    const int nb = __builtin_amdgcn_readfirstlane(tb.pt[32]) * 8;
    if (F.G == 256) {
        const int T = nb >> 3, ngrp = (T + 3) >> 2;
        const int rem = ngrp & 7, nfull = (rem >= 1 && rem <= 4) ? ngrp - rem : ngrp;
        for (int gi = F.xl; gi < nfull; gi += 8) { const int tix = gi * 4 + (F.rk >> 3), nt = F.rk & 7;
            if (tix < T) { int e, mt; moe_tile_of(tb, tix, e, mt); e = __builtin_amdgcn_readfirstlane(e); mt = __builtin_amdgcn_readfirstlane(mt); moe_dn_unit_dma(F, g, tb, e, mt, nt); } }
        if (nfull < ngrp && F.xl < 2 * rem) { const int gi = nfull + (F.xl >> 1), nh = F.xl & 1, tix = gi * 4 + (F.rk >> 3), nt = F.rk & 7;
            if (tix < T) { int e, mt; moe_tile_of(tb, tix, e, mt); e = __builtin_amdgcn_readfirstlane(e); mt = __builtin_amdgcn_readfirstlane(mt); moe_dn_unit_dma_h(F, g, tb, e, mt, nt, nh); } }
    } else
    for (int u = F.bx; u < nb; u += F.G) { int e, mt; moe_tile_of(tb, u >> 3, e, mt); e = __builtin_amdgcn_readfirstlane(e); mt = __builtin_amdgcn_readfirstlane(mt); moe_dn_unit_dma(F, g, tb, e, mt, u & 7); }
}

__device__ __forceinline__ void p10_final(const Frame& F) {
    const int tid = F.tid, lane = F.lane, wave = F.wave;
    const float* gpf = INP(22); const float* x1b = WSP(const float, WS_X1); const bf16_t* outb = WSP(const bf16_t, WS_OUTB);
    float* gfv = (float*)F.lds;
    for (int grp = F.bx; grp < NTOK / 32; grp += F.G) {
        const int row0 = grp * 32, b = row0 / SEQ;
        __syncthreads();
        for (int k = tid; k < DM; k += NTHREADS) gfv[k] = mod_at(F, b * 12288 + 5 * DM + k) * gpf[k];
        __syncthreads();
#pragma unroll 1
        for (int rp = 0; rp < 4; rp += 2) {
            u32x2 m2v[2][8][4]; f32x4 xvv[2][8];
#pragma unroll
            for (int q = 0; q < 2; ++q) { const int row = row0 + wave * 4 + rp + q;
#pragma unroll
                for (int i = 0; i < 8; ++i) {
#pragma unroll
                    for (int kk = 0; kk < 4; ++kk) m2v[q][i][kk] = *(const u32x2*)(outb + (size_t)(row * 4 + kk) * DM + i * 256 + lane * 4);
                    xvv[q][i] = *(const f32x4*)(x1b + (size_t)row * DM + i * 256 + lane * 4); } }
#pragma unroll
            for (int q = 0; q < 2; ++q) { const int row = row0 + wave * 4 + rp + q;
                f32x4 y[8]; float ss = 0.f;
#pragma unroll
                for (int i = 0; i < 8; ++i) { y[i] = (f32x4){0.f, 0.f, 0.f, 0.f};
#pragma unroll
                    for (int kk = 0; kk < 4; ++kk) { const u32x2 m2 = m2v[q][i][kk];
                        y[i][0] += bflo(m2[0]); y[i][1] += bfhi(m2[0]); y[i][2] += bflo(m2[1]); y[i][3] += bfhi(m2[1]); }
                    ss += y[i][0] * y[i][0] + y[i][1] * y[i][1] + y[i][2] * y[i][2] + y[i][3] * y[i][3]; }
                ss = wave_sum(ss); const float rs = rsqrtf(ss * (1.f / DM) + EPS);
#pragma unroll
                for (int i = 0; i < 8; ++i) { const int k = i * 256 + lane * 4; const f32x4 g4 = *(const f32x4*)(gfv + k);
                    f32x4 o; for (int e = 0; e < 4; ++e) o[e] = xvv[q][i][e] + g4[e] * (y[i][e] * rs);
                    *(f32x4*)(uni(F.a->out) + (size_t)row * DM + k) = o; }
            }
        }
    }
}


__global__ void __launch_bounds__(NTHREADS, 2) fwd_kernel(Args args) {
    extern __shared__ __attribute__((aligned(16))) char lds[];
    Frame F;
    F.lds = lds; F.a = &args;
    F.tid = threadIdx.x; F.lane = F.tid & 63; F.wave = __builtin_amdgcn_readfirstlane(F.tid >> 6); F.G = gridDim.x; F.bx = blockIdx.x;
    const int lo = args.ph_lo, hi = args.ph_hi;
    F.xl = F.bx & 7; F.rk = F.bx >> 3;
    XcdBarrier bar; bar.bar = (unsigned*)(args.ws + WS_CTL); bar.x = 0; bar.st = (volatile LAS unsigned*)(lds + LDS_MISC);
    if (hi - lo > 1) {
        if (F.tid == 0) { *(volatile LAS unsigned*)(lds + LDS_MISC) = 0u; *(volatile LAS unsigned*)(lds + LDS_MISC + 4) = 0u; }
        __syncthreads();
        bar = xcd_barrier_post((unsigned*)(args.ws + WS_CTL), (volatile LAS unsigned*)(lds + LDS_MISC));
        if (F.tid == 0) *(volatile LAS unsigned*)(lds + LDS_MISC + 16) = xb_add((unsigned*)(args.ws + WS_CTL + CTL_RANK_OFF) + bar.x, 1u);
    }
#ifndef PH_MASK
#define PH_MASK 0x7ff
#endif
#define IN(k) (((PH_MASK >> (k)) & 1) && lo <= (k) && (k) < hi)
#define SEAM(k) do { if (IN(k) && IN((k) + 1)) xcd_barrier(bar); } while (0)
    if (IN(0)) { p0_prologue(F); } SEAM(0);
    if (hi - lo > 1 && (F.G & 7) == 0) {
        if (F.tid == 0) { unsigned ok = 1u; for (int j = 0; j < 8; ++j) ok &= (xb_ld(&bar.bar[XB_XCNT(j)]) == (unsigned)(F.G >> 3)) ? 1u : 0u; *(volatile LAS unsigned*)(lds + LDS_MISC + 20) = ok; }
        __syncthreads();
        if (*(volatile LAS unsigned*)(lds + LDS_MISC + 20) && bar.x < 8u) { F.xl = (int)bar.x; F.rk = (int)*(volatile LAS unsigned*)(lds + LDS_MISC + 16); }
        F.xl = __builtin_amdgcn_readfirstlane(F.xl); F.rk = __builtin_amdgcn_readfirstlane(F.rk);
    }
    if (IN(1)) { p1_norm(F); } SEAM(1);
    if (IN(2)) { p2_inproj(F); } SEAM(2);
    if (IN(3)) { p3_mixers(F); } SEAM(3);
    if (IN(4)) { p4_merge_norm(F); } SEAM(4);
    if (IN(5)) { p5_outproj(F); } SEAM(5);
    if (IN(6)) { p6_postmix(F); } SEAM(6);
    if (IN(7)) { p7_moe_a(F); } SEAM(7);
    if (IN(8)) { p8_moe_b(F); } SEAM(8);
    if (IN(9)) { p9_moe_c(F); } SEAM(9);
    if (IN(10)) { p10_final(F); }
#undef IN
#undef SEAM
}

}

extern "C" void kernel_launch(void* const* d_in, const int* in_sizes, int n_in, void* d_out, int out_size, void* d_ws, size_t ws_size, hipStream_t stream) {
    static int grid = 0;
    if (grid == 0) {
        if (n_in != 23 || out_size != NTOK * DM || ws_size < WS_END) { fprintf(stderr, "kernel_launch: unexpected shapes (n_in %d out %d ws %zu need %zu)\n", n_in, out_size, ws_size, (size_t)WS_END); grid = -1; return; }
        int dev = 0, cus = 0, per_cu = 0;
        if (hipGetDevice(&dev) != hipSuccess || hipDeviceGetAttribute(&cus, hipDeviceAttributeMultiprocessorCount, dev) != hipSuccess) { grid = -1; return; }
        if (hipFuncSetAttribute((const void*)fwd_kernel, hipFuncAttributeMaxDynamicSharedMemorySize, LDS_BYTES) != hipSuccess) { fprintf(stderr, "kernel_launch: hipFuncSetAttribute failed\n"); grid = -1; return; }
        if (hipOccupancyMaxActiveBlocksPerMultiprocessor(&per_cu, (const void*)fwd_kernel, NTHREADS, LDS_BYTES) != hipSuccess || per_cu < 1)
            fprintf(stderr, "kernel_launch: occupancy query reports %d blocks per CU\n", per_cu);
        (void)hipGetLastError();
        grid = cus;
    }
    if (grid < 0) return;
    (void)hipMemsetAsync((char*)d_ws + WS_CTL, 0, CTL_BYTES, stream);
    Args a{};
    for (int i = 0; i < 23; ++i) a.in[i] = (const float*)d_in[i];
    a.out = (float*)d_out; a.ws = (unsigned char*)d_ws;
#if MK_N_LAUNCHES == 1
    a.ph_lo = 0; a.ph_hi = NPHASE;
    hipLaunchKernelGGL(fwd_kernel, dim3(grid), dim3(NTHREADS), LDS_BYTES, stream, a);
#else
    for (int p = 0; p < NPHASE; ++p) { a.ph_lo = p; a.ph_hi = p + 1; hipLaunchKernelGGL(fwd_kernel, dim3(grid), dim3(NTHREADS), LDS_BYTES, stream, a);
        if ((REP_MASK >> p) & 1) hipLaunchKernelGGL(fwd_kernel, dim3(grid), dim3(NTHREADS), LDS_BYTES, stream, a); }
#endif
    const hipError_t le = hipPeekAtLastError();
    if (le != hipSuccess) fprintf(stderr, "kernel_launch: launch failed: %s\n", hipGetErrorName(le));
}
```
